# Optimizing an MI355X kernel written in HIP

```python
import jax
import jax.numpy as jnp
from jax import lax
import numpy as np

D_MODEL = 1024
BATCH = 8
SEQ = 4096
DEPTH = 2

CTX_LEN = 256
GRID_W = 64
HEAD_DIM = D_MODEL // 16
N_FOURIER_GROUPS = 4
N_NA_HEADS = 4
N_GLA_HEADS = 4
N_GQA_HEADS = 4
N_GQA_KV_HEADS = 2
GQA_GROUP = N_GQA_HEADS // N_GQA_KV_HEADS
GLA_DK = HEAD_DIM // 2
GLA_DV = HEAD_DIM
GLA_GATE_RANK = 16
GLA_TAU = 16.0
GLA_CHUNK = 64
NA_ROWS = 8
NA_COLS = 16
Q_BLOCK = 128
D_FF = 256 * ((8 * D_MODEL // 3 + 255) // 256)
ROPE_THETA = 10000.0
EPS = 1e-6
N_MOD = 9

W_FOURIER = N_FOURIER_GROUPS * HEAD_DIM
W_NA = N_NA_HEADS * HEAD_DIM
W_GLA = N_GLA_HEADS * GLA_DV
W_GQA = N_GQA_HEADS * HEAD_DIM
D_MIX = W_FOURIER + W_NA + W_GLA + W_GQA

IN_LAYOUT = (
    ('fourier', W_FOURIER),
    ('na_q', W_NA), ('na_k', W_NA), ('na_v', W_NA),
    ('gla_q', N_GLA_HEADS * GLA_DK), ('gla_k', N_GLA_HEADS * GLA_DK),
    ('gla_v', W_GLA), ('gla_r', W_GLA),
    ('gla_gf', GLA_GATE_RANK), ('gla_gb', GLA_GATE_RANK),
    ('gqa_q', W_GQA), ('gqa_k', N_GQA_KV_HEADS * HEAD_DIM), ('gqa_v', N_GQA_KV_HEADS * HEAD_DIM),
)
D_IN = sum(w for _, w in IN_LAYOUT)

kernel_name = 'hybrid_parallel_group_diffusion_block'


def rms_norm(x, gain=None):
    xf = x.astype(jnp.float32)
    y = xf * lax.rsqrt(jnp.mean(xf * xf, axis=-1, keepdims=True) + EPS)
    if gain is not None:
        y = y * gain.astype(jnp.float32)
    return y.astype(x.dtype)


def modulate(h, shift, scale):
    return h * (1.0 + scale) + shift


def swiglu(h, w1, w3, w2):
    return (jax.nn.silu(h @ w1) * (h @ w3)) @ w2


def heads(t, n, d):
    return t.reshape(t.shape[:-1] + (n, d))


def split_in(h):
    offsets = np.cumsum([w for _, w in IN_LAYOUT])[:-1].tolist()
    parts = jnp.split(h, offsets, axis=-1)
    return {name: part for (name, _), part in zip(IN_LAYOUT, parts)}


def axial_rope(n_tokens):
    t = jnp.arange(n_tokens, dtype=jnp.int32)
    row = (t // GRID_W).astype(jnp.float32)
    col = (t % GRID_W).astype(jnp.float32)
    n_freq = HEAD_DIM // 4
    inv_freq = ROPE_THETA ** (-jnp.arange(n_freq, dtype=jnp.float32) / n_freq)
    ang = jnp.concatenate([row[:, None] * inv_freq, col[:, None] * inv_freq], axis=-1)
    return jnp.cos(ang)[:, None, :], jnp.sin(ang)[:, None, :]


def apply_rope(x, cos, sin):
    xf = x.astype(jnp.float32)
    x1, x2 = jnp.split(xf, 2, axis=-1)
    return jnp.concatenate([x1 * cos - x2 * sin, x1 * sin + x2 * cos], axis=-1).astype(x.dtype)


def fourier_mix(u):
    b_, l_, _ = u.shape
    uf = u.astype(jnp.float32).reshape(b_, l_, N_FOURIER_GROUPS, HEAD_DIM)
    y = jnp.fft.fft2(uf, axes=(1, 3), norm='ortho').real
    return y.reshape(b_, l_, W_FOURIER).astype(u.dtype)


def block_attention(q, k, v):
    b_, lq, hk, g, dh = q.shape
    nb = lq // Q_BLOCK
    qb = (q * dh ** -0.5).reshape(b_, nb, Q_BLOCK, hk, g, dh).swapaxes(0, 1)

    def one_block(q_blk):
        s = jnp.einsum('bqhgd,bkhd->bhgqk', q_blk, k).astype(jnp.float32)
        p = jax.nn.softmax(s, axis=-1).astype(v.dtype)
        return jnp.einsum('bhgqk,bkhd->bqhgd', p, v)

    o = lax.map(one_block, qb)
    return o.swapaxes(0, 1).reshape(b_, lq, hk * g * dh)


def neighborhood_attention(q, k, v, k_ctx, v_ctx, rpb):
    b_, s_, h_, dh = q.shape
    rows = s_ // GRID_W
    kr = min(NA_ROWS, rows)
    kg = k.reshape(b_, rows, GRID_W, h_, dh)
    vg = v.reshape(b_, rows, GRID_W, h_, dh)
    qg = q.reshape(b_, rows, GRID_W, h_, dh).transpose(1, 0, 2, 3, 4)
    r_pos = jnp.arange(rows)
    c_pos = jnp.arange(GRID_W)
    row_start = jnp.clip(r_pos - kr // 2, 0, rows - kr)
    rel_row = row_start[:, None] + jnp.arange(kr)[None, :] - r_pos[:, None]
    col_start = jnp.clip(c_pos - NA_COLS // 2, 0, GRID_W - NA_COLS)
    col_idx = col_start[:, None] + jnp.arange(NA_COLS)[None, :]
    rel_col = col_idx - c_pos[:, None]
    bias_col = rpb.astype(jnp.float32)[:, :, rel_col + NA_COLS - 1]
    scale = dh ** -0.5
    n_win = kr * NA_COLS

    def row_block(args):
        q_r, rs, rr = args
        k_blk = lax.dynamic_slice_in_dim(kg, rs, kr, axis=1)[:, :, col_idx]
        v_blk = lax.dynamic_slice_in_dim(vg, rs, kr, axis=1)[:, :, col_idx]
        bias = bias_col[:, rr + NA_ROWS - 1].transpose(0, 2, 1, 3)
        s_win = jnp.einsum('bchd,brckhd->bhcrk', q_r, k_blk).astype(jnp.float32) * scale + bias[None]
        s_ctx = jnp.einsum('bchd,bjhd->bhcj', q_r, k_ctx).astype(jnp.float32) * scale
        s = jnp.concatenate([s_win.reshape(b_, h_, GRID_W, n_win), s_ctx], axis=-1)
        p = jax.nn.softmax(s, axis=-1).astype(v.dtype)
        p_win = p[..., :n_win].reshape(b_, h_, GRID_W, kr, NA_COLS)
        p_ctx = p[..., n_win:]
        return (jnp.einsum('bhcrk,brckhd->bchd', p_win, v_blk)
                + jnp.einsum('bhcj,bjhd->bchd', p_ctx, v_ctx))

    out = lax.map(row_block, (qg, row_start, rel_row))
    return out.transpose(1, 0, 2, 3, 4).reshape(b_, s_, h_ * dh)


def gla_scan(q, k, v, log_a, s0):
    b_, h_, l_, _ = q.shape
    dv = v.shape[-1]
    n_chunks = l_ // GLA_CHUNK

    def chunks(t):
        return t.reshape(b_, h_, n_chunks, GLA_CHUNK, t.shape[-1]).transpose(2, 0, 1, 3, 4)

    lower_tri = jnp.tril(jnp.ones((GLA_CHUNK, GLA_CHUNK), dtype=bool))[None, None, :, :, None]

    def step(s, inp):
        qc, kc, vc, ac = inp
        qf, kf, vf = (t.astype(jnp.float32) for t in (qc, kc, vc))
        b = jnp.cumsum(ac.astype(jnp.float32), axis=2)
        rel = b[:, :, :, None, :] - b[:, :, None, :, :]
        decay = jnp.where(lower_tri, jnp.exp(jnp.minimum(rel, 0.0)), 0.0)
        scores = jnp.einsum('bhid,bhjd,bhijd->bhij', qf, kf, decay)
        o = (jnp.einsum('bhcd,bhde->bhce', qf * jnp.exp(b), s)
             + jnp.einsum('bhij,bhje->bhie', scores, vf))
        b_last = b[:, :, -1:, :]
        s_new = (jnp.exp(b_last[:, :, 0, :])[..., None] * s
                 + jnp.einsum('bhcd,bhce->bhde', kf * jnp.exp(b_last - b), vf))
        return s_new, o.astype(v.dtype)

    s_final, o = lax.scan(step, s0, (chunks(q), chunks(k), chunks(v), chunks(log_a)))
    return o.transpose(1, 2, 0, 3, 4).reshape(b_, h_, l_, dv), s_final


def bidir_gla(q, k, v, a_f, a_b, s0_f, s0_b):
    flip = lambda t: jnp.flip(t, axis=2)
    o_f, s_f = gla_scan(q, k, v, a_f, s0_f)
    o_b, s_b = gla_scan(flip(q), flip(k), flip(v), flip(a_b), s0_b)
    return o_f + flip(o_b), s_f, s_b


def gla_prepare(p, w_gf, b_gf, w_gb, b_gb):
    to_bhld = lambda t, d: heads(t, N_GLA_HEADS, d).transpose(0, 2, 1, 3)
    q = to_bhld(p['gla_q'] * GLA_DK ** -0.5, GLA_DK)
    k = to_bhld(p['gla_k'], GLA_DK)
    v = to_bhld(p['gla_v'], GLA_DV)
    a_f = to_bhld(jax.nn.log_sigmoid((p['gla_gf'] @ w_gf + b_gf).astype(jnp.float32)) / GLA_TAU, GLA_DK)
    a_b = to_bhld(jax.nn.log_sigmoid((p['gla_gb'] @ w_gb + b_gb).astype(jnp.float32)) / GLA_TAU, GLA_DK)
    return q, k, v, a_f, a_b


def gla_output(o, r, gain):
    b_, _, l_, _ = o.shape
    o = rms_norm(o.transpose(0, 2, 1, 3), gain).reshape(b_, l_, W_GLA)
    return o * jax.nn.silu(r)


def token_mixing(hx, hz, cos, sin, na_q_norm, na_k_norm, na_rpb, gla_w_gate_f, gla_b_gate_f,
                 gla_w_gate_b, gla_b_gate_b, gla_norm, gqa_q_norm, gqa_k_norm, with_ctx_out):
    px, pz = split_in(hx), split_in(hz)
    b_, s_ = hx.shape[0], hx.shape[1]
    lc = hz.shape[1]
    a_x = fourier_mix(px['fourier'])
    na_q = lambda p: rms_norm(heads(p['na_q'], N_NA_HEADS, HEAD_DIM), na_q_norm)
    na_k = lambda p: rms_norm(heads(p['na_k'], N_NA_HEADS, HEAD_DIM), na_k_norm)
    na_v = lambda p: heads(p['na_v'], N_NA_HEADS, HEAD_DIM)
    kz_na, vz_na = na_k(pz), na_v(pz)
    b_x = neighborhood_attention(na_q(px), na_k(px), na_v(px), kz_na, vz_na, na_rpb)
    gates = (gla_w_gate_f, gla_b_gate_f, gla_w_gate_b, gla_b_gate_b)
    s0 = jnp.zeros((b_, N_GLA_HEADS, GLA_DK, GLA_DV), jnp.float32)
    oz_gla, s_f, s_b = bidir_gla(*gla_prepare(pz, *gates), s0, s0)
    ox_gla, _, _ = bidir_gla(*gla_prepare(px, *gates), s_f, s_b)
    c_x = gla_output(ox_gla, px['gla_r'], gla_norm)
    gqa_q = lambda p: rms_norm(heads(p['gqa_q'], N_GQA_HEADS, HEAD_DIM), gqa_q_norm)
    gqa_k = lambda p: rms_norm(heads(p['gqa_k'], N_GQA_KV_HEADS, HEAD_DIM), gqa_k_norm)
    gqa_v = lambda p: heads(p['gqa_v'], N_GQA_KV_HEADS, HEAD_DIM)
    kz_gqa, vz_gqa = gqa_k(pz), gqa_v(pz)
    qx_gqa = apply_rope(gqa_q(px), cos, sin).reshape(b_, s_, N_GQA_KV_HEADS, GQA_GROUP, HEAD_DIM)
    kx_gqa = apply_rope(gqa_k(px), cos, sin)
    d_x = block_attention(qx_gqa, jnp.concatenate([kx_gqa, kz_gqa], axis=1),
                          jnp.concatenate([gqa_v(px), vz_gqa], axis=1))
    out_x = jnp.concatenate([a_x, b_x, c_x, d_x], axis=-1)
    if not with_ctx_out:
        return out_x, None
    a_z = fourier_mix(pz['fourier'])
    b_z = block_attention(na_q(pz)[:, :, :, None, :], kz_na, vz_na)
    c_z = gla_output(oz_gla, pz['gla_r'], gla_norm)
    d_z = block_attention(gqa_q(pz).reshape(b_, lc, N_GQA_KV_HEADS, GQA_GROUP, HEAD_DIM), kz_gqa, vz_gqa)
    return out_x, jnp.concatenate([a_z, b_z, c_z, d_z], axis=-1)


def setup_inputs(seed: int = 0) -> dict:
    key = jax.random.key(seed)
    ks = iter(jax.random.split(key, 32))
    f32 = jnp.float32

    def nrm(shape, std):
        return jax.random.normal(next(ks), shape, f32) * std

    L, D = DEPTH, D_MODEL
    return {
        'x': nrm((BATCH, SEQ, D), 1.0),
        'c': nrm((BATCH, D), 1.0),
        'ctx': nrm((BATCH, CTX_LEN, D), 1.0),
        'c_ctx': nrm((D,), 1.0),
        'w_mod': nrm((L, D, N_MOD * D), 0.5 * D ** -0.5),
        'b_mod': nrm((L, N_MOD * D), 0.02),
        'ffn1_w1': nrm((L, D, D_FF), D ** -0.5),
        'ffn1_w3': nrm((L, D, D_FF), D ** -0.5),
        'ffn1_w2': nrm((L, D_FF, D), D_FF ** -0.5),
        'w_in': nrm((L, D, D_IN), D ** -0.5),
        'na_q_norm': 1.0 + nrm((L, HEAD_DIM), 0.1),
        'na_k_norm': 1.0 + nrm((L, HEAD_DIM), 0.1),
        'na_rpb': nrm((L, N_NA_HEADS, 2 * NA_ROWS - 1, 2 * NA_COLS - 1), 0.1),
        'gla_w_gate_f': nrm((L, GLA_GATE_RANK, N_GLA_HEADS * GLA_DK), GLA_GATE_RANK ** -0.5),
        'gla_b_gate_f': nrm((L, N_GLA_HEADS * GLA_DK), 0.1),
        'gla_w_gate_b': nrm((L, GLA_GATE_RANK, N_GLA_HEADS * GLA_DK), GLA_GATE_RANK ** -0.5),
        'gla_b_gate_b': nrm((L, N_GLA_HEADS * GLA_DK), 0.1),
        'gla_norm': 1.0 + nrm((L, GLA_DV), 0.1),
        'gqa_q_norm': 1.0 + nrm((L, HEAD_DIM), 0.1),
        'gqa_k_norm': 1.0 + nrm((L, HEAD_DIM), 0.1),
        'w_out': nrm((L, D_MIX, D), D_MIX ** -0.5),
        'ffn2_w1': nrm((L, D, D_FF), D ** -0.5),
        'ffn2_w3': nrm((L, D, D_FF), D ** -0.5),
        'ffn2_w2': nrm((L, D_FF, D), D_FF ** -0.5),
    }


def reference(x, c, ctx, c_ctx, w_mod, b_mod, ffn1_w1, ffn1_w3, ffn1_w2, w_in,
              na_q_norm, na_k_norm, na_rpb, gla_w_gate_f, gla_b_gate_f, gla_w_gate_b, gla_b_gate_b,
              gla_norm, gqa_q_norm, gqa_k_norm, w_out, ffn2_w1, ffn2_w3, ffn2_w2):
    cos, sin = axial_rope(x.shape[1])
    z = ctx
    for l in range(DEPTH):
        last = l == DEPTH - 1
        mx = jnp.split((jax.nn.silu(c) @ w_mod[l] + b_mod[l])[:, None, :], N_MOD, axis=-1)
        mz = jnp.split(jax.nn.silu(c_ctx) @ w_mod[l] + b_mod[l], N_MOD, axis=-1)
        x = x + 0.5 * mx[2] * swiglu(modulate(rms_norm(x), mx[0], mx[1]), ffn1_w1[l], ffn1_w3[l], ffn1_w2[l])
        z = z + 0.5 * mz[2] * swiglu(modulate(rms_norm(z), mz[0], mz[1]), ffn1_w1[l], ffn1_w3[l], ffn1_w2[l])
        hx = modulate(rms_norm(x), mx[3], mx[4]) @ w_in[l]
        hz = modulate(rms_norm(z), mz[3], mz[4]) @ w_in[l]
        mix_x, mix_z = token_mixing(hx, hz, cos, sin, na_q_norm[l], na_k_norm[l], na_rpb[l],
                                    gla_w_gate_f[l], gla_b_gate_f[l], gla_w_gate_b[l], gla_b_gate_b[l],
                                    gla_norm[l], gqa_q_norm[l], gqa_k_norm[l], not last)
        x = x + mx[5] * (mix_x @ w_out[l])
        x = x + 0.5 * mx[8] * swiglu(modulate(rms_norm(x), mx[6], mx[7]), ffn2_w1[l], ffn2_w3[l], ffn2_w2[l])
        if not last:
            z = z + mz[5] * (mix_z @ w_out[l])
            z = z + 0.5 * mz[8] * swiglu(modulate(rms_norm(z), mz[6], mz[7]), ffn2_w1[l], ffn2_w3[l], ffn2_w2[l])
    return x
```

```cpp
#include <hip/hip_runtime.h>
#include <hip/hip_cooperative_groups.h>
#include <cstdio>
#include <cstdint>
namespace cg = cooperative_groups;
namespace pg8 {
#define PG8_LAS __attribute__((address_space(3)))
typedef unsigned short bf16_t;
typedef short bf16x8 __attribute__((ext_vector_type(8)));
typedef float f32x4 __attribute__((ext_vector_type(4)));
typedef unsigned u32x4 __attribute__((ext_vector_type(4)));
constexpr int BM = 256, BK = 64, HALF = 128, HTB = HALF * BK * 2  , STAGE_BYTES = 8 * HTB, NXCD = 8, WGM = 8;

__host__ __device__ __forceinline__ int lds_byte(int r, int c) { const int st = (r >> 4) * 2 + (c >> 5), rr = r & 15, cc = c & 31, ob = rr * 64 + cc * 2; return st * 1024 + (ob ^ (((ob >> 9) & 1) << 5)); }
__host__ __device__ __forceinline__ void stage_rc(int b, int& R, int& C) { const int st = b / 1024, sb = b % 1024, swz = sb ^ (((sb >> 9) & 1) << 5); R = (st >> 1) * 16 + swz / 64; C = (st & 1) * 32 + (swz % 64) / 2; }
__host__ __device__ __forceinline__ int perm32(int rho) { const int n = rho >> 4, i = rho & 15; return 8 * (i >> 2) + 4 * n + (i & 3); }

struct Unit { int pm, pn; };
struct Gemm { const bf16_t* A; const bf16_t* Bt; int M, N, K; };

struct StaticOrder {
    int nM, nN, nwg, G, c;
    __host__ __device__ void init(int M, int N, int G_, int c_) { nM = M / BM; nN = N / BM; nwg = nM * nN; G = G_; c = c_; }
    __host__ __device__ bool next(int i, Unit& u) const {
        const long L = (long)i * G + c; if (L >= nwg) return false;
        int wgid = (int)L; { const int q = nwg / NXCD, r = nwg % NXCD, xcd = wgid % NXCD, off = wgid / NXCD; wgid = (xcd < r ? xcd * (q + 1) : r * (q + 1) + (xcd - r) * q) + off; }
        const int nig = WGM * nN, gid = wgid / nig, fm = gid * WGM, gsz = (nM - fm) < WGM ? (nM - fm) : WGM;
        u.pm = fm + ((wgid % nig) % gsz); u.pn = (wgid % nig) / gsz; return true;
    }
    __device__ __forceinline__ void a_ready(const Unit&) const {}
    __device__ __forceinline__ void done(const Unit&) const {}
};

__device__ __forceinline__ unsigned cvt_pk_bf16(float lo, float hi) {
    typedef float f32x2_t __attribute__((ext_vector_type(2))); typedef __bf16 bf16x2_t __attribute__((ext_vector_type(2)));
    f32x2_t v = {lo, hi}; bf16x2_t b = __builtin_convertvector(v, bf16x2_t); return __builtin_bit_cast(unsigned, b);
}
__device__ __forceinline__ float silu_f(float v) { return v * __builtin_amdgcn_rcpf(1.0f + __expf(-v)); }
constexpr int ROWS_X = 32768;

struct EpiBf16 {
    static constexpr bool PERM = true, AFTER_DRAIN = false;
    bf16_t* O; int ldo;
    __device__ __forceinline__ void operator()(const f32x4 (&acc)[2][2][4][2], const Unit& u, int wr, int wc, int fr, int fq) const {
        const int row0 = u.pm * BM + wr * 64 + fr, col0 = u.pn * BM + wc * 32 + 8 * fq;
#pragma unroll
        for (int ai = 0; ai < 2; ++ai)
#pragma unroll
            for (int m = 0; m < 4; ++m) { bf16_t* rowp = O + (size_t)(row0 + ai * HALF + m * 16) * ldo + col0;
#pragma unroll
                for (int bj = 0; bj < 2; ++bj) { const f32x4 v0 = acc[ai][bj][m][0], v1 = acc[ai][bj][m][1]; u32x4 w;
                    w.x = cvt_pk_bf16(v0[0], v0[1]); w.y = cvt_pk_bf16(v0[2], v0[3]); w.z = cvt_pk_bf16(v1[0], v1[1]); w.w = cvt_pk_bf16(v1[2], v1[3]);
                    *(u32x4*)(rowp + bj * HALF) = w; } }
    }
};
struct EpiSwiglu {
    static constexpr bool PERM = true, AFTER_DRAIN = false;
    bf16_t* O; int ldo;
    __device__ __forceinline__ void operator()(const f32x4 (&acc)[2][2][4][2], const Unit& u, int wr, int wc, int fr, int fq) const {
        const int row0 = u.pm * BM + wr * 64 + fr, col0 = u.pn * HALF + wc * 32 + 8 * fq;
#pragma unroll
        for (int ai = 0; ai < 2; ++ai)
#pragma unroll
            for (int m = 0; m < 4; ++m) { bf16_t* rowp = O + (size_t)(row0 + ai * HALF + m * 16) * ldo + col0;
                const f32x4 g0 = acc[ai][0][m][0], g1 = acc[ai][0][m][1], u0 = acc[ai][1][m][0], u1 = acc[ai][1][m][1]; u32x4 w;
                w.x = cvt_pk_bf16(silu_f(g0[0]) * u0[0], silu_f(g0[1]) * u0[1]); w.y = cvt_pk_bf16(silu_f(g0[2]) * u0[2], silu_f(g0[3]) * u0[3]);
                w.z = cvt_pk_bf16(silu_f(g1[0]) * u1[0], silu_f(g1[1]) * u1[1]); w.w = cvt_pk_bf16(silu_f(g1[2]) * u1[2], silu_f(g1[3]) * u1[3]);
                *(u32x4*)rowp = w; }
    }
};
struct EpiResid {
    static constexpr bool PERM = false, AFTER_DRAIN = false;
    const float* inx; const float* inz; float* outx; float* outz; const float* gate;   float s;
    __device__ __forceinline__ void operator()(const f32x4 (&acc)[2][2][4][2], const Unit& u, int wr, int wc, int fr, int fq) const {
        const int trow = u.pm * BM; const bool isx = trow < ROWS_X; const int mi = isx ? (trow >> 12) : 8;
        const float* ib = isx ? inx + (size_t)trow * 1024 : inz + (size_t)(trow - ROWS_X) * 1024;
        float* ob = isx ? outx + (size_t)trow * 1024 : outz + (size_t)(trow - ROWS_X) * 1024;
        const int col0 = u.pn * BM + wc * 32 + 4 * fq; const float* gp = gate + (size_t)mi * 9216 + col0;
        f32x4 gv[2][2];
#pragma unroll
        for (int bj = 0; bj < 2; ++bj)
#pragma unroll
            for (int n = 0; n < 2; ++n) gv[bj][n] = *(const f32x4*)(gp + bj * HALF + n * 16) * s;
#pragma unroll
        for (int ai = 0; ai < 2; ++ai)
#pragma unroll
            for (int m = 0; m < 4; ++m) { const size_t off = (size_t)(ai * HALF + wr * 64 + m * 16 + fr) * 1024 + col0;
#pragma unroll
                for (int bj = 0; bj < 2; ++bj)
#pragma unroll
                    for (int n = 0; n < 2; ++n) { const f32x4 bs = *(const f32x4*)(ib + off + bj * HALF + n * 16);
                        *(f32x4*)(ob + off + bj * HALF + n * 16) = bs + gv[bj][n] * acc[ai][bj][m][n]; } }
    }
};

template <class Epi, class Sched, bool ALIGN_EPI = false, bool SP2 = false>
__device__ __forceinline__ void gemm_phase(PG8_LAS unsigned char* lds, const Gemm g, const Sched& S, const Epi& E) {
    int tid = threadIdx.x; asm volatile("" : "+v"(tid)); const int wid = __builtin_amdgcn_readfirstlane(tid >> 6), lane = tid & 63, wr = wid >> 2, wc = wid & 3, fr = lane & 15, fq = lane >> 4;
    const int K = g.K, nt = K / BK;
    unsigned voffA[2], voffB[2];
#pragma unroll
    for (int i = 0; i < 2; ++i) { int R, C; stage_rc(tid * 16 + i * 8192, R, C); const int Rb = Epi::PERM ? ((R & ~31) + perm32(R & 31)) : R;
        voffA[i] = (unsigned)(R * K + C) * 2u; voffB[i] = (unsigned)(Rb * K + C) * 2u; }
    const size_t kstep = (size_t)(BK * 2);
    const size_t hstep = (size_t)HALF * K * 2;
    const size_t tstep = 2 * hstep;
    const unsigned ldsw = (unsigned)wid * 1024u;
    const int aoff = lds_byte(wr * 64 + fr, fq * 8), boff = lds_byte(wc * 32 + fr, fq * 8);
#define PG8_SA(b, h) (((b) * 2 + (h)) * HTB)
#define PG8_SB(b, h) ((4 + (b) * 2 + (h)) * HTB)
#define PG8_STAGE(bufoff, gbase, voff) do { _Pragma("unroll") for (int _i = 0; _i < 2; ++_i) \
        __builtin_amdgcn_global_load_lds((const unsigned*)((const char*)(gbase) + (voff)[_i]), (PG8_LAS unsigned*)(lds + (bufoff) + ldsw + _i * 8192), 16, 0, 0); } while (0)
#define PG8_LDA(dst, b, h) do { _Pragma("unroll") for (int m = 0; m < 4; ++m) _Pragma("unroll") for (int k = 0; k < 2; ++k) dst[m][k] = *(const PG8_LAS bf16x8*)(lds + PG8_SA(b, h) + aoff + m * 2048 + k * 1024); } while (0)
#define PG8_LDB(dst, b, h) do { _Pragma("unroll") for (int n = 0; n < 2; ++n) _Pragma("unroll") for (int k = 0; k < 2; ++k) dst[n][k] = *(const PG8_LAS bf16x8*)(lds + PG8_SB(b, h) + boff + n * 2048 + k * 1024); } while (0)
#define PG8_MMA(ai, bj, At, Bt) do { __builtin_amdgcn_s_setprio(1); _Pragma("unroll") for (int m = 0; m < 4; ++m) _Pragma("unroll") for (int n = 0; n < 2; ++n) _Pragma("unroll") for (int k = 0; k < 2; ++k) \
        acc[ai][bj][m][n] = __builtin_amdgcn_mfma_f32_16x16x32_bf16(Bt[n][k], At[m][k], acc[ai][bj][m][n], 0, 0, 0); __builtin_amdgcn_s_setprio(0); } while (0)
#define PG8_WAIT_V(n) asm volatile("s_waitcnt vmcnt(" #n ")" ::: "memory")
#define PG8_WAIT_L(n) asm volatile("s_waitcnt lgkmcnt(" #n ")" ::: "memory")
#define PG8_BAR __builtin_amdgcn_s_barrier()
#define PG8_SCHED __builtin_amdgcn_sched_barrier(0)
    Unit cur, nxt; int ui = 0;
    if (!S.next(0, cur)) return;
    f32x4 acc[2][2][4][2];
#pragma unroll
    for (int a = 0; a < 2; ++a)
#pragma unroll
        for (int b = 0; b < 2; ++b)
#pragma unroll
            for (int m = 0; m < 4; ++m)
#pragma unroll
                for (int n = 0; n < 2; ++n) acc[a][b][m][n] = (f32x4){0.f, 0.f, 0.f, 0.f};
    bf16x8 At[4][2], B0[2][2], B1[2][2];
    const char* cA = (const char*)g.A + (size_t)cur.pm * tstep; const char* cB = (const char*)g.Bt + (size_t)cur.pn * tstep;
    S.a_ready(cur);
    if constexpr (SP2) {
        PG8_STAGE(PG8_SB(0, 0), cB, voffB); PG8_STAGE(PG8_SB(0, 1), cB + hstep, voffB); PG8_STAGE(PG8_SA(0, 0), cA, voffA); PG8_STAGE(PG8_SA(0, 1), cA + hstep, voffA);
        if (wr == 1) PG8_BAR;
        PG8_WAIT_V(2); PG8_BAR;
        PG8_STAGE(PG8_SB(1, 0), cB + kstep, voffB); PG8_STAGE(PG8_SA(1, 0), cA + kstep, voffA); PG8_STAGE(PG8_SB(1, 1), cB + hstep + kstep, voffB);
        PG8_WAIT_V(6); PG8_BAR;
    } else {
        PG8_STAGE(PG8_SB(0, 0), cB, voffB); PG8_STAGE(PG8_SA(0, 0), cA, voffA); PG8_STAGE(PG8_SB(0, 1), cB + hstep, voffB); PG8_STAGE(PG8_SA(0, 1), cA + hstep, voffA);
        if (wr == 1) PG8_BAR;
        PG8_WAIT_V(4); PG8_BAR;
        PG8_STAGE(PG8_SB(1, 0), cB + kstep, voffB); PG8_STAGE(PG8_SA(1, 0), cA + kstep, voffA); PG8_STAGE(PG8_SB(1, 1), cB + hstep + kstep, voffB);
        PG8_WAIT_V(6); PG8_BAR;
    }
    for (;;) {
        const bool has_next = S.next(ui + 1, nxt);
        const char* nA = has_next ? (const char*)g.A + (size_t)nxt.pm * tstep : cA; const char* nB = has_next ? (const char*)g.Bt + (size_t)nxt.pn * tstep : cB;
        for (int t = 0; t < nt; t += 2) {
            const bool last = (t == nt - 2);
            const char* a1 = cA + (size_t)(t + 1) * kstep;
            const char* a2 = last ? nA : cA + (size_t)(t + 2) * kstep; const char* b2 = last ? nB : cB + (size_t)(t + 2) * kstep;
            const char* a3 = a2 + kstep; const char* b3 = b2 + kstep;
            if (last && has_next) S.a_ready(nxt);
            if constexpr (SP2) {
            PG8_LDB(B0, 0, 0); PG8_LDB(B1, 0, 1); PG8_SCHED; PG8_LDA(At, 0, 0); PG8_STAGE(PG8_SA(1, 1), a1 + hstep, voffA);
            PG8_WAIT_V(8); PG8_WAIT_L(0); PG8_BAR; PG8_MMA(0, 0, At, B0); PG8_MMA(0, 1, At, B1); PG8_BAR; PG8_SCHED;
            PG8_LDA(At, 0, 1); PG8_STAGE(PG8_SB(0, 0), b2, voffB); PG8_STAGE(PG8_SB(0, 1), b2 + hstep, voffB); PG8_STAGE(PG8_SA(0, 0), a2, voffA);
            PG8_WAIT_V(8); PG8_WAIT_L(0); PG8_BAR; PG8_MMA(1, 0, At, B0); PG8_MMA(1, 1, At, B1); PG8_BAR; PG8_SCHED;
            PG8_LDB(B0, 1, 0); PG8_LDB(B1, 1, 1); PG8_SCHED; PG8_LDA(At, 1, 0); PG8_STAGE(PG8_SA(0, 1), a2 + hstep, voffA);
            PG8_WAIT_V(8); PG8_WAIT_L(0); PG8_BAR; PG8_MMA(0, 0, At, B0); PG8_MMA(0, 1, At, B1); PG8_BAR; PG8_SCHED;
            PG8_LDA(At, 1, 1); PG8_STAGE(PG8_SB(1, 0), b3, voffB); PG8_STAGE(PG8_SB(1, 1), b3 + hstep, voffB); PG8_STAGE(PG8_SA(1, 0), a3, voffA);
            PG8_WAIT_V(8); PG8_WAIT_L(0); PG8_BAR; PG8_MMA(1, 0, At, B0); PG8_MMA(1, 1, At, B1); PG8_BAR; PG8_SCHED;
            } else {
            PG8_LDB(B0, 0, 0); PG8_SCHED; PG8_LDA(At, 0, 0); PG8_STAGE(PG8_SA(1, 1), a1 + hstep, voffA);
            PG8_WAIT_L(8); PG8_BAR; PG8_WAIT_L(0); PG8_MMA(0, 0, At, B0); PG8_BAR; PG8_SCHED;
            PG8_LDB(B1, 0, 1); PG8_STAGE(PG8_SB(0, 0), b2, voffB);
            PG8_BAR; PG8_WAIT_L(0); PG8_MMA(0, 1, At, B1); PG8_BAR;
            PG8_LDA(At, 0, 1); PG8_STAGE(PG8_SA(0, 0), a2, voffA);
            PG8_BAR; PG8_WAIT_L(0); PG8_MMA(1, 0, At, B0); PG8_BAR; PG8_SCHED;
            PG8_STAGE(PG8_SB(0, 1), b2 + hstep, voffB);
            PG8_WAIT_V(6); PG8_BAR; PG8_MMA(1, 1, At, B1); PG8_BAR;
            PG8_LDB(B0, 1, 0); PG8_SCHED; PG8_LDA(At, 1, 0); PG8_STAGE(PG8_SA(0, 1), a2 + hstep, voffA);
            PG8_WAIT_L(8); PG8_BAR; PG8_WAIT_L(0); PG8_MMA(0, 0, At, B0); PG8_BAR; PG8_SCHED;
            PG8_LDB(B1, 1, 1); PG8_STAGE(PG8_SB(1, 0), b3, voffB);
            PG8_BAR; PG8_WAIT_L(0); PG8_MMA(0, 1, At, B1); PG8_BAR;
            PG8_LDA(At, 1, 1); PG8_STAGE(PG8_SA(1, 0), a3, voffA);
            PG8_BAR; PG8_WAIT_L(0); PG8_MMA(1, 0, At, B0); PG8_BAR; PG8_SCHED;
            PG8_STAGE(PG8_SB(1, 1), b3 + hstep, voffB);
            PG8_WAIT_V(6); PG8_BAR; PG8_MMA(1, 1, At, B1); PG8_BAR;
            }
        }
        if constexpr (ALIGN_EPI) { if (wr == 0) PG8_BAR; }
        if constexpr (!Epi::AFTER_DRAIN) { E(acc, cur, wr, wc, fr, fq); S.done(cur); }
        if (!has_next) break;
#pragma unroll
        for (int a = 0; a < 2; ++a)
#pragma unroll
            for (int b = 0; b < 2; ++b)
#pragma unroll
                for (int m = 0; m < 4; ++m)
#pragma unroll
                    for (int n = 0; n < 2; ++n) acc[a][b][m][n] = (f32x4){0.f, 0.f, 0.f, 0.f};
        cur = nxt; cA = nA; cB = nB; ++ui;
        if constexpr (ALIGN_EPI) { if (wr == 1) PG8_BAR; }
    }
    PG8_WAIT_V(0);
    if constexpr (!ALIGN_EPI) { if (wr == 0) PG8_BAR; }
    PG8_BAR;
    if constexpr (Epi::AFTER_DRAIN) { E.fused(acc, cur, wr, wc, fr, fq, lds, wid, lane); S.done(cur); }
#undef PG8_SA
#undef PG8_SB
#undef PG8_STAGE
#undef PG8_LDA
#undef PG8_LDB
#undef PG8_MMA
#undef PG8_WAIT_V
#undef PG8_WAIT_L
#undef PG8_BAR
#undef PG8_SCHED
}
}
#define DI __device__ __forceinline__
#define LAS __attribute__((address_space(3)))
typedef unsigned short bf16_t;
typedef short bf16x8 __attribute__((ext_vector_type(8)));
typedef float f32x4 __attribute__((ext_vector_type(4)));
typedef unsigned u32x4 __attribute__((ext_vector_type(4)));
typedef unsigned u32x2 __attribute__((ext_vector_type(2)));
typedef unsigned long long u64;
typedef unsigned long long u64x2 __attribute__((ext_vector_type(2)));

constexpr int NB = 8, SEQ = 4096, DM = 1024, CTX = 256, DFF = 2816, DIN = 2336, DINP = 2560, KSEQ = 4352, NCHUNK = 68;
constexpr int TX = NB * SEQ, TZ = NB * CTX, TT = TX + TZ;
constexpr float EPS = 1e-6f;
constexpr float QSCALE = 0.125f * 1.4426950408889634f;
constexpr float LOG2E = 1.4426950408889634f;
constexpr int C_FOUR = 0, C_NAQ = 256, C_NAK = 512, C_NAV = 768, C_GLQ = 1024, C_GLK = 1152, C_GLV = 1280, C_GLR = 1536, C_GF = 1792, C_GB = 1808, C_GQQ = 1824, C_GQK = 2080, C_GQV = 2208;
constexpr int C_GLQB = 768, C_GLKB = 896;

constexpr size_t MiB = 1u << 20;
constexpr size_t WS_W = 0;
constexpr size_t W_UP1 = 0, W_DN1 = 11 * MiB, W_IN = W_DN1 + 5 * MiB + MiB / 2, W_OUT = W_IN + 5 * MiB, W_UP2 = W_OUT + 2 * MiB, W_DN2 = W_UP2 + 11 * MiB, W_LAYER = 40 * MiB;
constexpr size_t WS_MOD = 80 * MiB;
constexpr size_t WS_TAB = 81 * MiB;
constexpr size_t T_FC64 = 0, T_FS64 = 8192, T_FSN64 = 16384, T_TW = 32768, T_ROPE = 65536, T_FC256 = 131072, T_FS256 = 262144, T_FSN256 = 393216;
constexpr size_t WS_Z = 82 * MiB;
constexpr size_t WS_HN = 90 * MiB;
constexpr size_t WS_HB = 158 * MiB;
constexpr size_t WS_NAVT = 345 * MiB;
constexpr size_t WS_GVT = WS_NAVT + 17 * MiB;
constexpr size_t WS_GLVT = WS_GVT + 9 * MiB;
constexpr size_t WS_KKT = WS_GLVT + 17 * MiB;
constexpr size_t WS_SLOC = WS_KKT + 17 * MiB;
constexpr size_t WS_SST = WS_SLOC + 34 * MiB;
constexpr size_t WS_TTR = WS_SST + 17 * MiB;
constexpr size_t WS_TTI = WS_TTR + 16 * MiB;
constexpr size_t WS_BLAST = WS_TTI + 16 * MiB;
constexpr size_t WS_END = WS_BLAST + 1 * MiB;
static_assert(WS_END <= 512 * MiB, "workspace map");
static_assert(WS_HB + (size_t)TT * DFF * 2 <= WS_NAVT && WS_HN + (size_t)TT * DM * 2 <= WS_HB, "workspace map 2");
constexpr int LDS_BYTES = 147456;

struct Params { const float* in[24]; float* out; unsigned char* ws; };

DI float bf2f(bf16_t h) { return __uint_as_float(((unsigned)h) << 16); }
DI unsigned pk2(float lo, float hi) { return pg8::cvt_pk_bf16(lo, hi); }
DI bf16_t f2bf(float f) { return (bf16_t)(pk2(f, 0.f) & 0xffffu); }
DI bf16x8 ld16(const bf16_t* p) { return *(const bf16x8*)p; }
DI u64 ld8(const bf16_t* p) { return *(const u64*)p; }
DI bf16x8 cat8(u64 a, u64 b) { u64x2 v = {a, b}; return __builtin_bit_cast(bf16x8, v); }
DI bf16x8 pack8(const f32x4& a, const f32x4& b) { u32x4 w; w.x = pk2(a[0], a[1]); w.y = pk2(a[2], a[3]); w.z = pk2(b[0], b[1]); w.w = pk2(b[2], b[3]); return __builtin_bit_cast(bf16x8, w); }
DI bf16x8 neg8(bf16x8 v) { u32x4 w = __builtin_bit_cast(u32x4, v); w ^= 0x80008000u; return __builtin_bit_cast(bf16x8, w); }
#define MFMA16(a, b, c) __builtin_amdgcn_mfma_f32_16x16x32_bf16((a), (b), (c), 0, 0, 0)
DI float quad_sum(float v) { v += __shfl_xor(v, 16); v += __shfl_xor(v, 32); return v; }
DI float quad_max(float v) { v = fmaxf(v, __shfl_xor(v, 16)); v = fmaxf(v, __shfl_xor(v, 32)); return v; }

DI void transpose_item(const float* W, int K, int N, bf16_t* WT, int mode, LAS float* scr, int item, int lane) {
    const int nblk = N / 32, kb = item / nblk, nb = item % nblk, k0 = 64 * kb, n0 = 32 * nb;
#pragma unroll 8
    for (int i = 0; i < 32; ++i) { const int kk = 2 * i + (lane >> 5); scr[kk * 33 + (lane & 31)] = W[(size_t)(k0 + kk) * N + n0 + (lane & 31)]; }
    asm volatile("s_waitcnt lgkmcnt(0)" ::: "memory");
    const int c = lane & 7;
    const int d0 = (mode == 0) ? n0 : ((n0 >> 7) * 256 + (n0 & 127) + (mode == 2 ? 128 : 0));
#pragma unroll
    for (int j = 0; j < 4; ++j) { const int n = (lane >> 3) + 8 * j; const LAS float* s = scr + (8 * c) * 33 + n;
        u32x4 o; o.x = pk2(s[0 * 33], s[1 * 33]); o.y = pk2(s[2 * 33], s[3 * 33]); o.z = pk2(s[4 * 33], s[5 * 33]); o.w = pk2(s[6 * 33], s[7 * 33]);
        *(u32x4*)(WT + (size_t)(d0 + n) * K + k0 + 8 * c) = o; }
    asm volatile("s_waitcnt lgkmcnt(0)" ::: "memory");
}

DI void phase_prologue(const Params& p, LAS unsigned char* lds, int tid, int lane, int wave, int bid, int G) {
    const int gw = bid * 8 + wave, NGW = G * 8;
    unsigned char* ws = p.ws;
    {
        LAS float* scr = (LAS float*)(lds + wave * 8704);
        constexpr int I_UP = 16 * 88, I_DN = 44 * 32, I_IN = 16 * 73, I_OUT = 16 * 32;
        constexpr int PER_L = 4 * I_UP + 2 * I_DN + I_IN + I_OUT;
        for (int it = gw; it < 2 * PER_L; it += NGW) {
            const int l = it / PER_L; int r = it % PER_L;
            bf16_t* wl = (bf16_t*)(ws + WS_W + (size_t)l * W_LAYER);
            if (r < I_UP) { transpose_item(p.in[6] + (size_t)l * DM * DFF, DM, DFF, (bf16_t*)((unsigned char*)wl + W_UP1), 1, scr, r, lane); continue; } r -= I_UP;
            if (r < I_UP) { transpose_item(p.in[7] + (size_t)l * DM * DFF, DM, DFF, (bf16_t*)((unsigned char*)wl + W_UP1), 2, scr, r, lane); continue; } r -= I_UP;
            if (r < I_DN) { transpose_item(p.in[8] + (size_t)l * DM * DFF, DFF, DM, (bf16_t*)((unsigned char*)wl + W_DN1), 0, scr, r, lane); continue; } r -= I_DN;
            if (r < I_IN) { transpose_item(p.in[9] + (size_t)l * DM * DIN, DM, DIN, (bf16_t*)((unsigned char*)wl + W_IN), 0, scr, r, lane); continue; } r -= I_IN;
            if (r < I_OUT) { transpose_item(p.in[20] + (size_t)l * DM * DM, DM, DM, (bf16_t*)((unsigned char*)wl + W_OUT), 0, scr, r, lane); continue; } r -= I_OUT;
            if (r < I_UP) { transpose_item(p.in[21] + (size_t)l * DM * DFF, DM, DFF, (bf16_t*)((unsigned char*)wl + W_UP2), 1, scr, r, lane); continue; } r -= I_UP;
            if (r < I_UP) { transpose_item(p.in[22] + (size_t)l * DM * DFF, DM, DFF, (bf16_t*)((unsigned char*)wl + W_UP2), 2, scr, r, lane); continue; } r -= I_UP;
            transpose_item(p.in[23] + (size_t)l * DM * DFF, DFF, DM, (bf16_t*)((unsigned char*)wl + W_DN2), 0, scr, r, lane);
        }
        const int gt = bid * 512 + tid, NT = G * 512;
        for (int i = gt; i < 2 * (DINP - DIN) * DM / 8; i += NT) { const int l = i / ((DINP - DIN) * DM / 8), r = i % ((DINP - DIN) * DM / 8);
            *(u32x4*)((bf16_t*)(ws + WS_W + (size_t)l * W_LAYER + W_IN) + (size_t)DIN * DM + (size_t)r * 8) = (u32x4){0u, 0u, 0u, 0u}; }
        unsigned char* tab = ws + WS_TAB;
        for (int i = gt; i < 4096; i += NT) { const int a = i >> 6, b = i & 63; const float x = (float)((a * b) & 63) * (1.0f / 32.0f);
            const float c = cospif(x), s = sinpif(x);
            ((bf16_t*)(tab + T_FC64))[i] = f2bf(c); ((bf16_t*)(tab + T_FS64))[i] = f2bf(s); ((bf16_t*)(tab + T_FSN64))[i] = f2bf(-s);
            const float y = (float)(a * b) * (1.0f / 2048.0f);
            ((float*)(tab + T_TW))[2 * i] = cospif(y); ((float*)(tab + T_TW))[2 * i + 1] = sinpif(y); }
        for (int i = gt; i < 65536; i += NT) { const int a = i >> 8, b = i & 255; const float x = (float)((a * b) & 255) * (1.0f / 128.0f);
            const float c = cospif(x), s = sinpif(x);
            ((bf16_t*)(tab + T_FC256))[i] = f2bf(c); ((bf16_t*)(tab + T_FS256))[i] = f2bf(s); ((bf16_t*)(tab + T_FSN256))[i] = f2bf(-s); }
        for (int i = gt; i < 1024; i += NT) { const int pp = i >> 4, f = i & 15; const float inv = powf(10000.0f, -(float)f / 16.0f); const float ang = (float)pp * inv;
            ((float*)(tab + T_ROPE))[2 * i] = cosf(ang); ((float*)(tab + T_ROPE))[2 * i + 1] = sinf(ang); }
    }
    __syncthreads();
    {
        LAS float* S = (LAS float*)lds;
        LAS float* red = (LAS float*)(lds + 9 * 1024 * 4);
        for (int i = tid; i < 9 * 1024; i += 512) { const int r = i >> 10, k = i & 1023; const float v = (r < 8) ? p.in[1][r * 1024 + k] : p.in[3][k]; S[i] = v / (1.0f + __expf(-v)); }
        __syncthreads();
        for (int it = bid; it < 2 * 144; it += G) {
            const int l = it / 144, nb = it % 144, n = nb * 64 + lane;
            const float* W = p.in[4] + (size_t)l * DM * 9216 + n;
            float acc[9];
#pragma unroll
            for (int r = 0; r < 9; ++r) acc[r] = 0.f;
            const int kbeg = wave * 128;
#pragma unroll 8
            for (int k = 0; k < 128; ++k) { const float w = W[(size_t)(kbeg + k) * 9216];
#pragma unroll
                for (int r = 0; r < 9; ++r) acc[r] += S[r * 1024 + kbeg + k] * w; }
#pragma unroll
            for (int r = 0; r < 9; ++r) red[(wave * 9 + r) * 64 + lane] = acc[r];
            __syncthreads();
            for (int i = tid; i < 9 * 64; i += 512) { const int r = i >> 6, c = i & 63; float s = 0.f;
#pragma unroll
                for (int w = 0; w < 8; ++w) s += red[(w * 9 + r) * 64 + c];
                const int nn = nb * 64 + c;
                ((float*)(ws + WS_MOD))[((size_t)l * 9 + r) * 9216 + nn] = s + p.in[5][(size_t)l * 9216 + nn]; }
            __syncthreads();
        }
    }
}

DI void norm_pass(const float* xx, const float* xz, const float* mod  , int ishift, int iscale, bf16_t* HN, int nrows, int gw, int NGW, int lane) {
    for (int row = gw; row < nrows; row += NGW) {
        const bool isx = row < TX; const int mi = isx ? (row >> 12) : 8;
        const float* src = isx ? xx + (size_t)row * DM : xz + (size_t)(row - TX) * DM;
        const float* sh = mod + (size_t)mi * 9216 + ishift * 1024; const float* sc = mod + (size_t)mi * 9216 + iscale * 1024;
        f32x4 v[4]; float ss = 0.f;
#pragma unroll
        for (int j = 0; j < 4; ++j) { v[j] = *(const f32x4*)(src + 4 * lane + 256 * j); ss += (v[j][0] * v[j][0] + v[j][1] * v[j][1]) + (v[j][2] * v[j][2] + v[j][3] * v[j][3]); }
#pragma unroll
        for (int o = 1; o < 64; o <<= 1) ss += __shfl_xor(ss, o);
        const float rstd = rsqrtf(ss * (1.0f / DM) + EPS);
#pragma unroll
        for (int j = 0; j < 4; ++j) { const f32x4 a = *(const f32x4*)(sc + 4 * lane + 256 * j), b = *(const f32x4*)(sh + 4 * lane + 256 * j);
            const f32x4 y = v[j] * rstd * (a + 1.0f) + b; u32x2 w; w.x = pk2(y[0], y[1]); w.y = pk2(y[2], y[3]);
            *(u32x2*)(HN + (size_t)row * DM + 4 * lane + 256 * j) = w; }
    }
}

DI float log_sigmoid(float x) { return fminf(x, 0.f) - log1pf(__expf(-fabsf(x))); }

DI void prep_tile(const Params& p, int l, int tile, LAS unsigned char* lds, int tid) {
    unsigned char* ws = p.ws;
    bf16_t* HX = (bf16_t*)(ws + WS_HB);
    int b, row0, pos0, gr; bool isx;
    if (tile < 512) { b = tile >> 6; gr = tile & 63; row0 = b * SEQ + 64 * gr; pos0 = 64 * gr; isx = true; }
    else { const int tz = tile - 512; b = tz >> 2; gr = tz & 3; row0 = TX + b * CTX + 64 * gr; pos0 = SEQ + 64 * gr; isx = false; }
    const float* rope = (const float*)(ws + WS_TAB + T_ROPE);
    {
        const int li = tid & 15, jg = tid >> 4;
        for (int it = 0; it < 28; ++it) {
            const int job = it * 32 + jg, t = job / 14, v = job % 14;
            int col; const float* gain; float scale = 1.0f; bool rp = false;
            if (v < 4) { col = C_NAQ + 64 * v; gain = p.in[10] + l * 64; scale = QSCALE; }
            else if (v < 8) { col = C_NAK + 64 * (v - 4); gain = p.in[11] + l * 64; }
            else if (v < 12) { col = C_GQQ + 64 * (v - 8); gain = p.in[18] + l * 64; scale = QSCALE; rp = isx; }
            else { col = C_GQK + 64 * (v - 12); gain = p.in[19] + l * 64; rp = isx; }
            bf16_t* ptr = HX + (size_t)(row0 + t) * DINP + col + 4 * li;
            const u32x2 raw = *(const u32x2*)ptr;
            float x[4] = {__uint_as_float(raw.x << 16), __uint_as_float(raw.x & 0xffff0000u), __uint_as_float(raw.y << 16), __uint_as_float(raw.y & 0xffff0000u)};
            float ss = (x[0] * x[0] + x[1] * x[1]) + (x[2] * x[2] + x[3] * x[3]);
            ss += __shfl_xor(ss, 1); ss += __shfl_xor(ss, 2); ss += __shfl_xor(ss, 4); ss += __shfl_xor(ss, 8);
            const float rstd = rsqrtf(ss * (1.0f / 64.0f) + EPS);
            const f32x4 g = *(const f32x4*)(gain + 4 * li);
            float y[4];
#pragma unroll
            for (int j = 0; j < 4; ++j) y[j] = x[j] * rstd * g[j];
            float o[4];
#pragma unroll
            for (int j = 0; j < 4; ++j) { const float partner = __shfl_xor(y[j], 8);
                if (rp) { const int d = 4 * li + j, i = d & 31; const int pp = (i < 16) ? gr : t, f = i & 15;
                    const float c = rope[2 * (pp * 16 + f)], s = rope[2 * (pp * 16 + f) + 1];
                    o[j] = (li < 8) ? (y[j] * c - partner * s) : (partner * s + y[j] * c); }
                else o[j] = y[j];
                o[j] *= scale; }
            u32x2 w; w.x = pk2(o[0], o[1]); w.y = pk2(o[2], o[3]);
            *(u32x2*)ptr = w;
        }
    }
    {
        for (int job = tid; job < 640 * 8; job += 512) {
            const int cc = job % 640, tg = job / 640;
            int col; bf16_t* dst;
            if (cc < 256) { col = C_NAV + cc; dst = (bf16_t*)(ws + WS_NAVT) + ((size_t)(b * 256 + cc)) * KSEQ; }
            else if (cc < 384) { col = C_GQV + (cc - 256); dst = (bf16_t*)(ws + WS_GVT) + ((size_t)(b * 128 + (cc - 256))) * KSEQ; }
            else { col = C_GLV + (cc - 384); dst = (bf16_t*)(ws + WS_GLVT) + ((size_t)(b * 256 + (cc - 384))) * KSEQ; }
            const bf16_t* src = HX + (size_t)(row0 + 8 * tg) * DINP + col;
            unsigned h[8];
#pragma unroll
            for (int i = 0; i < 8; ++i) h[i] = src[(size_t)i * DINP];
            u32x4 w; w.x = h[0] | (h[1] << 16); w.y = h[2] | (h[3] << 16); w.z = h[4] | (h[5] << 16); w.w = h[6] | (h[7] << 16);
            *(u32x4*)(dst + pos0 + 8 * tg) = w;
        }
    }
    LAS float* A = (LAS float*)lds;
    {
        const int colid = tid & 255, half = tid >> 8, dir = colid >> 7, hd = colid & 127;
        const float* wg = (dir == 0 ? p.in[13] : p.in[15]) + l * 16 * 128 + hd;
        const float bg = (dir == 0 ? p.in[14] : p.in[16])[l * 128 + hd];
        float w[16];
#pragma unroll
        for (int r = 0; r < 16; ++r) w[r] = wg[r * 128];
        for (int t = half * 32; t < half * 32 + 32; ++t) {
            const bf16_t* gp = HX + (size_t)(row0 + t) * DINP + (dir == 0 ? C_GF : C_GB);
            const bf16x8 g0 = ld16(gp), g1 = ld16(gp + 8);
            float acc = bg;
#pragma unroll
            for (int r = 0; r < 8; ++r) { acc += bf2f((bf16_t)g0[r]) * w[r]; acc += bf2f((bf16_t)g1[r]) * w[8 + r]; }
            A[(dir * 64 + t) * 128 + hd] = log_sigmoid(acc) * (1.0f / 16.0f);
        }
    }
    __syncthreads();
    if (tid < 256) {
        const int dir = tid >> 7, hd = tid & 127; float s = 0.f;
        if (dir == 0) { for (int t = 0; t < 64; ++t) { s += A[t * 128 + hd]; A[t * 128 + hd] = s; } }
        else { for (int t = 63; t >= 0; --t) { s += A[(64 + t) * 128 + hd]; A[(64 + t) * 128 + hd] = s; } }
        ((float*)(ws + WS_BLAST))[(((size_t)b * NCHUNK + (pos0 >> 6)) * 2 + dir) * 128 + hd] = s;
    }
    __syncthreads();
    {
        for (int job = tid; job < 2048; job += 512) {
            const int hd = job & 127, tg = (job >> 7) & 7, dir = job >> 10;
            const float bl = A[(dir * 64 + (dir == 0 ? 63 : 0)) * 128 + hd];
            const bf16_t* src = HX + (size_t)(row0 + 8 * tg) * DINP + C_GLK + hd;
            unsigned h[8];
#pragma unroll
            for (int i = 0; i < 8; ++i) { const float k = bf2f(src[(size_t)i * DINP]); h[i] = f2bf(k * __expf(bl - A[(dir * 64 + 8 * tg + i) * 128 + hd])); }
            u32x4 w; w.x = h[0] | (h[1] << 16); w.y = h[2] | (h[3] << 16); w.z = h[4] | (h[5] << 16); w.w = h[6] | (h[7] << 16);
            *(u32x4*)((bf16_t*)(ws + WS_KKT) + ((size_t)(dir * NB + b) * 128 + hd) * KSEQ + pos0 + 8 * tg) = w;
        }
    }
    __syncthreads();
    {
        const float qs = 0.17677669529663687f;
        for (int e = tid; e < 64 * 64; e += 512) {
            const int t = e >> 6, hp = (e & 63) * 2;
            bf16_t* rowp = HX + (size_t)(row0 + t) * DINP;
            const unsigned qraw = *(const unsigned*)(rowp + C_GLQ + hp), kraw = *(const unsigned*)(rowp + C_GLK + hp);
            const float q0 = __uint_as_float(qraw << 16), q1 = __uint_as_float(qraw & 0xffff0000u), k0 = __uint_as_float(kraw << 16), k1 = __uint_as_float(kraw & 0xffff0000u);
            const float bf0 = A[t * 128 + hp], bf1 = A[t * 128 + hp + 1], bb0 = A[(64 + t) * 128 + hp], bb1 = A[(64 + t) * 128 + hp + 1];
            *(unsigned*)(rowp + C_GLQ + hp) = pk2(q0 * qs * __expf(bf0), q1 * qs * __expf(bf1));
            *(unsigned*)(rowp + C_GLK + hp) = pk2(k0 * __expf(-bf0), k1 * __expf(-bf1));
            *(unsigned*)(rowp + C_GLQB + hp) = pk2(q0 * qs * __expf(bb0), q1 * qs * __expf(bb1));
            *(unsigned*)(rowp + C_GLKB + hp) = pk2(k0 * __expf(-bb0), k1 * __expf(-bb1));
        }
    }
    __syncthreads();
}

template <int NG> struct AttnState { float m[NG], l[NG]; f32x4 o[NG][4]; bf16x8 q[NG][2]; };

template <int NG> DI void attn_init(AttnState<NG>& st) {
#pragma unroll
    for (int g = 0; g < NG; ++g) { st.m[g] = -1e30f; st.l[g] = 0.f;
#pragma unroll
        for (int d = 0; d < 4; ++d) st.o[g][d] = (f32x4){0.f, 0.f, 0.f, 0.f}; }
}
template <int NG, bool BIAS> DI void attn_block(AttnState<NG>& st, const bf16_t* kp0, const bf16_t* kp1, const bf16_t* vp0, const bf16_t* vp1, const f32x4& bias0, const f32x4& bias1) {
    const bf16x8 k00 = ld16(kp0), k01 = ld16(kp0 + 32), k10 = ld16(kp1), k11 = ld16(kp1 + 32);
    u64 v0[4], v1[4];
#pragma unroll
    for (int d = 0; d < 4; ++d) { v0[d] = ld8(vp0 + (size_t)d * 16 * KSEQ); v1[d] = ld8(vp1 + (size_t)d * 16 * KSEQ); }
#pragma unroll
    for (int g = 0; g < NG; ++g) {
        f32x4 s0 = MFMA16(k00, st.q[g][0], ((f32x4){0.f, 0.f, 0.f, 0.f})); s0 = MFMA16(k01, st.q[g][1], s0);
        f32x4 s1 = MFMA16(k10, st.q[g][0], ((f32x4){0.f, 0.f, 0.f, 0.f})); s1 = MFMA16(k11, st.q[g][1], s1);
        if (BIAS) { s0 += bias0; s1 += bias1; }
        float mx = fmaxf(fmaxf(fmaxf(s0[0], s0[1]), fmaxf(s0[2], s0[3])), fmaxf(fmaxf(s1[0], s1[1]), fmaxf(s1[2], s1[3])));
        mx = quad_max(mx);
        const float mn = fmaxf(st.m[g], mx), corr = __builtin_amdgcn_exp2f(st.m[g] - mn); st.m[g] = mn;
        f32x4 p0, p1;
#pragma unroll
        for (int j = 0; j < 4; ++j) { p0[j] = __builtin_amdgcn_exp2f(s0[j] - mn); p1[j] = __builtin_amdgcn_exp2f(s1[j] - mn); }
        st.l[g] = st.l[g] * corr + ((p0[0] + p0[1]) + (p0[2] + p0[3])) + ((p1[0] + p1[1]) + (p1[2] + p1[3]));
        const bf16x8 pf = pack8(p0, p1);
#pragma unroll
        for (int d = 0; d < 4; ++d) { st.o[g][d] = st.o[g][d] * corr; st.o[g][d] = MFMA16(cat8(v0[d], v1[d]), pf, st.o[g][d]); }
    }
}
template <int NG> DI void attn_run(AttnState<NG>& st, const bf16_t* kl, size_t kpitch, const bf16_t* vl, int nblk) {
    const f32x4 z = {0.f, 0.f, 0.f, 0.f};
#pragma unroll 2
    for (int i = 0; i < nblk; ++i) { const bf16_t* kp0 = kl + (size_t)(32 * i) * kpitch; attn_block<NG, false>(st, kp0, kp0 + 16 * kpitch, vl + 32 * i, vl + 32 * i + 16, z, z); }
}
template <int NG> DI void attn_finish(AttnState<NG>& st, bf16_t* orow  , int hstride, int quad) {
#pragma unroll
    for (int g = 0; g < NG; ++g) { const float inv = 1.0f / quad_sum(st.l[g]);
#pragma unroll
        for (int d = 0; d < 4; ++d) { const f32x4 o = st.o[g][d] * inv; u32x2 w; w.x = pk2(o[0], o[1]); w.y = pk2(o[2], o[3]);
            *(u32x2*)(orow + g * hstride + 16 * d + 4 * quad) = w; } }
}

DI void gqa_unit_x(unsigned char* ws, int u, int lane) {
    const int c16 = lane & 15, quad = lane >> 4;
    const int qb = u & 255, kvh = (u >> 8) & 1, b = u >> 9;
    const bf16_t* HX = (const bf16_t*)(ws + WS_HB); bf16_t* MIX = (bf16_t*)(ws + WS_HN);
    const size_t qrow = (size_t)b * SEQ + 16 * qb + c16;
    AttnState<2> st; attn_init(st);
#pragma unroll
    for (int g = 0; g < 2; ++g) { const bf16_t* qp = HX + qrow * DINP + C_GQQ + (2 * kvh + g) * 64 + quad * 8; st.q[g][0] = ld16(qp); st.q[g][1] = ld16(qp + 32); }
    const bf16_t* vt = (const bf16_t*)(ws + WS_GVT) + ((size_t)(b * 2 + kvh) * 64 + c16) * KSEQ + quad * 4;
    attn_run<2>(st, HX + ((size_t)b * SEQ + c16) * DINP + C_GQK + kvh * 64 + quad * 8, DINP, vt, SEQ / 32);
    attn_run<2>(st, HX + ((size_t)TX + b * CTX + c16) * DINP + C_GQK + kvh * 64 + quad * 8, DINP, vt + SEQ, CTX / 32);
    attn_finish<2>(st, MIX + qrow * DM + 768 + (2 * kvh) * 64, 64, quad);
}
DI void gqa_unit_z(unsigned char* ws, int u, int lane) {
    const int c16 = lane & 15, quad = lane >> 4;
    const int qb = u & 15, kvh = (u >> 4) & 1, b = u >> 5;
    const bf16_t* HX = (const bf16_t*)(ws + WS_HB); bf16_t* MIX = (bf16_t*)(ws + WS_HN);
    const size_t qrow = (size_t)TX + b * CTX + 16 * qb + c16;
    AttnState<2> st; attn_init(st);
#pragma unroll
    for (int g = 0; g < 2; ++g) { const bf16_t* qp = HX + qrow * DINP + C_GQQ + (2 * kvh + g) * 64 + quad * 8; st.q[g][0] = ld16(qp); st.q[g][1] = ld16(qp + 32); }
    const bf16_t* vt = (const bf16_t*)(ws + WS_GVT) + ((size_t)(b * 2 + kvh) * 64 + c16) * KSEQ + quad * 4;
    attn_run<2>(st, HX + ((size_t)TX + b * CTX + c16) * DINP + C_GQK + kvh * 64 + quad * 8, DINP, vt + SEQ, CTX / 32);
    attn_finish<2>(st, MIX + qrow * DM + 768 + (2 * kvh) * 64, 64, quad);
}
DI void na_unit_z(unsigned char* ws, int u, int lane) {
    const int c16 = lane & 15, quad = lane >> 4;
    const int qb = u & 15, h = (u >> 4) & 3, b = u >> 6;
    const bf16_t* HX = (const bf16_t*)(ws + WS_HB); bf16_t* MIX = (bf16_t*)(ws + WS_HN);
    const size_t qrow = (size_t)TX + b * CTX + 16 * qb + c16;
    AttnState<1> st; attn_init(st);
    { const bf16_t* qp = HX + qrow * DINP + C_NAQ + h * 64 + quad * 8; st.q[0][0] = ld16(qp); st.q[0][1] = ld16(qp + 32); }
    const bf16_t* vt = (const bf16_t*)(ws + WS_NAVT) + ((size_t)(b * 4 + h) * 64 + c16) * KSEQ + quad * 4;
    attn_run<1>(st, HX + ((size_t)TX + b * CTX + c16) * DINP + C_NAK + h * 64 + quad * 8, DINP, vt + SEQ, CTX / 32);
    attn_finish<1>(st, MIX + qrow * DM + 256 + h * 64, 64, quad);
}
DI void na_unit_x(const Params& p, int l, int u, int lane) {
    unsigned char* ws = p.ws;
    const int c16 = lane & 15, quad = lane >> 4;
    const int cb = u & 3, r = (u >> 2) & 63, h = (u >> 8) & 3, b = u >> 10;
    const bf16_t* HX = (const bf16_t*)(ws + WS_HB); bf16_t* MIX = (bf16_t*)(ws + WS_HN);
    const int c = 16 * cb + c16;
    const size_t qrow = (size_t)b * SEQ + 64 * r + c;
    AttnState<1> st; attn_init(st);
    { const bf16_t* qp = HX + qrow * DINP + C_NAQ + h * 64 + quad * 8; st.q[0][0] = ld16(qp); st.q[0][1] = ld16(qp + 32); }
    const bf16_t* vt = (const bf16_t*)(ws + WS_NAVT) + ((size_t)(b * 4 + h) * 64 + c16) * KSEQ + quad * 4;
    const int rs = min(max(r - 4, 0), 56), cbase = min(max(16 * cb - 8, 0), 32), cs = min(max(c - 8, 0), 48);
    const float* rpb = p.in[12] + (size_t)(l * 4 + h) * 15 * 31;
#pragma unroll 2
    for (int wr = 0; wr < 8; ++wr) {
        const int krow = rs + wr, t0 = krow * 64 + cbase;
        const float* bp = rpb + (krow - r + 7) * 31;
        f32x4 b0, b1;
#pragma unroll
        for (int j = 0; j < 4; ++j) { const int kc0 = cbase + 4 * quad + j, kc1 = kc0 + 16;
            const bool ok0 = (kc0 >= cs) && (kc0 < cs + 16), ok1 = (kc1 >= cs) && (kc1 < cs + 16);
            b0[j] = ok0 ? bp[kc0 - c + 15] * LOG2E : -1e30f; b1[j] = ok1 ? bp[kc1 - c + 15] * LOG2E : -1e30f; }
        const bf16_t* kp0 = HX + ((size_t)b * SEQ + t0 + c16) * DINP + C_NAK + h * 64 + quad * 8;
        attn_block<1, true>(st, kp0, kp0 + (size_t)16 * DINP, vt + t0, vt + t0 + 16, b0, b1);
    }
    attn_run<1>(st, HX + ((size_t)TX + b * CTX + c16) * DINP + C_NAK + h * 64 + quad * 8, DINP, vt + SEQ, CTX / 32);
    attn_finish<1>(st, MIX + qrow * DM + 256 + h * 64, 64, quad);
}

DI int chunk_row0(int b, int pc) { return pc < 64 ? b * SEQ + 64 * pc : TX + b * CTX + 64 * (pc - 64); }
DI void gla_local_unit(unsigned char* ws, int u, int lane) {
    const int c16 = lane & 15, quad = lane >> 4;
    const int pc = u % NCHUNK; const int seq = u / NCHUNK; const int dir = seq & 1, h = (seq >> 1) & 3, b = seq >> 3;
    const bf16_t* vt = (const bf16_t*)(ws + WS_GLVT) + ((size_t)(b * 4 + h) * 64 + c16) * KSEQ + 64 * pc + quad * 8;
    const bf16_t* kt = (const bf16_t*)(ws + WS_KKT) + ((size_t)((dir * NB + b) * 4 + h) * 32 + c16) * KSEQ + 64 * pc + quad * 8;
    bf16x8 kf[2][2];
#pragma unroll
    for (int db = 0; db < 2; ++db)
#pragma unroll
        for (int ks = 0; ks < 2; ++ks) kf[db][ks] = ld16(kt + (size_t)db * 16 * KSEQ + 32 * ks);
    float* dst = (float*)(ws + WS_SLOC) + ((size_t)seq * NCHUNK + pc) * 2048;
#pragma unroll
    for (int eb = 0; eb < 4; ++eb) { const bf16x8 a0 = ld16(vt + (size_t)eb * 16 * KSEQ), a1 = ld16(vt + (size_t)eb * 16 * KSEQ + 32);
#pragma unroll
        for (int db = 0; db < 2; ++db) { f32x4 acc = MFMA16(a0, kf[db][0], ((f32x4){0.f, 0.f, 0.f, 0.f})); acc = MFMA16(a1, kf[db][1], acc);
#pragma unroll
            for (int j = 0; j < 4; ++j) dst[(16 * eb + 4 * quad + j) * 32 + 16 * db + c16] = acc[j]; } }
}
DI void gla_scan(unsigned char* ws, int gt, int NT) {
    const float* sloc = (const float*)(ws + WS_SLOC); bf16_t* sst = (bf16_t*)(ws + WS_SST); const float* blast = (const float*)(ws + WS_BLAST);
    for (int idx = gt; idx < 64 * 2048; idx += NT) {
        const int el = idx & 2047, seq = idx >> 11, d = el & 31, dir = seq & 1, h = (seq >> 1) & 3, b = seq >> 3;
        float S = 0.f;
        for (int s0 = 0; s0 < NCHUNK; s0 += 17) {
            float lv[17], dv[17];
#pragma unroll
            for (int i = 0; i < 17; ++i) { const int s = s0 + i; const int pc = (dir == 0) ? (s < 4 ? 64 + s : s - 4) : (s < 4 ? 67 - s : 67 - s);
                lv[i] = sloc[((size_t)seq * NCHUNK + pc) * 2048 + el]; dv[i] = blast[(((size_t)b * NCHUNK + pc) * 2 + dir) * 128 + h * 32 + d]; }
#pragma unroll
            for (int i = 0; i < 17; ++i) { const int s = s0 + i; const int pc = (dir == 0) ? (s < 4 ? 64 + s : s - 4) : (s < 4 ? 67 - s : 67 - s);
                sst[((size_t)seq * NCHUNK + pc) * 2048 + el] = f2bf(S); S = __expf(dv[i]) * S + lv[i]; }
        }
    }
}
DI void gla_out_unit(const Params& p, int l, int u, int lane) {
    unsigned char* ws = p.ws;
    const int c16 = lane & 15, quad = lane >> 4;
    const int ib = u & 3, pc = (u >> 2) % NCHUNK, bh = (u >> 2) / NCHUNK, h = bh & 3, b = bh >> 2;
    const bf16_t* HX = (const bf16_t*)(ws + WS_HB); bf16_t* MIX = (bf16_t*)(ws + WS_HN);
    const int row0 = chunk_row0(b, pc);
    const bf16_t* vt = (const bf16_t*)(ws + WS_GLVT) + ((size_t)(b * 4 + h) * 64 + c16) * KSEQ + 64 * pc + quad * 4;
    f32x4 o[4];
#pragma unroll
    for (int e = 0; e < 4; ++e) o[e] = (f32x4){0.f, 0.f, 0.f, 0.f};
    const int i_tok = 16 * ib + c16;
#pragma unroll
    for (int dir = 0; dir < 2; ++dir) {
        const int qc = (dir == 0 ? C_GLQ : C_GLQB) + h * 32, kc = (dir == 0 ? C_GLK : C_GLKB) + h * 32;
        const bf16x8 qf = ld16(HX + (size_t)(row0 + i_tok) * DINP + qc + quad * 8);
        const bf16_t* sp = (const bf16_t*)(ws + WS_SST) + ((size_t)((b * 4 + h) * 2 + dir) * NCHUNK + pc) * 2048 + c16 * 32 + quad * 8;
#pragma unroll
        for (int e = 0; e < 4; ++e) o[e] = MFMA16(ld16(sp + e * 16 * 32), qf, o[e]);
#pragma unroll
        for (int pr = 0; pr < 2; ++pr) {
            f32x4 s[2];
#pragma unroll
            for (int sb = 0; sb < 2; ++sb) { const int jb = 2 * pr + sb;
                const bf16x8 kf = ld16(HX + (size_t)(row0 + 16 * jb + c16) * DINP + kc + quad * 8);
                s[sb] = MFMA16(kf, qf, ((f32x4){0.f, 0.f, 0.f, 0.f}));
#pragma unroll
                for (int j = 0; j < 4; ++j) { const int jt = 16 * jb + 4 * quad + j; const bool keep = (dir == 0) ? (jt <= i_tok) : (jt >= i_tok); s[sb][j] = keep ? s[sb][j] : 0.f; } }
            const bf16x8 pf = pack8(s[0], s[1]);
#pragma unroll
            for (int e = 0; e < 4; ++e) o[e] = MFMA16(cat8(ld8(vt + (size_t)e * 16 * KSEQ + 32 * pr), ld8(vt + (size_t)e * 16 * KSEQ + 32 * pr + 16)), pf, o[e]);
        }
    }
    float ss = 0.f;
#pragma unroll
    for (int e = 0; e < 4; ++e) ss += (o[e][0] * o[e][0] + o[e][1] * o[e][1]) + (o[e][2] * o[e][2] + o[e][3] * o[e][3]);
    ss = quad_sum(ss);
    const float rstd = rsqrtf(ss * (1.0f / 64.0f) + EPS);
    const float* gain = p.in[17] + l * 64;
    const size_t row = (size_t)row0 + i_tok;
#pragma unroll
    for (int e = 0; e < 4; ++e) { const int ec = 16 * e + 4 * quad;
        const u32x2 rr = *(const u32x2*)(HX + row * DINP + C_GLR + h * 64 + ec); const f32x4 g = *(const f32x4*)(gain + ec);
        const float r0 = __uint_as_float(rr.x << 16), r1 = __uint_as_float(rr.x & 0xffff0000u), r2 = __uint_as_float(rr.y << 16), r3 = __uint_as_float(rr.y & 0xffff0000u);
        u32x2 w; w.x = pk2(o[e][0] * rstd * g[0] * pg8::silu_f(r0), o[e][1] * rstd * g[1] * pg8::silu_f(r1)); w.y = pk2(o[e][2] * rstd * g[2] * pg8::silu_f(r2), o[e][3] * rstd * g[3] * pg8::silu_f(r3));
        *(u32x2*)(MIX + row * DM + 512 + h * 64 + ec) = w; }
}

DI void four1_unit(unsigned char* ws, int u, int lane) {
    const int c16 = lane & 15, quad = lane >> 4;
    const int cq = u & 3, l2 = (u >> 2) & 63, bg = u >> 8, g = bg & 3, b = bg >> 2;
    const bf16_t* HX = (const bf16_t*)(ws + WS_HB);
    const bf16_t* FC = (const bf16_t*)(ws + WS_TAB + T_FC64); const bf16_t* FSN = (const bf16_t*)(ws + WS_TAB + T_FSN64); const float* TW = (const float*)(ws + WS_TAB + T_TW);
    bf16x8 uf[2];
    const bf16_t* up = HX + ((size_t)b * SEQ + l2) * DINP + C_FOUR + g * 64 + 16 * cq + c16;
#pragma unroll
    for (int ks = 0; ks < 2; ++ks) { unsigned hh[8];
#pragma unroll
        for (int j = 0; j < 8; ++j) hh[j] = up[(size_t)(64 * (quad * 8 + j + 32 * ks)) * DINP];
        u32x4 w; w.x = hh[0] | (hh[1] << 16); w.y = hh[2] | (hh[3] << 16); w.z = hh[4] | (hh[5] << 16); w.w = hh[6] | (hh[7] << 16); uf[ks] = __builtin_bit_cast(bf16x8, w); }
    bf16_t* tr = (bf16_t*)(ws + WS_TTR); bf16_t* ti = (bf16_t*)(ws + WS_TTI);
#pragma unroll
    for (int kq = 0; kq < 4; ++kq) {
        const bf16_t* fr = FC + (16 * kq + c16) * 64 + quad * 8; const bf16_t* fi = FSN + (16 * kq + c16) * 64 + quad * 8;
        f32x4 re = MFMA16(ld16(fr), uf[0], ((f32x4){0.f, 0.f, 0.f, 0.f})); re = MFMA16(ld16(fr + 32), uf[1], re);
        f32x4 im = MFMA16(ld16(fi), uf[0], ((f32x4){0.f, 0.f, 0.f, 0.f})); im = MFMA16(ld16(fi + 32), uf[1], im);
#pragma unroll
        for (int j = 0; j < 4; ++j) { const int kb = 16 * kq + 4 * quad + j; const float cw = TW[2 * (kb * 64 + l2)], sw = TW[2 * (kb * 64 + l2) + 1];
            const float xr = re[j] * cw + im[j] * sw, xi = im[j] * cw - re[j] * sw;
            const size_t off = (((size_t)bg * 64 + kb) * 64 + l2) * 64 + 16 * cq + c16;
            tr[off] = f2bf(xr); ti[off] = f2bf(xi); }
    }
}
template <int NLB, bool CPLX> DI void four2_unit(const bf16_t* xr, const bf16_t* xi, size_t xpitch, const bf16_t* FC64, const bf16_t* FS64, const bf16_t* FSN64,
                                                  const bf16_t* FLC, const bf16_t* FLS, bf16_t* out, size_t out_rstride, float scale, int mb, int lane) {
    const int c16 = lane & 15, quad = lane >> 4;
    bf16x8 bc[2], bs[2], bsn[2];
#pragma unroll
    for (int ks = 0; ks < 2; ++ks) { const size_t o = (size_t)(16 * mb + c16) * 64 + quad * 8 + 32 * ks; bc[ks] = ld16(FC64 + o); bs[ks] = ld16(FS64 + o); bsn[ks] = ld16(FSN64 + o); }
    bf16x8 qr[NLB / 2], qi[NLB / 2];
#pragma unroll
    for (int pr = 0; pr < NLB / 2; ++pr) {
        f32x4 tr[2], ti[2];
#pragma unroll
        for (int sb = 0; sb < 2; ++sb) { const int lb = 2 * pr + sb;
            const bf16_t* xp = xr + (size_t)(16 * lb + c16) * xpitch + quad * 8;
            const bf16x8 a0 = ld16(xp), a1 = ld16(xp + 32);
            tr[sb] = MFMA16(a0, bc[0], ((f32x4){0.f, 0.f, 0.f, 0.f})); tr[sb] = MFMA16(a1, bc[1], tr[sb]);
            ti[sb] = MFMA16(a0, bsn[0], ((f32x4){0.f, 0.f, 0.f, 0.f})); ti[sb] = MFMA16(a1, bsn[1], ti[sb]);
            if (CPLX) { const bf16_t* yp = xi + (size_t)(16 * lb + c16) * xpitch + quad * 8; const bf16x8 i0 = ld16(yp), i1 = ld16(yp + 32);
                tr[sb] = MFMA16(i0, bs[0], tr[sb]); tr[sb] = MFMA16(i1, bs[1], tr[sb]);
                ti[sb] = MFMA16(i0, bc[0], ti[sb]); ti[sb] = MFMA16(i1, bc[1], ti[sb]); } }
        qr[pr] = pack8(tr[0], tr[1]); qi[pr] = pack8(ti[0], ti[1]);
    }
    constexpr int NL = NLB * 16;
#pragma unroll 2
    for (int kq = 0; kq < NLB; ++kq) {
        f32x4 y = {0.f, 0.f, 0.f, 0.f};
        const bf16_t* fc = FLC + (size_t)(16 * kq + c16) * NL + quad * 4; const bf16_t* fs = FLS + (size_t)(16 * kq + c16) * NL + quad * 4;
#pragma unroll
        for (int pr = 0; pr < NLB / 2; ++pr) { y = MFMA16(cat8(ld8(fc + 32 * pr), ld8(fc + 32 * pr + 16)), qr[pr], y); y = MFMA16(cat8(ld8(fs + 32 * pr), ld8(fs + 32 * pr + 16)), qi[pr], y); }
#pragma unroll
        for (int j = 0; j < 4; ++j) out[(size_t)(16 * kq + 4 * quad + j) * out_rstride + c16] = f2bf(y[j] * scale);
    }
}

#define PHASE_VARS \
    int tid = threadIdx.x; asm volatile("" : "+v"(tid)); \
    const int lane = tid & 63, wave = __builtin_amdgcn_readfirstlane(tid >> 6); \
    const int G = gridDim.x, bid = blockIdx.x, gw = bid * 8 + wave, NGW = G * 8, gt = bid * 512 + tid, NT = G * 512; \
    unsigned char* ws = p.ws; asm volatile("" : "+s"(ws)); \
    int hs = hs_loop; asm volatile("" : "+s"(hs)); \
    const int l = hs >> 1; const bool second = hs & 1; const bool lastl = (l == 1); \
    const float* mod = (const float*)(ws + WS_MOD) + (size_t)l * 9 * 9216; \
    const unsigned char* wl = ws + WS_W + (size_t)l * W_LAYER; \
    float* ZB = (float*)(ws + WS_Z); bf16_t* HN = (bf16_t*)(ws + WS_HN); bf16_t* HB = (bf16_t*)(ws + WS_HB); \
    (void)lane; (void)wave; (void)gw; (void)NGW; (void)gt; (void)NT; (void)second; (void)lastl; (void)mod; (void)wl; (void)ZB; (void)HN; (void)HB; (void)bid; (void)G;

__global__ void __launch_bounds__(512, 2) mega_fwd(Params p) {
    extern __shared__ __attribute__((aligned(16))) unsigned char lds_raw[];
    LAS unsigned char* lds = (LAS unsigned char*)lds_raw;
    cg::grid_group grid = cg::this_grid();
    { const int hs_loop = 0; PHASE_VARS
      phase_prologue(p, lds, tid, lane, wave, bid, G); }
    grid.sync();

#pragma unroll 1
    for (int hs_loop = 0; hs_loop < 4; ++hs_loop) {
        { PHASE_VARS
          const float* xin = (hs == 0) ? p.in[0] : p.out; const float* zin = (hs == 0) ? p.in[2] : ZB;
          norm_pass(xin, zin, mod, second ? 6 : 0, second ? 7 : 1, HN, (hs == 3) ? TX : TT, gw, NGW, lane); }
        grid.sync();
        { PHASE_VARS
          const int Mrows = (hs == 3) ? TX : TT;
          pg8::Gemm g{HN, (const bf16_t*)(wl + (second ? W_UP2 : W_UP1)), Mrows, 2 * DFF, DM}; pg8::StaticOrder S; S.init(Mrows, 2 * DFF, G, bid);
          pg8::EpiSwiglu E{HB, DFF}; pg8::gemm_phase<pg8::EpiSwiglu, pg8::StaticOrder, true, true>(lds, g, S, E); }
        grid.sync();
        { PHASE_VARS
          const int Mrows = (hs == 3) ? TX : TT;
          const float* xin = (hs == 0) ? p.in[0] : p.out; const float* zin = (hs == 0) ? p.in[2] : ZB;
          pg8::Gemm g{HB, (const bf16_t*)(wl + (second ? W_DN2 : W_DN1)), Mrows, DM, DFF}; pg8::StaticOrder S; S.init(Mrows, DM, G, bid);
          pg8::EpiResid E{xin, zin, p.out, ZB, mod + (second ? 8 : 2) * 1024, 0.5f}; pg8::gemm_phase<pg8::EpiResid, pg8::StaticOrder, true, true>(lds, g, S, E); }
        grid.sync();
        if (hs_loop & 1) continue;
        { PHASE_VARS
          norm_pass(p.out, ZB, mod, 3, 4, HN, TT, gw, NGW, lane); }
        grid.sync();
        { PHASE_VARS
          pg8::Gemm g{HN, (const bf16_t*)(wl + W_IN), TT, DINP, DM}; pg8::StaticOrder S; S.init(TT, DINP, G, bid);
          pg8::EpiBf16 E{HB, DINP}; pg8::gemm_phase<pg8::EpiBf16, pg8::StaticOrder, true, true>(lds, g, S, E); }
        grid.sync();
        { PHASE_VARS
          for (int t = bid; t < 544; t += G) prep_tile(p, l, t, lds, tid); }
        grid.sync();
        { PHASE_VARS
          for (int u = gw; u < 8192 + 4352; u += NGW) { if (u < 8192) four1_unit(ws, u, lane); else gla_local_unit(ws, u - 8192, lane); } }
        grid.sync();
        { PHASE_VARS
          gla_scan(ws, gt, NT); }
        { PHASE_VARS
          const unsigned char* tab = ws + WS_TAB;
          const int n_f2 = 8192, n_na = 8192, n_fz = lastl ? 0 : 128, n_naz = lastl ? 0 : 512;
          const int tot = n_f2 + n_na + n_fz + n_naz;
          for (int u = gw; u < tot; u += NGW) {
              if (u < n_na) na_unit_x(p, l, u, lane);
              else if (u < n_na + n_f2) { const int v = u - n_na; const int mb = v & 3, kb = (v >> 2) & 63, bg = v >> 8;
                  const size_t xo = ((size_t)bg * 64 + kb) * 4096;
                  four2_unit<4, true>((const bf16_t*)(ws + WS_TTR) + xo, (const bf16_t*)(ws + WS_TTI) + xo, 64, (const bf16_t*)(tab + T_FC64), (const bf16_t*)(tab + T_FS64), (const bf16_t*)(tab + T_FSN64),
                                      (const bf16_t*)(tab + T_FC64), (const bf16_t*)(tab + T_FS64), HN + ((size_t)(bg >> 2) * SEQ + kb) * DM + (bg & 3) * 64 + 16 * mb, (size_t)64 * DM, 1.0f / 512.0f, mb, lane); }
              else if (u < n_na + n_f2 + n_fz) { const int v = u - n_na - n_f2; const int mb = v & 3, bg = v >> 2;
                  const bf16_t* xr = HB + ((size_t)TX + (bg >> 2) * CTX) * DINP + C_FOUR + (bg & 3) * 64;
                  four2_unit<16, false>(xr, xr, DINP, (const bf16_t*)(tab + T_FC64), (const bf16_t*)(tab + T_FS64), (const bf16_t*)(tab + T_FSN64),
                                        (const bf16_t*)(tab + T_FC256), (const bf16_t*)(tab + T_FS256), HN + ((size_t)TX + (bg >> 2) * CTX) * DM + (bg & 3) * 64 + 16 * mb, (size_t)DM, 1.0f / 128.0f, mb, lane); }
              else na_unit_z(ws, u - n_na - n_f2 - n_fz, lane);
          } }
        grid.sync();
        { PHASE_VARS
          const int n_gqa = 4096, n_gz = lastl ? 0 : 256, n_gla = 8 * 4 * NCHUNK * 4;
          const int tot = n_gqa + n_gz + n_gla;
          for (int u = gw; u < tot; u += NGW) {
              if (u < n_gqa) gqa_unit_x(ws, u, lane);
              else if (u < n_gqa + n_gz) gqa_unit_z(ws, u - n_gqa, lane);
              else { const int v = u - n_gqa - n_gz; const int pc = (v >> 2) % NCHUNK; if (!(lastl && pc >= 64)) gla_out_unit(p, l, v, lane); }
          } }
        grid.sync();
        { PHASE_VARS
          const int Mo = lastl ? TX : TT; pg8::Gemm g{HN, (const bf16_t*)(wl + W_OUT), Mo, DM, DM}; pg8::StaticOrder S; S.init(Mo, DM, G, bid);
          pg8::EpiResid E{p.out, ZB, p.out, ZB, mod + 5 * 1024, 1.0f}; pg8::gemm_phase<pg8::EpiResid, pg8::StaticOrder, true, true>(lds, g, S, E); }
        grid.sync();
    }
}

extern "C" void kernel_launch(void* const* d_in, const int* in_sizes, int n_in, void* d_out, int out_size, void* d_ws, size_t ws_size, hipStream_t stream) {
    static int grid = 0;
    if (grid == 0) {
        int dev = 0, cus = 0, per_cu = 0;
        hipGetDevice(&dev);
        hipDeviceGetAttribute(&cus, hipDeviceAttributeMultiprocessorCount, dev);
        hipFuncSetAttribute((const void*)mega_fwd, hipFuncAttributeMaxDynamicSharedMemorySize, LDS_BYTES);
        hipOccupancyMaxActiveBlocksPerMultiprocessor(&per_cu, (const void*)mega_fwd, 512, LDS_BYTES);
        (void)hipGetLastError();
        if (per_cu < 1) per_cu = 1;
        if (per_cu > 1) per_cu = 1;
        grid = cus * per_cu;
        if (n_in != 24 || ws_size < WS_END) { fprintf(stderr, "kernel_launch: unexpected n_in %d / ws_size %zu (need %zu)\n", n_in, ws_size, (size_t)WS_END); }
    }
    Params p{};
    for (int i = 0; i < 24; ++i) p.in[i] = (const float*)d_in[i];
    p.out = (float*)d_out; p.ws = (unsigned char*)d_ws;
    void* args[] = {&p};
    hipError_t e = hipLaunchCooperativeKernel((const void*)mega_fwd, dim3(grid), dim3(512), args, LDS_BYTES, stream);
    if (e != hipSuccess) fprintf(stderr, "cooperative launch failed: %s (grid %d)\n", hipGetErrorString(e), grid);
}
```

```cpp
#include <hip/hip_runtime.h>
#include <hip/hip_cooperative_groups.h>
#include <cstdio>
#include <cstdint>
namespace cg = cooperative_groups;

namespace pg8 {
#define PG8_LAS __attribute__((address_space(3)))
typedef unsigned short bf16_t;
typedef short bf16x8 __attribute__((ext_vector_type(8)));
typedef float f32x4 __attribute__((ext_vector_type(4)));
typedef unsigned u32x4 __attribute__((ext_vector_type(4)));
constexpr int BM = 256, BK = 64, HALF = 128, HTB = HALF * BK * 2  , STAGE_BYTES = 8 * HTB, NXCD = 8, WGM = 8;

__host__ __device__ __forceinline__ int lds_byte(int r, int c) { const int st = (r >> 4) * 2 + (c >> 5), rr = r & 15, cc = c & 31, ob = rr * 64 + cc * 2; return st * 1024 + (ob ^ (((ob >> 9) & 1) << 5)); }
__host__ __device__ __forceinline__ void stage_rc(int b, int& R, int& C) { const int st = b / 1024, sb = b % 1024, swz = sb ^ (((sb >> 9) & 1) << 5); R = (st >> 1) * 16 + swz / 64; C = (st & 1) * 32 + (swz % 64) / 2; }
__host__ __device__ __forceinline__ int perm32(int rho) { const int n = rho >> 4, i = rho & 15; return 8 * (i >> 2) + 4 * n + (i & 3); }

struct Unit { int pm, pn, slot; };
struct Gemm { const bf16_t* A; const bf16_t* Bt; int M, N, K, ld; };

struct StaticOrder {
    int nM, nN, nwg, G, c;
    __host__ __device__ void init(int M, int N, int G_, int c_) { nM = M / BM; nN = N / BM; nwg = nM * nN; G = G_; c = c_; }
    __host__ __device__ bool next(int i, Unit& u) const {
        const long L = (long)i * G + c; if (L >= nwg) return false; u.slot = i & 1;
        int wgid = (int)L; { const int q = nwg / NXCD, r = nwg % NXCD, xcd = wgid % NXCD, off = wgid / NXCD; wgid = (xcd < r ? xcd * (q + 1) : r * (q + 1) + (xcd - r) * q) + off; }
        const int nig = WGM * nN, gid = wgid / nig, fm = gid * WGM, gsz = (nM - fm) < WGM ? (nM - fm) : WGM;
        u.pm = fm + ((wgid % nig) % gsz); u.pn = (wgid % nig) / gsz; return true;
    }
    __device__ __forceinline__ void a_ready(const Unit&) const {}
    __device__ __forceinline__ void done(const Unit&) const {}
};

__device__ __forceinline__ unsigned cvt_pk_bf16(float lo, float hi) {
    typedef float f32x2_t __attribute__((ext_vector_type(2))); typedef __bf16 bf16x2_t __attribute__((ext_vector_type(2)));
    f32x2_t v = {lo, hi}; bf16x2_t b = __builtin_convertvector(v, bf16x2_t); return __builtin_bit_cast(unsigned, b);
}
__device__ __forceinline__ float silu_f(float v) { return v * __builtin_amdgcn_rcpf(1.0f + __expf(-v)); }
constexpr int ROWS_X = 32768;
constexpr unsigned PREF_LDS_ADDR = 131072 + 1024;
#define PG8_PREF ((PG8_LAS float*)(size_t)PREF_LDS_ADDR)
__device__ __forceinline__ float fq_sum(float v) {
    v += __int_as_float(__builtin_amdgcn_ds_swizzle(__float_as_int(v), (16 << 10) | 0x1F));
    auto rr = __builtin_amdgcn_permlane32_swap(__float_as_uint(v), __float_as_uint(v), false, false); return __uint_as_float(rr[0]) + __uint_as_float(rr[1]); }
constexpr float NORM_EPS = 1e-6f;

struct EpiBf16 {
    static constexpr bool PERM = true, AFTER_DRAIN = false;
    bf16_t* O; int ldo;
    __device__ __forceinline__ void operator()(const f32x4 (&acc)[2][2][4][2], const Unit& u, int wr, int wc, int fr, int fq) const {
        const int row0 = u.pm * BM + wr * 64 + fr, col0 = u.pn * BM + wc * 32 + 8 * fq;
        const PG8_LAS float* ps = PG8_PREF + u.slot * 512;
        f32x4 sbv[2][2];
#pragma unroll
        for (int bj = 0; bj < 2; ++bj)
#pragma unroll
            for (int n = 0; n < 2; ++n) sbv[bj][n] = *(const PG8_LAS f32x4*)(ps + 256 + wc * 32 + 8 * fq + bj * HALF + 4 * n);
#pragma unroll
        for (int ai = 0; ai < 2; ++ai)
#pragma unroll
            for (int m = 0; m < 4; ++m) { bf16_t* rowp = O + (size_t)(row0 + ai * HALF + m * 16) * ldo + col0;
                const float rstd = rsqrtf(ps[wr * 64 + fr + ai * HALF + m * 16] * (1.0f / 1024.0f) + NORM_EPS);
#pragma unroll
                for (int bj = 0; bj < 2; ++bj) { const f32x4 v0 = acc[ai][bj][m][0] * rstd + sbv[bj][0], v1 = acc[ai][bj][m][1] * rstd + sbv[bj][1]; u32x4 w;
                    w.x = cvt_pk_bf16(v0[0], v0[1]); w.y = cvt_pk_bf16(v0[2], v0[3]); w.z = cvt_pk_bf16(v1[0], v1[1]); w.w = cvt_pk_bf16(v1[2], v1[3]);
                    *(u32x4*)(rowp + bj * HALF) = w; } }
    }
};
struct EpiSwiglu {
    static constexpr bool PERM = true, AFTER_DRAIN = false;
    bf16_t* O; int ldo;
    __device__ __forceinline__ void operator()(const f32x4 (&acc)[2][2][4][2], const Unit& u, int wr, int wc, int fr, int fq) const {
        const int row0 = u.pm * BM + wr * 64 + fr, col0 = u.pn * HALF + wc * 32 + 8 * fq;
        const PG8_LAS float* ps = PG8_PREF + u.slot * 512;
        f32x4 sbv[2][2];
#pragma unroll
        for (int bj = 0; bj < 2; ++bj)
#pragma unroll
            for (int n = 0; n < 2; ++n) sbv[bj][n] = *(const PG8_LAS f32x4*)(ps + 256 + bj * HALF + wc * 32 + 8 * fq + 4 * n);
#pragma unroll
        for (int ai = 0; ai < 2; ++ai)
#pragma unroll
            for (int m = 0; m < 4; ++m) { bf16_t* rowp = O + (size_t)(row0 + ai * HALF + m * 16) * ldo + col0;
                const float rstd = rsqrtf(ps[wr * 64 + fr + ai * HALF + m * 16] * (1.0f / 1024.0f) + NORM_EPS);
                const f32x4 g0 = acc[ai][0][m][0] * rstd + sbv[0][0], g1 = acc[ai][0][m][1] * rstd + sbv[0][1], u0 = acc[ai][1][m][0] * rstd + sbv[1][0], u1 = acc[ai][1][m][1] * rstd + sbv[1][1]; u32x4 w;
                w.x = cvt_pk_bf16(silu_f(g0[0]) * u0[0], silu_f(g0[1]) * u0[1]); w.y = cvt_pk_bf16(silu_f(g0[2]) * u0[2], silu_f(g0[3]) * u0[3]);
                w.z = cvt_pk_bf16(silu_f(g1[0]) * u1[0], silu_f(g1[1]) * u1[1]); w.w = cvt_pk_bf16(silu_f(g1[2]) * u1[2], silu_f(g1[3]) * u1[3]);
                *(u32x4*)rowp = w; }
    }
};
struct EpiResid {
    static constexpr bool PERM = false, AFTER_DRAIN = false;
    const float* inx; const float* inz; float* outx; float* outz; const float* gate;   float s;
    bf16_t* hn; const float* nscale; float* rowss;
    __device__ __forceinline__ void operator()(const f32x4 (&acc)[2][2][4][2], const Unit& u, int wr, int wc, int fr, int fq) const {
        const int trow = u.pm * BM; const bool isx = trow < ROWS_X; const int mi = isx ? (trow >> 12) : 8;
        const float* ib = isx ? inx + (size_t)trow * 1024 : inz + (size_t)(trow - ROWS_X) * 1024;
        float* ob = isx ? outx + (size_t)trow * 1024 : outz + (size_t)(trow - ROWS_X) * 1024;
        const int col0 = u.pn * BM + wc * 32 + 4 * fq; const float* gp = gate + (size_t)mi * 9216 + col0;
        f32x4 gv[2][2], sv[2][2];
        const bool fuse = hn != nullptr;
#pragma unroll
        for (int bj = 0; bj < 2; ++bj)
#pragma unroll
            for (int n = 0; n < 2; ++n) { gv[bj][n] = *(const f32x4*)(gp + bj * HALF + n * 16) * s;
                sv[bj][n] = fuse ? *(const f32x4*)(nscale + (size_t)mi * 9216 + col0 + bj * HALF + n * 16) + 1.0f : (f32x4){1.f, 1.f, 1.f, 1.f}; }
#pragma unroll
        for (int am = 0; am < 8; ++am) { const int ai = am >> 2, m = am & 3;
            f32x4 pre[2][2];
            const int rt = ai * HALF + wr * 64 + m * 16 + fr; const unsigned off = (unsigned)(rt * 1024 + col0);
#pragma unroll
            for (int bj = 0; bj < 2; ++bj)
#pragma unroll
                for (int n = 0; n < 2; ++n) pre[bj][n] = *(const f32x4*)(ib + (off + bj * HALF + n * 16));
            { float ssq = 0.f;
#pragma unroll
                for (int bj = 0; bj < 2; ++bj)
#pragma unroll
                    for (int n = 0; n < 2; ++n) { const f32x4 bs = pre[bj][n];
                        const f32x4 xn = bs + gv[bj][n] * acc[ai][bj][m][n];
                        *(f32x4*)(ob + off + bj * HALF + n * 16) = xn;
                        if (fuse) { const f32x4 a = xn * sv[bj][n]; typedef unsigned u32x2e __attribute__((ext_vector_type(2))); u32x2e w; w.x = cvt_pk_bf16(a[0], a[1]); w.y = cvt_pk_bf16(a[2], a[3]);
                            *(u32x2e*)(hn + (size_t)trow * 1024 + (off + bj * HALF + n * 16)) = w;
                            ssq += (xn[0] * xn[0] + xn[1] * xn[1]) + (xn[2] * xn[2] + xn[3] * xn[3]); } }
                if (fuse) { ssq = fq_sum(ssq); if (fq == 0) __hip_atomic_fetch_add(rowss + trow + rt, ssq, __ATOMIC_RELAXED, __HIP_MEMORY_SCOPE_AGENT); } } }
    }
};

struct OneUnit {
    int pm, pn; bool have;
    __device__ __forceinline__ bool next(int i, Unit& u) const { if (i != 0 || !have) return false; u.pm = pm; u.pn = pn; u.slot = 0; return true; }
    __device__ __forceinline__ void a_ready(const Unit&) const {}
    __device__ __forceinline__ void done(const Unit&) const {}
};
struct EpiPart {
    static constexpr bool PERM = false, AFTER_DRAIN = false;
    float* P;
    __device__ __forceinline__ void operator()(const f32x4 (&acc)[2][2][4][2], const Unit& u, int wr, int wc, int fr, int fq) const {
        const int col0 = u.pn * BM + wc * 32 + 4 * fq;
#pragma unroll
        for (int ai = 0; ai < 2; ++ai)
#pragma unroll
            for (int m = 0; m < 4; ++m) { float* rp = P + (size_t)(u.pm * BM + ai * HALF + wr * 64 + m * 16 + fr) * 1024 + col0;
#pragma unroll
                for (int bj = 0; bj < 2; ++bj)
#pragma unroll
                    for (int n = 0; n < 2; ++n) *(f32x4*)(rp + bj * HALF + n * 16) = acc[ai][bj][m][n]; }
    }
};
struct PrefOrder : StaticOrder {
    const float* rowss; const float* sb; int sbN;
    __device__ __forceinline__ void a_ready(const Unit& u) const {
        const int wid = __builtin_amdgcn_readfirstlane((int)threadIdx.x >> 6); const unsigned voff = (threadIdx.x & 63u) * 16u;
        const int mi = (u.pm * BM < ROWS_X) ? ((u.pm * BM) >> 12) : 8;
        const float* src = (wid == 0) ? rowss + (size_t)u.pm * BM : sb + (size_t)mi * sbN + (size_t)u.pn * BM;
        const unsigned dst = PREF_LDS_ADDR + (unsigned)u.slot * 2048u + (wid == 0 ? 0u : 1024u);
        if (wid < 2) { unsigned keep; asm volatile("s_mov_b32 %0, m0\n\ts_mov_b32 m0, %2\n\ts_nop 0\n\tglobal_load_lds_dwordx4 %1, %3\n\ts_mov_b32 m0, %0" : "=&s"(keep) : "v"(voff), "s"(dst), "s"(src) : "memory"); }
    }
};
template <class Epi, class Sched, bool ALIGN_EPI = false, bool SP2 = false>
__device__ __forceinline__ void gemm_phase(PG8_LAS unsigned char* lds, const Gemm g, const Sched& S, const Epi& E) {
    int tid = threadIdx.x; asm volatile("" : "+v"(tid)); const int wid = __builtin_amdgcn_readfirstlane(tid >> 6), lane = tid & 63, wr = wid >> 2, wc = wid & 3, fr = lane & 15, fq = lane >> 4;
    const int K = g.K, nt = K / BK, LD = g.ld;
    unsigned voffA[2], voffB[2];
#pragma unroll
    for (int i = 0; i < 2; ++i) { int R, C; stage_rc(tid * 16 + i * 8192, R, C); const int Rb = Epi::PERM ? ((R & ~31) + perm32(R & 31)) : R;
        voffA[i] = (unsigned)(R * LD + C) * 2u; voffB[i] = (unsigned)(Rb * LD + C) * 2u; }
    const size_t kstep = (size_t)(BK * 2);
    const size_t hstep = (size_t)HALF * LD * 2;
    const size_t tstep = 2 * hstep;
    const unsigned ldsw = (unsigned)wid * 1024u;
    const int aoff = lds_byte(wr * 64 + fr, fq * 8), boff = lds_byte(wc * 32 + fr, fq * 8);
#define PG8_SA(b, h) (((b) * 2 + (h)) * HTB)
#define PG8_SB(b, h) ((4 + (b) * 2 + (h)) * HTB)
#define PG8_STAGE(bufoff, gbase, voff) do { _Pragma("unroll") for (int _i = 0; _i < 2; ++_i) \
        __builtin_amdgcn_global_load_lds((const unsigned*)((const char*)(gbase) + (voff)[_i]), (PG8_LAS unsigned*)(lds + (bufoff) + ldsw + _i * 8192), 16, 0, 0); } while (0)
#define PG8_LDA(dst, b, h) do { _Pragma("unroll") for (int m = 0; m < 4; ++m) _Pragma("unroll") for (int k = 0; k < 2; ++k) dst[m][k] = *(const PG8_LAS bf16x8*)(lds + PG8_SA(b, h) + aoff + m * 2048 + k * 1024); } while (0)
#define PG8_LDB(dst, b, h) do { _Pragma("unroll") for (int n = 0; n < 2; ++n) _Pragma("unroll") for (int k = 0; k < 2; ++k) dst[n][k] = *(const PG8_LAS bf16x8*)(lds + PG8_SB(b, h) + boff + n * 2048 + k * 1024); } while (0)
#define PG8_MMA(ai, bj, At, Bt) do { __builtin_amdgcn_s_setprio(1); _Pragma("unroll") for (int m = 0; m < 4; ++m) _Pragma("unroll") for (int n = 0; n < 2; ++n) _Pragma("unroll") for (int k = 0; k < 2; ++k) \
        acc[ai][bj][m][n] = __builtin_amdgcn_mfma_f32_16x16x32_bf16(Bt[n][k], At[m][k], acc[ai][bj][m][n], 0, 0, 0); __builtin_amdgcn_s_setprio(0); } while (0)
#define PG8_WAIT_V(n) asm volatile("s_waitcnt vmcnt(" #n ")" ::: "memory")
#define PG8_WAIT_L(n) asm volatile("s_waitcnt lgkmcnt(" #n ")" ::: "memory")
#define PG8_BAR __builtin_amdgcn_s_barrier()
#define PG8_SCHED __builtin_amdgcn_sched_barrier(0)
    Unit cur, nxt; int ui = 0;
    if (!S.next(0, cur)) return;
    f32x4 acc[2][2][4][2];
#pragma unroll
    for (int a = 0; a < 2; ++a)
#pragma unroll
        for (int b = 0; b < 2; ++b)
#pragma unroll
            for (int m = 0; m < 4; ++m)
#pragma unroll
                for (int n = 0; n < 2; ++n) acc[a][b][m][n] = (f32x4){0.f, 0.f, 0.f, 0.f};
    bf16x8 At[4][2], B0[2][2], B1[2][2];
    const char* cA = (const char*)g.A + (size_t)cur.pm * tstep; const char* cB = (const char*)g.Bt + (size_t)cur.pn * tstep;
    S.a_ready(cur);
    if constexpr (SP2) {
        PG8_STAGE(PG8_SB(0, 0), cB, voffB); PG8_STAGE(PG8_SB(0, 1), cB + hstep, voffB); PG8_STAGE(PG8_SA(0, 0), cA, voffA); PG8_STAGE(PG8_SA(0, 1), cA + hstep, voffA);
        if (wr == 1) PG8_BAR;
        PG8_WAIT_V(2); PG8_BAR;
        PG8_STAGE(PG8_SB(1, 0), cB + kstep, voffB); PG8_STAGE(PG8_SA(1, 0), cA + kstep, voffA); PG8_STAGE(PG8_SB(1, 1), cB + hstep + kstep, voffB);
        PG8_WAIT_V(6); PG8_BAR;
    } else {
        PG8_STAGE(PG8_SB(0, 0), cB, voffB); PG8_STAGE(PG8_SA(0, 0), cA, voffA); PG8_STAGE(PG8_SB(0, 1), cB + hstep, voffB); PG8_STAGE(PG8_SA(0, 1), cA + hstep, voffA);
        if (wr == 1) PG8_BAR;
        PG8_WAIT_V(4); PG8_BAR;
        PG8_STAGE(PG8_SB(1, 0), cB + kstep, voffB); PG8_STAGE(PG8_SA(1, 0), cA + kstep, voffA); PG8_STAGE(PG8_SB(1, 1), cB + hstep + kstep, voffB);
        PG8_WAIT_V(6); PG8_BAR;
    }
    for (;;) {
        const bool has_next = S.next(ui + 1, nxt);
        const char* nA = has_next ? (const char*)g.A + (size_t)nxt.pm * tstep : cA; const char* nB = has_next ? (const char*)g.Bt + (size_t)nxt.pn * tstep : cB;
        for (int t = 0; t < nt; t += 2) {
            const bool last = (t == nt - 2);
            const char* a1 = cA + (size_t)(t + 1) * kstep;
            const char* a2 = last ? nA : cA + (size_t)(t + 2) * kstep; const char* b2 = last ? nB : cB + (size_t)(t + 2) * kstep;
            const char* a3 = a2 + kstep; const char* b3 = b2 + kstep;
            if (last && has_next) S.a_ready(nxt);
            if constexpr (SP2) {
            PG8_LDB(B0, 0, 0); PG8_LDB(B1, 0, 1); PG8_SCHED; PG8_LDA(At, 0, 0); PG8_STAGE(PG8_SA(1, 1), a1 + hstep, voffA);
            PG8_WAIT_V(8); PG8_WAIT_L(0); PG8_BAR; PG8_MMA(0, 0, At, B0); PG8_MMA(0, 1, At, B1); PG8_BAR; PG8_SCHED;
            PG8_LDA(At, 0, 1); PG8_STAGE(PG8_SB(0, 0), b2, voffB); PG8_STAGE(PG8_SB(0, 1), b2 + hstep, voffB); PG8_STAGE(PG8_SA(0, 0), a2, voffA);
            PG8_WAIT_V(8); PG8_WAIT_L(0); PG8_BAR; PG8_MMA(1, 0, At, B0); PG8_MMA(1, 1, At, B1); PG8_BAR; PG8_SCHED;
            PG8_LDB(B0, 1, 0); PG8_LDB(B1, 1, 1); PG8_SCHED; PG8_LDA(At, 1, 0); PG8_STAGE(PG8_SA(0, 1), a2 + hstep, voffA);
            PG8_WAIT_V(8); PG8_WAIT_L(0); PG8_BAR; PG8_MMA(0, 0, At, B0); PG8_MMA(0, 1, At, B1); PG8_BAR; PG8_SCHED;
            PG8_LDA(At, 1, 1); PG8_STAGE(PG8_SB(1, 0), b3, voffB); PG8_STAGE(PG8_SB(1, 1), b3 + hstep, voffB); PG8_STAGE(PG8_SA(1, 0), a3, voffA);
            PG8_WAIT_V(8); PG8_WAIT_L(0); PG8_BAR; PG8_MMA(1, 0, At, B0); PG8_MMA(1, 1, At, B1); PG8_BAR; PG8_SCHED;
            } else {
            PG8_LDB(B0, 0, 0); PG8_SCHED; PG8_LDA(At, 0, 0); PG8_STAGE(PG8_SA(1, 1), a1 + hstep, voffA);
            PG8_WAIT_L(8); PG8_BAR; PG8_WAIT_L(0); PG8_MMA(0, 0, At, B0); PG8_BAR; PG8_SCHED;
            PG8_LDB(B1, 0, 1); PG8_STAGE(PG8_SB(0, 0), b2, voffB);
            PG8_BAR; PG8_WAIT_L(0); PG8_MMA(0, 1, At, B1); PG8_BAR;
            PG8_LDA(At, 0, 1); PG8_STAGE(PG8_SA(0, 0), a2, voffA);
            PG8_BAR; PG8_WAIT_L(0); PG8_MMA(1, 0, At, B0); PG8_BAR; PG8_SCHED;
            PG8_STAGE(PG8_SB(0, 1), b2 + hstep, voffB);
            PG8_WAIT_V(6); PG8_BAR; PG8_MMA(1, 1, At, B1); PG8_BAR;
            PG8_LDB(B0, 1, 0); PG8_SCHED; PG8_LDA(At, 1, 0); PG8_STAGE(PG8_SA(0, 1), a2 + hstep, voffA);
            PG8_WAIT_L(8); PG8_BAR; PG8_WAIT_L(0); PG8_MMA(0, 0, At, B0); PG8_BAR; PG8_SCHED;
            PG8_LDB(B1, 1, 1); PG8_STAGE(PG8_SB(1, 0), b3, voffB);
            PG8_BAR; PG8_WAIT_L(0); PG8_MMA(0, 1, At, B1); PG8_BAR;
            PG8_LDA(At, 1, 1); PG8_STAGE(PG8_SA(1, 0), a3, voffA);
            PG8_BAR; PG8_WAIT_L(0); PG8_MMA(1, 0, At, B0); PG8_BAR; PG8_SCHED;
            PG8_STAGE(PG8_SB(1, 1), b3 + hstep, voffB);
            PG8_WAIT_V(6); PG8_BAR; PG8_MMA(1, 1, At, B1); PG8_BAR;
            }
        }
        if constexpr (ALIGN_EPI) { if (wr == 0) PG8_BAR; }
        if constexpr (!Epi::AFTER_DRAIN) { E(acc, cur, wr, wc, fr, fq); S.done(cur); }
        if (!has_next) break;
#pragma unroll
        for (int a = 0; a < 2; ++a)
#pragma unroll
            for (int b = 0; b < 2; ++b)
#pragma unroll
                for (int m = 0; m < 4; ++m)
#pragma unroll
                    for (int n = 0; n < 2; ++n) acc[a][b][m][n] = (f32x4){0.f, 0.f, 0.f, 0.f};
        cur = nxt; cA = nA; cB = nB; ++ui;
        if constexpr (ALIGN_EPI) { if (wr == 1) PG8_BAR; }
    }
    PG8_WAIT_V(0);
    if constexpr (!ALIGN_EPI) { if (wr == 0) PG8_BAR; }
    PG8_BAR;
    if constexpr (Epi::AFTER_DRAIN) { E.fused(acc, cur, wr, wc, fr, fq, lds, wid, lane); S.done(cur); }
#undef PG8_SA
#undef PG8_SB
#undef PG8_STAGE
#undef PG8_LDA
#undef PG8_LDB
#undef PG8_MMA
#undef PG8_WAIT_V
#undef PG8_WAIT_L
#undef PG8_BAR
#undef PG8_SCHED
}
}
#include <hip/hip_bf16.h>
#include <cmath>
namespace attn_body {
using bf16=__hip_bfloat16;
using bf16x8=__attribute__((ext_vector_type(8)))short;
using s16x4=__attribute__((ext_vector_type(4)))short;
using f32x16=__attribute__((ext_vector_type(16)))float;
using u32x4=__attribute__((ext_vector_type(4)))unsigned;
constexpr int D=64,QP=2560,KP=2560,OP=1024;
constexpr int NW=8,QBLK=32,QB=QBLK*NW,KVBLK=64;
__device__ __forceinline__ int crow(int r,int hi){return (r&3)+8*(r>>2)+4*hi;}
#define SBAR() __builtin_amdgcn_sched_barrier(0)
__device__ __forceinline__ void cmask(f32x16&p0,f32x16&p1,int jb,int qrel,int hi){
  const float NEG=-INFINITY; int kb=64*jb+4*hi;
  #pragma unroll
  for(int r=0;r<16;++r){int kv=kb+(r&3)+8*(r>>2); if(kv>qrel)p0[r]=NEG; if(kv+32>qrel)p1[r]=NEG;}
}

constexpr int NSLOT=3, SLOTB=8192;
constexpr int LDS_K=0, LDS_V=NSLOT*SLOTB, LDS_WS=2*NSLOT*SLOTB, LDS_OST=LDS_WS+NW*64*4, LDS_BYTES=LDS_OST+NW*4096;
constexpr float C2=0.125f*1.4426950408889634f;
__device__ __forceinline__ void glds16(const void*gbase,unsigned voff,unsigned lds_dst){unsigned keep;
  asm volatile("s_mov_b32 %0, m0\n\ts_mov_b32 m0, %2\n\ts_nop 0\n\tglobal_load_lds_dwordx4 %1, %3\n\ts_mov_b32 m0, %0":"=&s"(keep):"v"(voff),"s"(lds_dst),"s"(gbase):"memory");}
__device__ __forceinline__ float max3f(float a,float b,float c){float r;asm("v_max3_f32 %0, %1, %2, %3":"=v"(r):"v"(a),"v"(b),"v"(c));return r;}
__device__ __forceinline__ float max2f(float a,float b){float r;asm("v_max_f32_e32 %0, %1, %2":"=v"(r):"v"(a),"v"(b));return r;}
__device__ __forceinline__ float fadd_s(float a,float b){float r;asm("v_add_f32_e32 %0, %1, %2":"=v"(r):"v"(a),"v"(b));return r;}
__device__ __forceinline__ float fsub_s(float a,float b){float r;asm("v_sub_f32_e32 %0, %1, %2":"=v"(r):"v"(a),"v"(b));return r;}
typedef float f32x2_t __attribute__((ext_vector_type(2))); typedef __bf16 bf16x2_t __attribute__((ext_vector_type(2)));
__device__ __forceinline__ unsigned cvtpk_s(float lo,float hi){f32x2_t v={lo,hi};bf16x2_t b=__builtin_convertvector(v,bf16x2_t);return __builtin_bit_cast(unsigned,b);}
#define WAIT_BAR(N) asm volatile("s_waitcnt vmcnt(" #N ") lgkmcnt(0)\n\ts_barrier":::"memory")

__device__ __forceinline__ void qkt(f32x16&p0,f32x16&p1,const char*Kslot,const bf16x8*qr,const f32x16&negm,int r32,int hi){
  const char*kb=Kslot+hi*1024+r32*16;
  #pragma unroll
  for(int d0=0;d0<4;++d0){
    const bf16x8 b0=*reinterpret_cast<const bf16x8*>(kb+d0*2048);
    const bf16x8 b1=*reinterpret_cast<const bf16x8*>(kb+d0*2048+512);
    if(d0==0){p0=__builtin_amdgcn_mfma_f32_32x32x16_bf16(b0,qr[0],negm,0,0,0);p1=__builtin_amdgcn_mfma_f32_32x32x16_bf16(b1,qr[0],negm,0,0,0);}
    else{p0=__builtin_amdgcn_mfma_f32_32x32x16_bf16(b0,qr[d0],p0,0,0,0);p1=__builtin_amdgcn_mfma_f32_32x32x16_bf16(b1,qr[d0],p1,0,0,0);}}
}
typedef __attribute__((address_space(3))) const char* lds_cptr;
typedef short v4i16_t __attribute__((ext_vector_type(4)));
__device__ __forceinline__ void kload8(bf16x8*kf,lds_cptr kp){
  kf[0]=*(const __attribute__((address_space(3))) bf16x8*)(kp);      kf[1]=*(const __attribute__((address_space(3))) bf16x8*)(kp+512);
  kf[2]=*(const __attribute__((address_space(3))) bf16x8*)(kp+2048); kf[3]=*(const __attribute__((address_space(3))) bf16x8*)(kp+2560);
  kf[4]=*(const __attribute__((address_space(3))) bf16x8*)(kp+4096); kf[5]=*(const __attribute__((address_space(3))) bf16x8*)(kp+4608);
  kf[6]=*(const __attribute__((address_space(3))) bf16x8*)(kp+6144); kf[7]=*(const __attribute__((address_space(3))) bf16x8*)(kp+6656);
}
__device__ __forceinline__ void kload2(bf16x8*kf,lds_cptr kp,int j){ kf[2*j]=*(const __attribute__((address_space(3))) bf16x8*)(kp+j*2048); kf[2*j+1]=*(const __attribute__((address_space(3))) bf16x8*)(kp+j*2048+512); }
__device__ __forceinline__ s16x4 vtr(lds_cptr p){ return __builtin_bit_cast(s16x4,__builtin_amdgcn_ds_read_tr16_b64_v4i16((__attribute__((address_space(3))) v4i16_t*)p)); }
__device__ __forceinline__ float rowmax(const f32x16&p0,const f32x16&p1){
  float a=max3f(p0[0],p0[1],p1[0]),b=max3f(p0[2],p0[3],p1[1]);a=max3f(a,p1[2],p1[3]);
  #pragma unroll
  for(int r=4;r<16;r+=4){a=max3f(a,p0[r],p0[r+1]);b=max3f(b,p0[r+2],p0[r+3]);a=max3f(a,p1[r],p1[r+1]);b=max3f(b,p1[r+2],p1[r+3]);}
  const float m=max2f(a,b);
  auto rr=__builtin_amdgcn_permlane32_swap(__float_as_uint(m),__float_as_uint(m),false,false);
  return max2f(__uint_as_float(rr[0]),__uint_as_float(rr[1]));
}
__device__ __forceinline__ void pv(f32x16*o,int vb,bf16x8 pa0,bf16x8 pa1,bf16x8 pa2,bf16x8 pa3){
  #pragma unroll
  for(int d0=0;d0<2;++d0){s16x4 lo[4],hi[4];
    #pragma unroll
    for(int ks=0;ks<4;++ks){
      asm volatile("ds_read_b64_tr_b16 %0,%1 offset:%c2":"=&v"(lo[ks]):"v"(vb),"i"(d0*4096+ks*1024):"memory");
      asm volatile("ds_read_b64_tr_b16 %0,%1 offset:%c2":"=&v"(hi[ks]):"v"(vb),"i"(d0*4096+ks*1024+512):"memory");}
    asm volatile("s_waitcnt lgkmcnt(0)":::"memory");SBAR();
    #define PK(k) (bf16x8){lo[k][0],lo[k][1],lo[k][2],lo[k][3],hi[k][0],hi[k][1],hi[k][2],hi[k][3]}
    o[d0]=__builtin_amdgcn_mfma_f32_32x32x16_bf16(pa0,PK(0),o[d0],0,0,0);
    o[d0]=__builtin_amdgcn_mfma_f32_32x32x16_bf16(pa1,PK(1),o[d0],0,0,0);
    o[d0]=__builtin_amdgcn_mfma_f32_32x32x16_bf16(pa2,PK(2),o[d0],0,0,0);
    o[d0]=__builtin_amdgcn_mfma_f32_32x32x16_bf16(pa3,PK(3),o[d0],0,0,0);
    #undef PK
  }
}

#ifndef ATTN_STORE16
#define ATTN_STORE16(p,v) (*(u32x4*)(p)=(v))
#endif
template<int THRL> __device__ __forceinline__ void attn_unit(const bf16*Qu,const bf16*__restrict__ K0,const bf16*__restrict__ V0,const bf16*__restrict__ K1,const bf16*__restrict__ V1,int NT0,int NT,bf16*Ou,char*shm){
  int tid=threadIdx.x; asm volatile("":"+v"(tid)); const int lane=tid&63,r32=lane&31,hi=lane>>5; const int wid=__builtin_amdgcn_readfirstlane(tid>>6);
  const bf16*Qw=Qu+(long)(wid*QBLK)*QP;
  const unsigned lds0=(unsigned)(uintptr_t)shm;
  float*wsf=(float*)(shm+LDS_WS)+wid*64;
  const unsigned koff=(unsigned)(lane*KP+wid*8)*2u;
  const unsigned voff=(unsigned)((16*(wid&3)+(lane>>2))*KP+(wid>>2)*32+(lane&3)*8)*2u;
  const unsigned kdst=lds0+LDS_K+wid*1024, vdst=lds0+LDS_V+wid*1024;
  #define DMA_K(t,slot) glds16(((t)<NT0?K0+(long)(t)*KVBLK*KP:K1+(long)((t)-NT0)*KVBLK*KP),koff,(unsigned)__builtin_amdgcn_readfirstlane(kdst+(slot)))
  #define DMA_V(t,slot) glds16(((t)<NT0?V0+(long)(t)*KVBLK*KP:V1+(long)((t)-NT0)*KVBLK*KP),voff,(unsigned)__builtin_amdgcn_readfirstlane(vdst+(slot)))
  const int vb0=(int)(lds0+LDS_V)+((lane>>4)&1)*32+(lane&3)*8+(4*hi+((lane&15)>>2))*64;
  const char*Kbase=shm+LDS_K; bf16x8 kf[8];
  const lds_cptr shm3=(lds_cptr)shm; const lds_cptr kp0=shm3+LDS_K+hi*1024+r32*16; const lds_cptr vp0=shm3+LDS_V+((lane>>4)&1)*32+(lane&3)*8+(4*hi+((lane&15)>>2))*64;
  DMA_K(0,0);DMA_V(0,0);DMA_K(1,SLOTB);
  bf16x8 qr[4];
  #pragma unroll
  for(int d0=0;d0<4;++d0)qr[d0]=*reinterpret_cast<const bf16x8*>(&Qw[(long)r32*QP+d0*16+hi*8]);
  float mhat=0.f,l_reg=0.f;f32x16 o[2];o[0]=f32x16{};o[1]=f32x16{};
  #define CMASK(P0,P1,t) do{}while(0)
  bool resc=false;
  #define START(P0,P1) do{ const float rm=rowmax(P0,P1); resc=false; \
    { const float dl=rm; mhat=fadd_s(mhat,dl); \
      _Pragma("unroll") for(int r=0;r<16;++r){P0[r]=fsub_s(P0[r],dl);P1[r]=fsub_s(P1[r],dl);} \
 } \
    _Pragma("unroll") for(int r=0;r<16;++r)P0[r]=__builtin_amdgcn_exp2f(P0[r]); }while(0)
  #define RESC() do{ if(resc){ asm volatile("s_waitcnt lgkmcnt(0)":::"memory"); \
      _Pragma("unroll") for(int d_=0;d_<2;++d_) _Pragma("unroll") for(int r=0;r<16;++r)o[d_][r]*=wsf[crow(r,hi)]; } }while(0)
  f32x16 pA0,pA1,pB0,pB1;
  int sl_prev=0,sl_cur=0,sl_next=SLOTB;
  #define ROT() do{sl_prev=sl_cur;sl_cur=sl_next;sl_next=(sl_next==(NSLOT-1)*SLOTB)?0:sl_next+SLOTB;}while(0)
  DMA_K(2,2*SLOTB);
  WAIT_BAR(3);
  qkt(pA0,pA1,Kbase,qr,f32x16{},r32,hi);asm volatile("s_nop 15\n\ts_nop 7":"+v"(pA0),"+v"(pA1));CMASK(pA0,pA1,0);
  START(pA0,pA1);
  _Pragma("unroll") for(int r=0;r<16;++r)pA1[r]=__builtin_amdgcn_exp2f(pA1[r]);
  WAIT_BAR(0);
  DMA_K(3,0);DMA_V(1,SLOTB);
  ROT();
  kload8(kf,kp0+sl_cur);
  WAIT_BAR(2);
  s16x4 vlo[8],vhi[8]; u32x4 pw0,pw1,pw2,pw3;
  #define PKW(P,B) cvtpk_s(P[B],P[B+1])
  #define PAF(k) __builtin_bit_cast(bf16x8,pw##k)
  #define VFR(i) (bf16x8){vlo[i][0],vlo[i][1],vlo[i][2],vlo[i][3],vhi[i][0],vhi[i][1],vhi[i][2],vhi[i][3]}
  #define PIN(x) asm volatile("":"+v"(x))
  #define MX3(a,b,c) __builtin_fmaxf(__builtin_fmaxf((a),(b)),(c))
  #define GAPA(MF,A0,A1,A2,A3,W0,W1,PW) do{ MF; sacc+=A0; sacc+=A1; sacc+=A2; sacc+=A3; PIN(sacc); W0; W1; PIN(PW); SBAR(); }while(0)
  #define EX(v) __builtin_amdgcn_exp2f(v)
  #define GAPB(MF,X,B) do{ MF; X[B]=EX(X[B]); X[B+1]=EX(X[B+1]); X[B+2]=EX(X[B+2]); X[B+3]=EX(X[B+3]); PIN(X); SBAR(); }while(0)
  #define VRD(i) do{ vlo[i]=vtr(vp_+(((i)>>2)*4096+((i)&3)*1024)); vhi[i]=vtr(vp_+(((i)>>2)*4096+((i)&3)*1024+512)); }while(0)
  #define KRD(G,j) do{ if(G){ kload2(kf,kp0+sl_next,j); SBAR(); } }while(0)
  #define STEP(C0,C1,P0,P1,t,GK,GV,GL) do{ SBAR(); \
    const lds_cptr vp_=vp0+sl_prev; \
    VRD(0); SBAR(); float sacc=(P0[0]+P0[1]); \
    GAPA(C0=__builtin_amdgcn_mfma_f32_32x32x16_bf16(kf[0],qr[0],f32x16{},0,0,0), P0[2],P0[3],P0[4],P0[5],     pw0[0]=PKW(P0,0), pw0[1]=PKW(P0,2), pw0); \
    VRD(4); SBAR(); GAPA(C1=__builtin_amdgcn_mfma_f32_32x32x16_bf16(kf[1],qr[0],f32x16{},0,0,0), P0[6],P0[7],P0[8],P0[9],     pw0[2]=PKW(P0,4), pw0[3]=PKW(P0,6), pw0); \
    VRD(1); SBAR(); GAPA(C0=__builtin_amdgcn_mfma_f32_32x32x16_bf16(kf[2],qr[1],C0,0,0,0),   P0[10],P0[11],P0[12],P0[13], pw1[0]=PKW(P0,8), pw1[1]=PKW(P0,10), pw1); \
    VRD(5); SBAR(); GAPA(C1=__builtin_amdgcn_mfma_f32_32x32x16_bf16(kf[3],qr[1],C1,0,0,0),   P0[14],P0[15],P1[0],P1[1],   pw1[2]=PKW(P0,12),pw1[3]=PKW(P0,14), pw1); \
    VRD(2); SBAR(); GAPA(C0=__builtin_amdgcn_mfma_f32_32x32x16_bf16(kf[4],qr[2],C0,0,0,0),   P1[2],P1[3],P1[4],P1[5],     pw2[0]=PKW(P1,0), pw2[1]=PKW(P1,2), pw2); \
    VRD(6); SBAR(); GAPA(C1=__builtin_amdgcn_mfma_f32_32x32x16_bf16(kf[5],qr[2],C1,0,0,0),   P1[6],P1[7],P1[8],P1[9],     pw2[2]=PKW(P1,4), pw2[3]=PKW(P1,6), pw2); \
    VRD(3); SBAR(); GAPA(C0=__builtin_amdgcn_mfma_f32_32x32x16_bf16(kf[6],qr[3],C0,0,0,0),   P1[10],P1[11],P1[12],P1[13], pw3[0]=PKW(P1,8), pw3[1]=PKW(P1,10), pw3); \
    VRD(7); SBAR(); GAPA(C1=__builtin_amdgcn_mfma_f32_32x32x16_bf16(kf[7],qr[3],C1,0,0,0),   P1[14],P1[15],0.f,0.f,       pw3[2]=PKW(P1,12),pw3[3]=PKW(P1,14), pw3); \
    l_reg+=sacc; \
    if(GK){DMA_K((t)+3,sl_cur);} if(GV){DMA_V((t)+1,sl_next);} \
    _Pragma("unroll") for(int r=0;r<16;++r){C0[r]-=mhat;C1[r]-=mhat;} \
    { float a=MX3(C0[0],C0[1],C1[0]),b=MX3(C0[2],C0[3],C1[1]); a=MX3(a,C1[2],C1[3]); \
      _Pragma("unroll") for(int r=4;r<16;r+=4){a=MX3(a,C0[r],C0[r+1]);b=MX3(b,C0[r+2],C0[r+3]);a=MX3(a,C1[r],C1[r+1]);b=MX3(b,C1[r+2],C1[r+3]);} \
      float rm=__builtin_fmaxf(a,b); { auto rr=__builtin_amdgcn_permlane32_swap(__float_as_uint(rm),__float_as_uint(rm),false,false); rm=__builtin_fmaxf(__uint_as_float(rr[0]),__uint_as_float(rr[1])); } \
      resc=false; \
      if(__builtin_expect(__any(rm>(float)THRL),0)){ const float dl=__builtin_fmaxf(rm,0.f); mhat+=dl; \
        _Pragma("unroll") for(int r=0;r<16;++r){C0[r]-=dl;C1[r]-=dl;} \
        const float f=__builtin_amdgcn_exp2f(-dl); l_reg*=f; if(hi==0)wsf[r32]=f; resc=true; } } \
    SBAR(); \
    GAPB(o[0]=__builtin_amdgcn_mfma_f32_32x32x16_bf16(PAF(0),VFR(0),o[0],0,0,0), C0,0); \
    GAPB(o[1]=__builtin_amdgcn_mfma_f32_32x32x16_bf16(PAF(0),VFR(4),o[1],0,0,0), C0,4); \
    KRD(GL,0); GAPB(o[0]=__builtin_amdgcn_mfma_f32_32x32x16_bf16(PAF(1),VFR(1),o[0],0,0,0), C0,8); \
    KRD(GL,1); GAPB(o[1]=__builtin_amdgcn_mfma_f32_32x32x16_bf16(PAF(1),VFR(5),o[1],0,0,0), C0,12); \
    KRD(GL,2); GAPB(o[0]=__builtin_amdgcn_mfma_f32_32x32x16_bf16(PAF(2),VFR(2),o[0],0,0,0), C1,0); \
    KRD(GL,3); GAPB(o[1]=__builtin_amdgcn_mfma_f32_32x32x16_bf16(PAF(2),VFR(6),o[1],0,0,0), C1,4); \
    GAPB(o[0]=__builtin_amdgcn_mfma_f32_32x32x16_bf16(PAF(3),VFR(3),o[0],0,0,0), C1,8); \
    GAPB(o[1]=__builtin_amdgcn_mfma_f32_32x32x16_bf16(PAF(3),VFR(7),o[1],0,0,0), C1,12); \
    }while(0)
  int t=1;
  #undef CMASK
  #define CMASK(P0,P1,t) do{}while(0)
  for(;t+5<NT;t+=2){
    STEP(pB0,pB1,pA0,pA1,t,true,true,true);     WAIT_BAR(2); RESC(); ROT();
    STEP(pA0,pA1,pB0,pB1,t+1,true,true,true);   WAIT_BAR(2); RESC(); ROT();
  }
  #undef CMASK
  #define CMASK(P0,P1,t) do{}while(0)
  #define ENDW(tt) do{ if((tt)+3<NT){WAIT_BAR(2);} else if((tt)+2<NT){WAIT_BAR(1);} else {WAIT_BAR(0);} }while(0)
  for(;t+1<NT;t+=2){
    STEP(pB0,pB1,pA0,pA1,t,(t+3<NT),(t+1<NT),(t+1<NT));       ENDW(t);   RESC(); ROT();
    STEP(pA0,pA1,pB0,pB1,t+1,(t+4<NT),(t+2<NT),(t+2<NT));     ENDW(t+1); RESC(); ROT();
  }
  STEP(pB0,pB1,pA0,pA1,NT-1,false,false,false); RESC();
  { float sacc=pB0[0]+pB0[1]; _Pragma("unroll") for(int r=2;r<16;++r)sacc+=pB0[r]; _Pragma("unroll") for(int r=0;r<16;++r)sacc+=pB1[r]; l_reg+=sacc;
    pw0=(u32x4){PKW(pB0,0),PKW(pB0,2),PKW(pB0,4),PKW(pB0,6)};pw1=(u32x4){PKW(pB0,8),PKW(pB0,10),PKW(pB0,12),PKW(pB0,14)};pw2=(u32x4){PKW(pB1,0),PKW(pB1,2),PKW(pB1,4),PKW(pB1,6)};pw3=(u32x4){PKW(pB1,8),PKW(pB1,10),PKW(pB1,12),PKW(pB1,14)};
    SBAR(); pv(o,vb0+sl_cur,PAF(0),PAF(1),PAF(2),PAF(3)); }
  #undef PKW
  #undef PAF
  #undef VFR
  #undef PIN
  #undef MX3
  #undef GAPA
  #undef GAPB
  #undef EX
  #undef VRD
  #undef KRD
  #undef STEP
  #undef ENDW
  {auto rr=__builtin_amdgcn_permlane32_swap(__float_as_uint(l_reg),__float_as_uint(l_reg),false,false);l_reg=__uint_as_float(rr[0])+__uint_as_float(rr[1]);}
  if(hi==0)wsf[32+r32]=l_reg;asm volatile("s_waitcnt lgkmcnt(0)":::"memory");
  float rli[16];
  #pragma unroll
  for(int r=0;r<16;++r)rli[r]=__builtin_amdgcn_rcpf(wsf[32+crow(r,hi)]);
  bf16*Ow=Ou+(long)(wid*QBLK)*OP;
  { bf16*stg=(bf16*)(shm+LDS_OST)+wid*2048;
    #pragma unroll
    for(int r=0;r<16;++r){const int orow=crow(r,hi);
      #pragma unroll
      for(int d0=0;d0<2;++d0)stg[orow*64+d0*32+r32]=__float2bfloat16(o[d0][r]*rli[r]);}
    asm volatile("s_waitcnt lgkmcnt(0)":::"memory");
    #pragma unroll
    for(int i=0;i<4;++i){const int row=i*8+(lane>>3),ch=lane&7; const u32x4 v=*(const u32x4*)(stg+row*64+ch*8); ATTN_STORE16(Ow+(long)row*OP+ch*8,v);} }
  asm volatile("s_waitcnt lgkmcnt(0)\n\ts_barrier":::"memory");
  #undef DMA_K
  #undef DMA_V
  #undef CMASK
  #undef START
  #undef RESC
  #undef ROT
}
constexpr int ATTN_LDS_BYTES=LDS_BYTES;
#undef SBAR
#undef WAIT_BAR
}
#define DI __device__ __forceinline__
#define LAS __attribute__((address_space(3)))
typedef unsigned short bf16_t;
typedef short bf16x8 __attribute__((ext_vector_type(8)));
typedef float f32x4 __attribute__((ext_vector_type(4)));
typedef unsigned u32x4 __attribute__((ext_vector_type(4)));
typedef unsigned u32x2 __attribute__((ext_vector_type(2)));
typedef unsigned long long u64;
typedef unsigned long long u64x2 __attribute__((ext_vector_type(2)));

constexpr int NB = 8, SEQ = 4096, DM = 1024, CTX = 256, DFF = 2816, DIN = 2336, DINP = 2560, KSEQ = 4352, NCHUNK = 68;
constexpr int TX = NB * SEQ, TZ = NB * CTX, TT = TX + TZ;
constexpr float EPS = 1e-6f;
constexpr float QSCALE = 0.125f * 1.4426950408889634f;
constexpr float LOG2E = 1.4426950408889634f;
constexpr int C_FOUR = 0, C_NAQ = 256, C_NAK = 512, C_NAV = 768, C_GLQ = 1024, C_GLK = 1152, C_GLV = 1280, C_GLR = 1536, C_GF = 1792, C_GB = 1808, C_GQQ = 1824, C_GQK = 2080, C_GQV = 2208;
constexpr int C_GLQB = 768, C_GLKB = 896;

constexpr size_t MiB = 1u << 20;
constexpr size_t WS_W = 0;
constexpr size_t W_UP1 = 0, W_DN1 = 11 * MiB, W_IN = W_DN1 + 5 * MiB + MiB / 2, W_OUT = W_IN + 5 * MiB, W_UP2 = W_OUT + 2 * MiB, W_DN2 = W_UP2 + 11 * MiB, W_LAYER = 40 * MiB;
constexpr size_t WS_MOD = 80 * MiB;
constexpr size_t WS_TAB = 81 * MiB;
constexpr size_t T_FC64 = 0, T_FS64 = 8192, T_FSN64 = 16384, T_TW = 32768, T_ROPE = 65536, T_FC256 = 131072, T_FS256 = 262144, T_FSN256 = 393216;
constexpr size_t WS_Z = 82 * MiB;
constexpr size_t WS_HN = 90 * MiB;
constexpr size_t WS_HB = 158 * MiB;
constexpr size_t WS_NAVT = 345 * MiB;
constexpr size_t WS_GVT = WS_NAVT + 17 * MiB;
constexpr size_t WS_GLVT = WS_GVT + 9 * MiB;
constexpr size_t WS_KKT = WS_GLVT + 17 * MiB;
constexpr size_t WS_SLOC = WS_KKT + 17 * MiB;
constexpr size_t WS_SST = WS_SLOC + 34 * MiB;
constexpr size_t WS_TTR = WS_SST + 17 * MiB;
constexpr size_t WS_TTI = WS_TTR + 16 * MiB;
constexpr size_t WS_BLAST = WS_TTI + 16 * MiB;
constexpr size_t WS_ROWSS = WS_BLAST + 1 * MiB;
constexpr size_t WS_SB = WS_ROWSS + 1 * MiB;
constexpr int SB_UP1 = 0, SB_IN = 9 * 5632, SB_UP2 = 9 * (5632 + 2560), SB_LAYER = 9 * (5632 + 2560 + 5632);
constexpr size_t WS_BAR = WS_SB + 2 * MiB;
constexpr size_t WS_END = WS_BAR + 1 * MiB;
constexpr int LDS_PREF = 131072 + 1024; static_assert(LDS_PREF == (int)pg8::PREF_LDS_ADDR, "prefetch slots");
constexpr int LDS_BARST = 131072 + 256;
static_assert(WS_END <= 512 * MiB, "workspace map");
static_assert(WS_HB + (size_t)TT * DFF * 2 <= WS_NAVT && WS_HN + (size_t)TT * DM * 2 <= WS_HB, "workspace map 2");
constexpr int LDS_BYTES = 147456;
#ifndef REP_NA
#define REP_NA 1
#endif
#ifndef REP_F2
#define REP_F2 1
#endif
#ifndef REP_SYNC
#define REP_SYNC 0
#endif
#ifndef REP_PRO
#define REP_PRO 1
#endif
#ifndef REP_S2
#define REP_S2 1
#endif
#ifndef REP_S3
#define REP_S3 1
#endif
#ifndef REP_S4
#define REP_S4 1
#endif
#ifndef REP_UP
#define REP_UP 1
#endif
#ifndef REP_NORM
#define REP_NORM 1
#endif
#ifndef DIAG_MODE
#define DIAG_MODE 0
#endif
#ifndef DIAG_A
#define DIAG_A 2
#define DIAG_B 7
#endif

struct Params { const float* in[24]; float* out; unsigned char* ws; };
#define XB_TMO      128
#define XB_XCNT(j)  (256  + 64 * (j))
#define XB_XSUB(j)  (1280 + 64 * (j))
#define XB_XGEN(j)  (2304 + 64 * (j))
#define XB_TOP      3328
#define XB_TOPGEN   3392
#define XCD_BAR_WORDS 3456
#define XB_SPIN_CAP (1u << 18)

__device__ __forceinline__ unsigned xb_ld(unsigned* p)              { return __hip_atomic_load(p, __ATOMIC_RELAXED, __HIP_MEMORY_SCOPE_AGENT); }
__device__ __forceinline__ unsigned xb_add(unsigned* p, unsigned v) { return __hip_atomic_fetch_add(p, v, __ATOMIC_RELAXED, __HIP_MEMORY_SCOPE_AGENT); }
__device__ __forceinline__ unsigned xb_xcc_id() { return (unsigned)__builtin_amdgcn_s_getreg((3 << 11) | 20) & 0xFu; }
#define XB_SPIN(cond, bar) do { unsigned _sp = 0; while (cond) { __builtin_amdgcn_s_sleep(1); \
    if ((++_sp & 255u) == 0u) { if (xb_ld(&(bar)[XB_TMO])) break; if (_sp > XB_SPIN_CAP) { atomicAdd(&(bar)[XB_TMO], 1u); break; } } } } while (0)

struct XcdBarrier {
    unsigned* bar; unsigned x;
    volatile LAS unsigned* st;
};

__device__ __forceinline__ XcdBarrier xcd_barrier_post(unsigned* bar, volatile LAS unsigned* st) {
    XcdBarrier b; b.bar = bar; b.x = xb_xcc_id(); b.st = st;
    if (threadIdx.x == 0) (void)xb_add(&bar[XB_XCNT(b.x)], 1u);
    return b;
}
__device__ __forceinline__ void xcd_barrier_complete(unsigned* bar, unsigned x, unsigned& nloc, unsigned& nx) {
    const unsigned G = gridDim.x * gridDim.y * gridDim.z;
    unsigned sum, cnt, mine, sp = 0u;
    for (;;) {
        sum = 0u; cnt = 0u; mine = 0u;
#pragma unroll
        for (unsigned j = 0; j < 16; ++j) { const unsigned c = xb_ld(&bar[XB_XCNT(j)]); sum += c; cnt += (c > 0u) ? 1u : 0u; mine = (j == x) ? c : mine; }
        if (sum == G) break;
        __builtin_amdgcn_s_sleep(1);
        if ((++sp & 255u) == 0u) { if (xb_ld(&bar[XB_TMO])) break; if (sp > XB_SPIN_CAP) { atomicAdd(&bar[XB_TMO], 1u); break; } }
    }
    nloc = mine > 0u ? mine : 1u; nx = cnt > 0u ? cnt : 1u;
}

__device__ __forceinline__ void xcd_barrier(const XcdBarrier& b) {
    asm volatile("s_waitcnt vmcnt(0)" ::: "memory");
    __syncthreads();
    if (threadIdx.x == 0) {
        unsigned* bar = b.bar;
        __builtin_amdgcn_s_waitcnt(0);
        unsigned nloc = b.st[0], nx = b.st[1];
        if (nloc == 0u) { xcd_barrier_complete(bar, b.x, nloc, nx); b.st[0] = nloc; b.st[1] = nx; }
        const unsigned old = xb_add(&bar[XB_XSUB(b.x)], 1u);
        const unsigned gen = old / nloc;
        if (old + 1u == (gen + 1u) * nloc) {
            __builtin_amdgcn_fence(__ATOMIC_RELEASE, "agent");
            asm volatile("s_waitcnt vmcnt(0)" ::: "memory");
            const unsigned og = xb_add(&bar[XB_TOP], 1u);
            const unsigned tg = og / nx;
            if (og + 1u == (tg + 1u) * nx) xb_add(&bar[XB_TOPGEN], 1u);
            else XB_SPIN(xb_ld(&bar[XB_TOPGEN]) == tg, bar);
            __builtin_amdgcn_fence(__ATOMIC_ACQUIRE, "agent");
            xb_add(&bar[XB_XGEN(b.x)], 1u);
            asm volatile("s_waitcnt vmcnt(0)" ::: "memory");
        } else {
            XB_SPIN(xb_ld(&bar[XB_XGEN(b.x)]) == gen, bar);
            __builtin_amdgcn_fence(__ATOMIC_ACQUIRE, "agent");
            asm volatile("s_waitcnt vmcnt(0)" ::: "memory");
        }
    }
    __syncthreads();
}
__device__ __attribute__((noinline)) void grid_bar_fn(unsigned* bar, unsigned st_addr) { XcdBarrier xb_; xb_.bar = bar; xb_.x = xb_xcc_id(); xb_.st = (volatile LAS unsigned*)(size_t)st_addr; xcd_barrier(xb_); }

DI float bf2f(bf16_t h) { return __uint_as_float(((unsigned)h) << 16); }
DI unsigned pk2(float lo, float hi) { return pg8::cvt_pk_bf16(lo, hi); }
DI bf16_t f2bf(float f) { return (bf16_t)(pk2(f, 0.f) & 0xffffu); }
DI bf16x8 ld16(const bf16_t* p) { return *(const bf16x8*)p; }
DI u64 ld8(const bf16_t* p) { return *(const u64*)p; }
DI bf16x8 cat8(u64 a, u64 b) { u64x2 v = {a, b}; return __builtin_bit_cast(bf16x8, v); }
DI bf16x8 pack8(const f32x4& a, const f32x4& b) { u32x4 w; w.x = pk2(a[0], a[1]); w.y = pk2(a[2], a[3]); w.z = pk2(b[0], b[1]); w.w = pk2(b[2], b[3]); return __builtin_bit_cast(bf16x8, w); }
DI bf16x8 neg8(bf16x8 v) { u32x4 w = __builtin_bit_cast(u32x4, v); w ^= 0x80008000u; return __builtin_bit_cast(bf16x8, w); }
#define MFMA16(a, b, c) __builtin_amdgcn_mfma_f32_16x16x32_bf16((a), (b), (c), 0, 0, 0)
template <int M> DI float swz_xor(float v) { return __int_as_float(__builtin_amdgcn_ds_swizzle(__float_as_int(v), (M << 10) | 0x1F)); }
DI float half_sum(float v) { auto rr = __builtin_amdgcn_permlane32_swap(__float_as_uint(v), __float_as_uint(v), false, false); return __uint_as_float(rr[0]) + __uint_as_float(rr[1]); }
DI float half_max(float v) { auto rr = __builtin_amdgcn_permlane32_swap(__float_as_uint(v), __float_as_uint(v), false, false); return fmaxf(__uint_as_float(rr[0]), __uint_as_float(rr[1])); }
DI float quad_sum(float v) { v += swz_xor<16>(v); return half_sum(v); }
DI float quad_max(float v) { v = fmaxf(v, swz_xor<16>(v)); return half_max(v); }

DI void transpose_item(const float* W, int K, int N, bf16_t* WT, int mode, LAS float* scr, int item, int lane) {
    const int nblk = N / 32, kb = item / nblk, nb = item % nblk, k0 = 64 * kb, n0 = 32 * nb;
    { const int kr = lane >> 3, nq = lane & 7;
      f32x4 wv[8];
#pragma unroll
      for (int i = 0; i < 8; ++i) wv[i] = *(const f32x4*)(W + (size_t)(k0 + 8 * i + kr) * N + n0 + 4 * nq);
#pragma unroll
      for (int i = 0; i < 8; ++i) { LAS float* d = scr + (8 * i + kr) * 33 + 4 * nq; d[0] = wv[i][0]; d[1] = wv[i][1]; d[2] = wv[i][2]; d[3] = wv[i][3]; } }
    asm volatile("s_waitcnt lgkmcnt(0)" ::: "memory");
    const int c = lane & 7;
    const int d0 = (mode == 0) ? n0 : ((n0 >> 7) * 256 + (n0 & 127) + (mode == 2 ? 128 : 0));
#pragma unroll
    for (int j = 0; j < 4; ++j) { const int n = (lane >> 3) + 8 * j; const LAS float* s = scr + (8 * c) * 33 + n;
        u32x4 o; o.x = pk2(s[0 * 33], s[1 * 33]); o.y = pk2(s[2 * 33], s[3 * 33]); o.z = pk2(s[4 * 33], s[5 * 33]); o.w = pk2(s[6 * 33], s[7 * 33]);
        *(u32x4*)(WT + (size_t)(d0 + n) * K + k0 + 8 * c) = o; }
    asm volatile("s_waitcnt lgkmcnt(0)" ::: "memory");
}

template <bool FIRST> DI void phase_prologue(const Params& p, LAS unsigned char* lds, int tid, int lane, int wave, int bid, int G, int l_lo, int l_hi) {
    constexpr bool first = FIRST;
    const int gw = bid * 8 + wave, NGW = G * 8;
    unsigned char* ws = p.ws;
    {
        LAS float* scr = (LAS float*)(lds + wave * 8704);
        constexpr int I_UP = 16 * 88, I_DN = 44 * 32, I_IN = 16 * 73, I_OUT = 16 * 32;
        constexpr int PER_L = 4 * I_UP + 2 * I_DN + I_IN + I_OUT;
        for (int it = gw; it < (l_hi - l_lo) * PER_L; it += NGW) {
            const int l = l_lo + it / PER_L; int r = it % PER_L;
            bf16_t* wl = (bf16_t*)(ws + WS_W + (size_t)l * W_LAYER);
            if (r < I_UP) { transpose_item(p.in[6] + (size_t)l * DM * DFF, DM, DFF, (bf16_t*)((unsigned char*)wl + W_UP1), 1, scr, r, lane); continue; } r -= I_UP;
            if (r < I_UP) { transpose_item(p.in[7] + (size_t)l * DM * DFF, DM, DFF, (bf16_t*)((unsigned char*)wl + W_UP1), 2, scr, r, lane); continue; } r -= I_UP;
            if (r < I_DN) { transpose_item(p.in[8] + (size_t)l * DM * DFF, DFF, DM, (bf16_t*)((unsigned char*)wl + W_DN1), 0, scr, r, lane); continue; } r -= I_DN;
            if (r < I_IN) { transpose_item(p.in[9] + (size_t)l * DM * DIN, DM, DIN, (bf16_t*)((unsigned char*)wl + W_IN), 0, scr, r, lane); continue; } r -= I_IN;
            if (r < I_OUT) { transpose_item(p.in[20] + (size_t)l * DM * DM, DM, DM, (bf16_t*)((unsigned char*)wl + W_OUT), 0, scr, r, lane); continue; } r -= I_OUT;
            if (r < I_UP) { transpose_item(p.in[21] + (size_t)l * DM * DFF, DM, DFF, (bf16_t*)((unsigned char*)wl + W_UP2), 1, scr, r, lane); continue; } r -= I_UP;
            if (r < I_UP) { transpose_item(p.in[22] + (size_t)l * DM * DFF, DM, DFF, (bf16_t*)((unsigned char*)wl + W_UP2), 2, scr, r, lane); continue; } r -= I_UP;
            transpose_item(p.in[23] + (size_t)l * DM * DFF, DFF, DM, (bf16_t*)((unsigned char*)wl + W_DN2), 0, scr, r, lane);
        }
        const int gt = bid * 512 + tid, NT = G * 512;
        for (int i = gt; i < (l_hi - l_lo) * (DINP - DIN) * DM / 8; i += NT) { const int l = l_lo + i / ((DINP - DIN) * DM / 8), r = i % ((DINP - DIN) * DM / 8);
            *(u32x4*)((bf16_t*)(ws + WS_W + (size_t)l * W_LAYER + W_IN) + (size_t)DIN * DM + (size_t)r * 8) = (u32x4){0u, 0u, 0u, 0u}; }
        if (first) {
        for (int i = gt; i < 5 * TT; i += NT) ((float*)(ws + WS_ROWSS))[TT + i] = 0.f;
        unsigned char* tab = ws + WS_TAB;
        for (int i = gt; i < 4096; i += NT) { const int a = i >> 6, b = i & 63; const float x = (float)((a * b) & 63) * (1.0f / 32.0f);
            const float c = cospif(x), s = sinpif(x);
            ((bf16_t*)(tab + T_FC64))[i] = f2bf(c); ((bf16_t*)(tab + T_FS64))[i] = f2bf(s); ((bf16_t*)(tab + T_FSN64))[i] = f2bf(-s);
            const float y = (float)(a * b) * (1.0f / 2048.0f);
            ((float*)(tab + T_TW))[2 * i] = cospif(y); ((float*)(tab + T_TW))[2 * i + 1] = sinpif(y); }
        for (int i = gt; i < 65536; i += NT) { const int a = i >> 8, b = i & 255; const float x = (float)((a * b) & 255) * (1.0f / 128.0f);
            const float c = cospif(x), s = sinpif(x);
            ((bf16_t*)(tab + T_FC256))[i] = f2bf(c); ((bf16_t*)(tab + T_FS256))[i] = f2bf(s); ((bf16_t*)(tab + T_FSN256))[i] = f2bf(-s); }
        for (int i = gt; i < 1024; i += NT) { const int pp = i >> 4, f = i & 15; const float inv = powf(10000.0f, -(float)f / 16.0f); const float ang = (float)pp * inv;
            ((float*)(tab + T_ROPE))[2 * i] = cosf(ang); ((float*)(tab + T_ROPE))[2 * i + 1] = sinf(ang); }
        }
    }
    if (!FIRST) return;
    __syncthreads();
    {
        LAS float* S = (LAS float*)lds;
        LAS float* red = (LAS float*)(lds + 9 * 1024 * 4);
        for (int i = tid; i < 9 * 1024; i += 512) { const int r = i >> 10, k = i & 1023; const float v = (r < 8) ? p.in[1][r * 1024 + k] : p.in[3][k]; S[i] = v / (1.0f + __expf(-v)); }
        __syncthreads();
        for (int it = bid; it < 2 * 144; it += G) {
            const int l = it / 144, nb = it % 144, n = nb * 64 + lane;
            const float* W = p.in[4] + (size_t)l * DM * 9216 + n;
            float acc[9];
#pragma unroll
            for (int r = 0; r < 9; ++r) acc[r] = 0.f;
            const int kbeg = wave * 128;
#pragma unroll 8
            for (int k = 0; k < 128; ++k) { const float w = W[(size_t)(kbeg + k) * 9216];
#pragma unroll
                for (int r = 0; r < 9; ++r) acc[r] += S[r * 1024 + kbeg + k] * w; }
#pragma unroll
            for (int r = 0; r < 9; ++r) red[(wave * 9 + r) * 64 + lane] = acc[r];
            __syncthreads();
            for (int i = tid; i < 9 * 64; i += 512) { const int r = i >> 6, c = i & 63; float s = 0.f;
#pragma unroll
                for (int w = 0; w < 8; ++w) s += red[(w * 9 + r) * 64 + c];
                const int nn = nb * 64 + c;
                ((float*)(ws + WS_MOD))[((size_t)l * 9 + r) * 9216 + nn] = s + p.in[5][(size_t)l * 9216 + nn]; }
            __syncthreads();
        }
    }
}

DI void scale_pass(const float* xx, const float* xz, const float* mod  , int iscale, bf16_t* HN, float* rowss, int nrows, int gw, int NGW, int lane) {
    for (int row = gw; row < nrows; row += NGW) {
        const bool isx = row < TX; const int mi = isx ? (row >> 12) : 8;
        const float* src = isx ? xx + (size_t)row * DM : xz + (size_t)(row - TX) * DM;
        const float* sc = mod + (size_t)mi * 9216 + iscale * 1024;
        f32x4 v[4]; float ss = 0.f;
#pragma unroll
        for (int j = 0; j < 4; ++j) { v[j] = *(const f32x4*)(src + 4 * lane + 256 * j); ss += (v[j][0] * v[j][0] + v[j][1] * v[j][1]) + (v[j][2] * v[j][2] + v[j][3] * v[j][3]); }
        ss += swz_xor<1>(ss); ss += swz_xor<2>(ss); ss += swz_xor<4>(ss); ss += swz_xor<8>(ss); ss += swz_xor<16>(ss); ss = half_sum(ss);
        if (lane == 0) rowss[row] = ss;
#pragma unroll
        for (int j = 0; j < 4; ++j) { const f32x4 a = *(const f32x4*)(sc + 4 * lane + 256 * j);
            const f32x4 y = v[j] * (a + 1.0f); u32x2 w; w.x = pk2(y[0], y[1]); w.y = pk2(y[2], y[3]);
            *(u32x2*)(HN + (size_t)row * DM + 4 * lane + 256 * j) = w; }
    }
}
DI void shift_bias_pass(unsigned char* ws, int gw, int NGW, int lane, int l, int n_lo, int n_hi) {
    for (int it = n_lo + gw; it < n_hi; it += NGW) {
        int n = it; int g, N; size_t woff, sboff;
        if (n < 5632) { g = 0; N = 5632; woff = W_UP1; sboff = SB_UP1; } else if (n < 5632 + 2560) { g = 1; N = 2560; n -= 5632; woff = W_IN; sboff = SB_IN; } else { g = 2; N = 5632; n -= 5632 + 2560; woff = W_UP2; sboff = SB_UP2; }
        const bf16_t* wrow = (const bf16_t*)(ws + WS_W + (size_t)l * W_LAYER + woff) + (size_t)n * DM + 16 * lane;
        const bf16x8 w0 = ld16(wrow), w1 = ld16(wrow + 8);
        float wf[16];
#pragma unroll
        for (int j = 0; j < 8; ++j) { wf[j] = bf2f((bf16_t)w0[j]); wf[8 + j] = bf2f((bf16_t)w1[j]); }
        const float* modl = (const float*)(ws + WS_MOD) + (size_t)l * 9 * 9216 + (3 * g) * 1024 + 16 * lane;
        float* sb = (float*)(ws + WS_SB) + (size_t)l * SB_LAYER + sboff;
#pragma unroll
        for (int mi = 0; mi < 9; ++mi) { float s = 0.f;
#pragma unroll
            for (int j4 = 0; j4 < 4; ++j4) { const f32x4 sh = *(const f32x4*)(modl + (size_t)mi * 9216 + 4 * j4); s += (sh[0] * wf[4 * j4] + sh[1] * wf[4 * j4 + 1]) + (sh[2] * wf[4 * j4 + 2] + sh[3] * wf[4 * j4 + 3]); }
            s += swz_xor<1>(s); s += swz_xor<2>(s); s += swz_xor<4>(s); s += swz_xor<8>(s); s += swz_xor<16>(s); s = half_sum(s);
            if (lane == 0) sb[(size_t)mi * N + n] = s; }
    }
}

DI void norm_pass(const float* xx, const float* xz, const float* mod  , int ishift, int iscale, bf16_t* HN, int nrows, int gw, int NGW, int lane) {
    for (int row = gw; row < nrows; row += NGW) {
        const bool isx = row < TX; const int mi = isx ? (row >> 12) : 8;
        const float* src = isx ? xx + (size_t)row * DM : xz + (size_t)(row - TX) * DM;
        const float* sh = mod + (size_t)mi * 9216 + ishift * 1024; const float* sc = mod + (size_t)mi * 9216 + iscale * 1024;
        f32x4 v[4]; float ss = 0.f;
#pragma unroll
        for (int j = 0; j < 4; ++j) { v[j] = *(const f32x4*)(src + 4 * lane + 256 * j); ss += (v[j][0] * v[j][0] + v[j][1] * v[j][1]) + (v[j][2] * v[j][2] + v[j][3] * v[j][3]); }
        ss += swz_xor<1>(ss); ss += swz_xor<2>(ss); ss += swz_xor<4>(ss); ss += swz_xor<8>(ss); ss += swz_xor<16>(ss); ss = half_sum(ss);
        const float rstd = rsqrtf(ss * (1.0f / DM) + EPS);
#pragma unroll
        for (int j = 0; j < 4; ++j) { const f32x4 a = *(const f32x4*)(sc + 4 * lane + 256 * j), b = *(const f32x4*)(sh + 4 * lane + 256 * j);
            const f32x4 y = v[j] * rstd * (a + 1.0f) + b; u32x2 w; w.x = pk2(y[0], y[1]); w.y = pk2(y[2], y[3]);
            *(u32x2*)(HN + (size_t)row * DM + 4 * lane + 256 * j) = w; }
    }
}

DI void shift_bias_mfma(unsigned char* ws, int gw, int NGW, int lane) {
    const int c16 = lane & 15, quad = lane >> 4;
    constexpr int NBLK = (5632 + 2560 + 5632) / 16;
    for (int it = gw; it < 2 * NBLK; it += NGW) {
        const int l = it / NBLK; int n0 = (it % NBLK) * 16; int g, N; size_t woff, sboff;
        if (n0 < 5632) { g = 0; N = 5632; woff = W_UP1; sboff = SB_UP1; } else if (n0 < 5632 + 2560) { g = 1; N = 2560; n0 -= 5632; woff = W_IN; sboff = SB_IN; } else { g = 2; N = 5632; n0 -= 5632 + 2560; woff = W_UP2; sboff = SB_UP2; }
        const bf16_t* wrow = (const bf16_t*)(ws + WS_W + (size_t)l * W_LAYER + woff) + (size_t)(n0 + c16) * DM + quad * 8;
        const float* shp = (const float*)(ws + WS_MOD) + (size_t)l * 9 * 9216 + (3 * g) * 1024 + (size_t)min(c16, 8) * 9216 + quad * 8;
        f32x4 acc = {0.f, 0.f, 0.f, 0.f};
#pragma unroll 8
        for (int ks = 0; ks < 32; ++ks) { const bf16x8 a = ld16(wrow + 32 * ks); const f32x4 s0 = *(const f32x4*)(shp + 32 * ks), s1 = *(const f32x4*)(shp + 32 * ks + 4);
            bf16x8 b = pack8(s0, s1); if (c16 >= 9) b = (bf16x8){0, 0, 0, 0, 0, 0, 0, 0};
            acc = MFMA16(a, b, acc); }
        if (c16 < 9) *(f32x4*)((float*)(ws + WS_SB) + (size_t)l * SB_LAYER + sboff + (size_t)c16 * N + n0 + quad * 4) = acc;
    }
}
DI void z_finalize(unsigned char* ws, const float* zin, const float* gate8  , bf16_t* hnz  , const float* nscale8, float* rowssz, int gw, int NGW, int lane) {
    const float* part = (const float*)(ws + WS_TTR);
    float* ZB = (float*)(ws + WS_Z);
    for (int r = gw; r < TZ; r += NGW) {
        float ss = 0.f;
#pragma unroll
        for (int j = 0; j < 4; ++j) { const size_t o = (size_t)r * DM + 4 * lane + 256 * j;
            f32x4 a = *(const f32x4*)(part + o);
#pragma unroll
            for (int s = 1; s < 4; ++s) a += *(const f32x4*)(part + (size_t)s * TZ * DM + o);
            const f32x4 g = *(const f32x4*)(gate8 + 4 * lane + 256 * j), zi = *(const f32x4*)(zin + o);
            const f32x4 zn = zi + g * 0.5f * a;
            *(f32x4*)(ZB + o) = zn;
            if (hnz) { const f32x4 sc = *(const f32x4*)(nscale8 + 4 * lane + 256 * j) + 1.0f; const f32x4 y = zn * sc; u32x2 w; w.x = pk2(y[0], y[1]); w.y = pk2(y[2], y[3]); *(u32x2*)(hnz + o) = w;
                ss += (zn[0] * zn[0] + zn[1] * zn[1]) + (zn[2] * zn[2] + zn[3] * zn[3]); } }
        if (hnz) { ss += swz_xor<1>(ss); ss += swz_xor<2>(ss); ss += swz_xor<4>(ss); ss += swz_xor<8>(ss); ss += swz_xor<16>(ss); ss = half_sum(ss); if (lane == 0) rowssz[r] = ss; }
    }
}

DI float log_sigmoid(float x) { return fminf(x, 0.f) - __logf(1.0f + __expf(-fabsf(x))); }

template <bool ROPE> DI void prep_vec(u32x2 raw, bf16_t* ptr, const float* gain, float scale, bool rp, int li, int gr, int t, const LAS float* ropeL) {
    float x[4] = {__uint_as_float(raw.x << 16), __uint_as_float(raw.x & 0xffff0000u), __uint_as_float(raw.y << 16), __uint_as_float(raw.y & 0xffff0000u)};
    float ss = (x[0] * x[0] + x[1] * x[1]) + (x[2] * x[2] + x[3] * x[3]);
    ss += swz_xor<1>(ss); ss += swz_xor<2>(ss); ss += swz_xor<4>(ss); ss += swz_xor<8>(ss);
    const float rstd = rsqrtf(ss * (1.0f / 64.0f) + EPS);
    const f32x4 g = *(const f32x4*)(gain + 4 * li);
    float o[4];
#pragma unroll
    for (int j = 0; j < 4; ++j) { const float y = x[j] * rstd * g[j];
        if (ROPE) { const float partner = swz_xor<8>(y);
            const int d = 4 * li + j, i = d & 31; const int pp = (i < 16) ? gr : t, f = i & 15;
            const float cs = ropeL[2 * (pp * 16 + f)], sn = ropeL[2 * (pp * 16 + f) + 1];
            const float rot = (li < 8) ? (y * cs - partner * sn) : (partner * sn + y * cs);
            o[j] = (rp ? rot : y) * scale; }
        else o[j] = y * scale; }
    u32x2 w; w.x = pk2(o[0], o[1]); w.y = pk2(o[2], o[3]);
    *(u32x2*)ptr = w;
}

DI void gla_local_unit(unsigned char* ws, int u, int lane);
DI void prep_tile(const Params& p, int l, int tile, LAS unsigned char* lds, int tid) {
    unsigned char* ws = p.ws;
    bf16_t* HX = (bf16_t*)(ws + WS_HB);
    int b, row0, pos0, gr; bool isx;
    if (tile < 512) { b = tile >> 6; gr = tile & 63; row0 = b * SEQ + 64 * gr; pos0 = 64 * gr; isx = true; }
    else { const int tz = tile - 512; b = tz >> 2; gr = tz & 3; row0 = TX + b * CTX + 64 * gr; pos0 = SEQ + 64 * gr; isx = false; }
    const LAS float* ropeL = (const LAS float*)(lds + 65536);
    {
        const int li = tid & 15, jg = tid >> 4;
#pragma unroll
        for (int hb = 0; hb < 2; ++hb) {
            const int t = hb * 32 + jg;
            bf16_t* rowp = HX + (size_t)(row0 + t) * DINP + 4 * li;
            u32x2 raw[14];
#pragma unroll
            for (int v = 0; v < 14; ++v) { const int col = (v < 4) ? C_NAQ + 64 * v : (v < 8) ? C_NAK + 64 * (v - 4) : (v < 12) ? C_GQQ + 64 * (v - 8) : C_GQK + 64 * (v - 12);
                raw[v] = *(const u32x2*)(rowp + col); }
#pragma unroll
            for (int v = 0; v < 14; ++v) { const int col = (v < 4) ? C_NAQ + 64 * v : (v < 8) ? C_NAK + 64 * (v - 4) : (v < 12) ? C_GQQ + 64 * (v - 8) : C_GQK + 64 * (v - 12);
                if (v < 4) prep_vec<false>(raw[v], rowp + col, p.in[10] + l * 64, QSCALE, false, li, gr, t, ropeL);
                else if (v < 8) prep_vec<false>(raw[v], rowp + col, p.in[11] + l * 64, 1.0f, false, li, gr, t, ropeL);
                else if (v < 12) prep_vec<true>(raw[v], rowp + col, p.in[18] + l * 64, QSCALE, isx, li, gr, t, ropeL);
                else prep_vec<true>(raw[v], rowp + col, p.in[19] + l * 64, 1.0f, isx, li, gr, t, ropeL); }
        }
    }
    {
#pragma unroll
        for (int k0 = 0; k0 < 2; ++k0) {
            unsigned h[4][8]; bf16_t* dstp[4];
#pragma unroll
            for (int k = 0; k < 4; ++k) { const int job = tid + 512 * (k0 * 4 + k); const int cc = job & 511, tg = job >> 9;
                int col; bf16_t* dst;
                if (cc < 256) { col = C_NAV + cc; dst = (bf16_t*)(ws + WS_NAVT) + ((size_t)(b * 256 + cc)) * KSEQ; }
                else { col = C_GLV + (cc - 256); dst = (bf16_t*)(ws + WS_GLVT) + ((size_t)(b * 256 + (cc - 256))) * KSEQ; }
                const bf16_t* src = HX + (size_t)(row0 + 8 * tg) * DINP + col;
#pragma unroll
                for (int i = 0; i < 8; ++i) h[k][i] = src[(size_t)i * DINP];
                dstp[k] = dst + pos0 + 8 * tg; }
#pragma unroll
            for (int k = 0; k < 4; ++k) { u32x4 w; w.x = h[k][0] | (h[k][1] << 16); w.y = h[k][2] | (h[k][3] << 16); w.z = h[k][4] | (h[k][5] << 16); w.w = h[k][6] | (h[k][7] << 16);
                *(u32x4*)dstp[k] = w; }
        }
    }
    LAS float* A = (LAS float*)lds;
    {
        const int colid = tid & 255, half = tid >> 8, dir = colid >> 7, hd = colid & 127;
        const float* wg = (dir == 0 ? p.in[13] : p.in[15]) + l * 16 * 128 + hd;
        const float bg = (dir == 0 ? p.in[14] : p.in[16])[l * 128 + hd];
        float w[16];
#pragma unroll
        for (int r = 0; r < 16; ++r) w[r] = wg[r * 128];
#pragma unroll 4
        for (int t = half * 32; t < half * 32 + 32; ++t) {
            const bf16_t* gp = HX + (size_t)(row0 + t) * DINP + (dir == 0 ? C_GF : C_GB);
            const bf16x8 g0 = ld16(gp), g1 = ld16(gp + 8);
            float acc = bg;
#pragma unroll
            for (int r = 0; r < 8; ++r) { acc += bf2f((bf16_t)g0[r]) * w[r]; acc += bf2f((bf16_t)g1[r]) * w[8 + r]; }
            A[(dir * 64 + t) * 128 + hd] = log_sigmoid(acc) * (1.0f / 16.0f);
        }
    }
    __syncthreads();
    if (tid < 256) {
        const int dir = tid >> 7, hd = tid & 127; float s = 0.f;
        if (dir == 0) {
#pragma unroll 8
            for (int t = 0; t < 64; ++t) { s += A[t * 128 + hd]; A[t * 128 + hd] = s; } }
        else {
#pragma unroll 8
            for (int t = 63; t >= 0; --t) { s += A[(64 + t) * 128 + hd]; A[(64 + t) * 128 + hd] = s; } }
        ((float*)(ws + WS_BLAST))[(((size_t)b * NCHUNK + (pos0 >> 6)) * 2 + dir) * 128 + hd] = s;
    }
    __syncthreads();
    {
        unsigned short kraw[4][8];
#pragma unroll
        for (int k = 0; k < 4; ++k) { const int job = tid + 512 * k; const int hd = job & 127, tg = (job >> 7) & 7;
            const bf16_t* src = HX + (size_t)(row0 + 8 * tg) * DINP + C_GLK + hd;
#pragma unroll
            for (int i = 0; i < 8; ++i) kraw[k][i] = src[(size_t)i * DINP]; }
#pragma unroll
        for (int k = 0; k < 4; ++k) { const int job = tid + 512 * k; const int hd = job & 127, tg = (job >> 7) & 7, dir = job >> 10;
            const float bl = A[(dir * 64 + (dir == 0 ? 63 : 0)) * 128 + hd];
            unsigned h[8];
#pragma unroll
            for (int i = 0; i < 8; ++i) h[i] = f2bf(bf2f(kraw[k][i]) * __expf(bl - A[(dir * 64 + 8 * tg + i) * 128 + hd]));
            u32x4 w; w.x = h[0] | (h[1] << 16); w.y = h[2] | (h[3] << 16); w.z = h[4] | (h[5] << 16); w.w = h[6] | (h[7] << 16);
            *(u32x4*)((bf16_t*)(ws + WS_KKT) + ((size_t)(dir * NB + b) * 128 + hd) * KSEQ + pos0 + 8 * tg) = w; }
    }
    __syncthreads();
    {
        const float qs = 0.17677669529663687f;
        unsigned qraw[8], kraw[8];
#pragma unroll
        for (int k = 0; k < 8; ++k) { const int e = tid + 512 * k; const int t = e >> 6, hp = (e & 63) * 2; const bf16_t* rowp = HX + (size_t)(row0 + t) * DINP;
            qraw[k] = *(const unsigned*)(rowp + C_GLQ + hp); kraw[k] = *(const unsigned*)(rowp + C_GLK + hp); }
#pragma unroll
        for (int k = 0; k < 8; ++k) { const int e = tid + 512 * k; const int t = e >> 6, hp = (e & 63) * 2; bf16_t* rowp = HX + (size_t)(row0 + t) * DINP;
            const float q0 = __uint_as_float(qraw[k] << 16), q1 = __uint_as_float(qraw[k] & 0xffff0000u), k0 = __uint_as_float(kraw[k] << 16), k1 = __uint_as_float(kraw[k] & 0xffff0000u);
            const float bf0 = A[t * 128 + hp], bf1 = A[t * 128 + hp + 1], bb0 = A[(64 + t) * 128 + hp], bb1 = A[(64 + t) * 128 + hp + 1];
            *(unsigned*)(rowp + C_GLQ + hp) = pk2(q0 * qs * __expf(bf0), q1 * qs * __expf(bf1));
            *(unsigned*)(rowp + C_GLK + hp) = pk2(k0 * __expf(-bf0), k1 * __expf(-bf1));
            *(unsigned*)(rowp + C_GLQB + hp) = pk2(q0 * qs * __expf(bb0), q1 * qs * __expf(bb1));
            *(unsigned*)(rowp + C_GLKB + hp) = pk2(k0 * __expf(-bb0), k1 * __expf(-bb1)); }
    }
    asm volatile("s_waitcnt vmcnt(0)" ::: "memory");
    __syncthreads();
    { const int wv = __builtin_amdgcn_readfirstlane(tid >> 6), h = wv >> 1, dir = wv & 1;
      gla_local_unit(ws, ((b * 4 + h) * 2 + dir) * NCHUNK + (pos0 >> 6), tid & 63); }
}

template <int NG> struct AttnState { float m[NG], l[NG]; f32x4 o[NG][4]; bf16x8 q[NG][2]; };

template <int NG> DI void attn_init(AttnState<NG>& st) {
#pragma unroll
    for (int g = 0; g < NG; ++g) { st.m[g] = -1e30f; st.l[g] = 0.f;
#pragma unroll
        for (int d = 0; d < 4; ++d) st.o[g][d] = (f32x4){0.f, 0.f, 0.f, 0.f}; }
}
template <int NG, bool BIAS> DI void attn_block(AttnState<NG>& st, const bf16_t* kp0, const bf16_t* kp1, const bf16_t* vp0, const bf16_t* vp1, const f32x4& bias0, const f32x4& bias1) {
    const bf16x8 k00 = ld16(kp0), k01 = ld16(kp0 + 32), k10 = ld16(kp1), k11 = ld16(kp1 + 32);
    u64 v0[4], v1[4];
#pragma unroll
    for (int d = 0; d < 4; ++d) { v0[d] = ld8(vp0 + (size_t)d * 16 * KSEQ); v1[d] = ld8(vp1 + (size_t)d * 16 * KSEQ); }
#pragma unroll
    for (int g = 0; g < NG; ++g) {
        f32x4 s0 = MFMA16(k00, st.q[g][0], ((f32x4){0.f, 0.f, 0.f, 0.f})); s0 = MFMA16(k01, st.q[g][1], s0);
        f32x4 s1 = MFMA16(k10, st.q[g][0], ((f32x4){0.f, 0.f, 0.f, 0.f})); s1 = MFMA16(k11, st.q[g][1], s1);
        if (BIAS) { s0 += bias0; s1 += bias1; }
        float mx = fmaxf(fmaxf(fmaxf(s0[0], s0[1]), fmaxf(s0[2], s0[3])), fmaxf(fmaxf(s1[0], s1[1]), fmaxf(s1[2], s1[3])));
        mx = quad_max(mx);
        const float mn = fmaxf(st.m[g], mx), corr = __builtin_amdgcn_exp2f(st.m[g] - mn); st.m[g] = mn;
        f32x4 p0, p1;
#pragma unroll
        for (int j = 0; j < 4; ++j) { p0[j] = __builtin_amdgcn_exp2f(s0[j] - mn); p1[j] = __builtin_amdgcn_exp2f(s1[j] - mn); }
        st.l[g] = st.l[g] * corr + ((p0[0] + p0[1]) + (p0[2] + p0[3])) + ((p1[0] + p1[1]) + (p1[2] + p1[3]));
        const bf16x8 pf = pack8(p0, p1);
#pragma unroll
        for (int d = 0; d < 4; ++d) { st.o[g][d] = st.o[g][d] * corr; st.o[g][d] = MFMA16(cat8(v0[d], v1[d]), pf, st.o[g][d]); }
    }
}
template <int NG> DI void attn_run(AttnState<NG>& st, const bf16_t* kl, size_t kpitch, const bf16_t* vl, int nblk) {
    const f32x4 z = {0.f, 0.f, 0.f, 0.f};
#pragma unroll 2
    for (int i = 0; i < nblk; ++i) { const bf16_t* kp0 = kl + (size_t)(32 * i) * kpitch; attn_block<NG, false>(st, kp0, kp0 + 16 * kpitch, vl + 32 * i, vl + 32 * i + 16, z, z); }
}
template <int NG> DI void attn_finish(AttnState<NG>& st, bf16_t* orow  , int hstride, int quad) {
#pragma unroll
    for (int g = 0; g < NG; ++g) { const float inv = 1.0f / quad_sum(st.l[g]);
#pragma unroll
        for (int d = 0; d < 4; ++d) { const f32x4 o = st.o[g][d] * inv; u32x2 w; w.x = pk2(o[0], o[1]); w.y = pk2(o[2], o[3]);
            *(u32x2*)(orow + g * hstride + 16 * d + 4 * quad) = w; } }
}

DI void gqa_unit_x(unsigned char* ws, int u, int lane) {
    const int c16 = lane & 15, quad = lane >> 4;
    const int qb = u & 255, kvh = (u >> 8) & 1, b = u >> 9;
    const bf16_t* HX = (const bf16_t*)(ws + WS_HB); bf16_t* MIX = (bf16_t*)(ws + WS_HN);
    const size_t qrow = (size_t)b * SEQ + 16 * qb + c16;
    AttnState<2> st; attn_init(st);
#pragma unroll
    for (int g = 0; g < 2; ++g) { const bf16_t* qp = HX + qrow * DINP + C_GQQ + (2 * kvh + g) * 64 + quad * 8; st.q[g][0] = ld16(qp); st.q[g][1] = ld16(qp + 32); }
    const bf16_t* vt = (const bf16_t*)(ws + WS_GVT) + ((size_t)(b * 2 + kvh) * 64 + c16) * KSEQ + quad * 4;
    attn_run<2>(st, HX + ((size_t)b * SEQ + c16) * DINP + C_GQK + kvh * 64 + quad * 8, DINP, vt, SEQ / 32);
    attn_run<2>(st, HX + ((size_t)TX + b * CTX + c16) * DINP + C_GQK + kvh * 64 + quad * 8, DINP, vt + SEQ, CTX / 32);
    attn_finish<2>(st, MIX + qrow * DM + 768 + (2 * kvh) * 64, 64, quad);
}
DI void gqa_unit_z(unsigned char* ws, int u, int lane) {
    const int c16 = lane & 15, quad = lane >> 4;
    const int qb = u & 15, kvh = (u >> 4) & 1, b = u >> 5;
    const bf16_t* HX = (const bf16_t*)(ws + WS_HB); bf16_t* MIX = (bf16_t*)(ws + WS_HN);
    const size_t qrow = (size_t)TX + b * CTX + 16 * qb + c16;
    AttnState<2> st; attn_init(st);
#pragma unroll
    for (int g = 0; g < 2; ++g) { const bf16_t* qp = HX + qrow * DINP + C_GQQ + (2 * kvh + g) * 64 + quad * 8; st.q[g][0] = ld16(qp); st.q[g][1] = ld16(qp + 32); }
    const bf16_t* vt = (const bf16_t*)(ws + WS_GVT) + ((size_t)(b * 2 + kvh) * 64 + c16) * KSEQ + quad * 4;
    attn_run<2>(st, HX + ((size_t)TX + b * CTX + c16) * DINP + C_GQK + kvh * 64 + quad * 8, DINP, vt + SEQ, CTX / 32);
    attn_finish<2>(st, MIX + qrow * DM + 768 + (2 * kvh) * 64, 64, quad);
}
DI void na_unit_z(unsigned char* ws, int u, int lane) {
    const int c16 = lane & 15, quad = lane >> 4;
    const int qb = u & 15, h = (u >> 4) & 3, b = u >> 6;
    const bf16_t* HX = (const bf16_t*)(ws + WS_HB); bf16_t* MIX = (bf16_t*)(ws + WS_HN);
    const size_t qrow = (size_t)TX + b * CTX + 16 * qb + c16;
    AttnState<1> st; attn_init(st);
    { const bf16_t* qp = HX + qrow * DINP + C_NAQ + h * 64 + quad * 8; st.q[0][0] = ld16(qp); st.q[0][1] = ld16(qp + 32); }
    const bf16_t* vt = (const bf16_t*)(ws + WS_NAVT) + ((size_t)(b * 4 + h) * 64 + c16) * KSEQ + quad * 4;
    attn_run<1>(st, HX + ((size_t)TX + b * CTX + c16) * DINP + C_NAK + h * 64 + quad * 8, DINP, vt + SEQ, CTX / 32);
    attn_finish<1>(st, MIX + qrow * DM + 256 + h * 64, 64, quad);
}
DI void na_unit_x(unsigned char* ws, const LAS float* rpbL, int u, int lane) {
    const int c16 = lane & 15, quad = lane >> 4;
    const int cb = u & 3, r = (u >> 2) & 63, h = (u >> 8) & 3, b = u >> 10;
    const bf16_t* HX = (const bf16_t*)(ws + WS_HB); bf16_t* MIX = (bf16_t*)(ws + WS_HN);
    const int c = 16 * cb + c16;
    const size_t qrow = (size_t)b * SEQ + 64 * r + c;
    AttnState<1> st; attn_init(st);
    { const bf16_t* qp = HX + qrow * DINP + C_NAQ + h * 64 + quad * 8; st.q[0][0] = ld16(qp); st.q[0][1] = ld16(qp + 32); }
    const bf16_t* vt = (const bf16_t*)(ws + WS_NAVT) + ((size_t)(b * 4 + h) * 64 + c16) * KSEQ + quad * 4;
    const int rs = min(max(r - 4, 0), 56), cbase = min(max(16 * cb - 8, 0), 32), cs = min(max(c - 8, 0), 48);
    const LAS float* rpb = rpbL + h * 15 * 31;
#pragma unroll 2
    for (int wr = 0; wr < 8; ++wr) {
        const int krow = rs + wr, t0 = krow * 64 + cbase;
        const LAS float* bp = rpb + (krow - r + 7) * 31;
        f32x4 b0, b1;
#pragma unroll
        for (int j = 0; j < 4; ++j) { const int kc0 = cbase + 4 * quad + j, kc1 = kc0 + 16;
            const bool ok0 = (kc0 >= cs) && (kc0 < cs + 16), ok1 = (kc1 >= cs) && (kc1 < cs + 16);
            const float w0 = bp[min(max(kc0 - c + 15, 0), 30)], w1 = bp[min(max(kc1 - c + 15, 0), 30)];
            b0[j] = ok0 ? w0 * LOG2E : -1e30f; b1[j] = ok1 ? w1 * LOG2E : -1e30f; }
        const bf16_t* kp0 = HX + ((size_t)b * SEQ + t0 + c16) * DINP + C_NAK + h * 64 + quad * 8;
        attn_block<1, true>(st, kp0, kp0 + (size_t)16 * DINP, vt + t0, vt + t0 + 16, b0, b1);
    }
    attn_run<1>(st, HX + ((size_t)TX + b * CTX + c16) * DINP + C_NAK + h * 64 + quad * 8, DINP, vt + SEQ, CTX / 32);
    attn_finish<1>(st, MIX + qrow * DM + 256 + h * 64, 64, quad);
}

DI void na_row_unit(unsigned char* ws, const LAS float* rpbL, int u, int lane) {
    const int c16 = lane & 15, quad = lane >> 4;
    const int r = u & 63, h = (u >> 6) & 3, b = u >> 8;
    const bf16_t* HX = (const bf16_t*)(ws + WS_HB); bf16_t* MIX = (bf16_t*)(ws + WS_HN);
    const size_t qrow0 = (size_t)b * SEQ + 64 * r;
    float m[4], l[4]; f32x4 o[4][4]; bf16x8 q[4][2];
#pragma unroll
    for (int g = 0; g < 4; ++g) { m[g] = -1e30f; l[g] = 0.f;
#pragma unroll
        for (int d = 0; d < 4; ++d) o[g][d] = (f32x4){0.f, 0.f, 0.f, 0.f};
        const bf16_t* qp = HX + (qrow0 + 16 * g + c16) * DINP + C_NAQ + h * 64 + quad * 8; q[g][0] = ld16(qp); q[g][1] = ld16(qp + 32); }
    const bf16_t* vt = (const bf16_t*)(ws + WS_NAVT) + ((size_t)(b * 4 + h) * 64 + c16) * KSEQ + quad * 8;
    const int tokoff = 8 * (c16 >> 2) + (c16 & 3);
    const int rs = min(max(r - 4, 0), 56);
    const LAS float* rpb = rpbL + h * 15 * 31;
#pragma unroll 2
    for (int blk = 0; blk < 24; ++blk) {
        const bool win = blk < 16; const int wr = blk >> 1, cblk = blk & 1;
        const int t0 = win ? (rs + wr) * 64 + 32 * cblk : SEQ + 32 * (blk - 16);
        const bf16_t* kbase = (win ? HX + ((size_t)b * SEQ + t0 + tokoff) * DINP : HX + ((size_t)TX + b * CTX + (t0 - SEQ) + tokoff) * DINP) + C_NAK + h * 64 + quad * 8;
        const bf16x8 kA0 = ld16(kbase), kA1 = ld16(kbase + 32), kB0 = ld16(kbase + (size_t)4 * DINP), kB1 = ld16(kbase + (size_t)4 * DINP + 32);
        bf16x8 vf[4];
#pragma unroll
        for (int d = 0; d < 4; ++d) vf[d] = ld16(vt + t0 + (size_t)d * 16 * KSEQ);
        const LAS float* bp = rpb + (win ? (rs + wr - r + 7) : 0) * 31;
#pragma unroll
        for (int g = 0; g < 4; ++g) {
            if (win && ((g == 0 && cblk == 1) || (g == 3 && cblk == 0))) continue;
            f32x4 s0 = MFMA16(kA0, q[g][0], ((f32x4){0.f, 0.f, 0.f, 0.f})); s0 = MFMA16(kA1, q[g][1], s0);
            f32x4 s1 = MFMA16(kB0, q[g][0], ((f32x4){0.f, 0.f, 0.f, 0.f})); s1 = MFMA16(kB1, q[g][1], s1);
            if (win) { const int c = 16 * g + c16, cs = min(max(c - 8, 0), 48);
                const int kc0 = 32 * cblk + 8 * quad, lo = cs - kc0; const LAS float* bq = bp + (kc0 - c + 15);
#pragma unroll
                for (int j = 0; j < 4; ++j) { const float w0 = bq[j], w1 = bq[j + 4];
                    const bool ok0 = (unsigned)(j - lo) < 16u, ok1 = (unsigned)(j + 4 - lo) < 16u;
                    s0[j] = ok0 ? s0[j] + w0 * LOG2E : -INFINITY; s1[j] = ok1 ? s1[j] + w1 * LOG2E : -INFINITY; } }
            float mx = fmaxf(fmaxf(fmaxf(s0[0], s0[1]), fmaxf(s0[2], s0[3])), fmaxf(fmaxf(s1[0], s1[1]), fmaxf(s1[2], s1[3])));
            mx = quad_max(mx);
            if (__any(mx > m[g] + 8.0f)) { const float mn = fmaxf(m[g], mx), corr = __builtin_amdgcn_exp2f(m[g] - mn); m[g] = mn; l[g] *= corr;
#pragma unroll
                for (int d = 0; d < 4; ++d) o[g][d] = o[g][d] * corr; }
            const float mr = m[g];
            f32x4 p0, p1;
#pragma unroll
            for (int j = 0; j < 4; ++j) { p0[j] = __builtin_amdgcn_exp2f(s0[j] - mr); p1[j] = __builtin_amdgcn_exp2f(s1[j] - mr); }
            l[g] += ((p0[0] + p0[1]) + (p0[2] + p0[3])) + ((p1[0] + p1[1]) + (p1[2] + p1[3]));
            const bf16x8 pf = pack8(p0, p1);
#pragma unroll
            for (int d = 0; d < 4; ++d) o[g][d] = MFMA16(vf[d], pf, o[g][d]);
        }
    }
#pragma unroll
    for (int g = 0; g < 4; ++g) { const float inv = 1.0f / quad_sum(l[g]); bf16_t* orow = MIX + (qrow0 + 16 * g + c16) * DM + 256 + h * 64;
#pragma unroll
        for (int d = 0; d < 4; ++d) { const f32x4 ov = o[g][d] * inv; u32x2 w; w.x = pk2(ov[0], ov[1]); w.y = pk2(ov[2], ov[3]);
            *(u32x2*)(orow + 16 * d + 4 * quad) = w; } }
}

DI int chunk_row0(int b, int pc) { return pc < 64 ? b * SEQ + 64 * pc : TX + b * CTX + 64 * (pc - 64); }
DI void gla_local_unit(unsigned char* ws, int u, int lane) {
    const int c16 = lane & 15, quad = lane >> 4;
    const int pc = u % NCHUNK; const int seq = u / NCHUNK; const int dir = seq & 1, h = (seq >> 1) & 3, b = seq >> 3;
    const bf16_t* vt = (const bf16_t*)(ws + WS_GLVT) + ((size_t)(b * 4 + h) * 64 + c16) * KSEQ + 64 * pc + quad * 8;
    const bf16_t* kt = (const bf16_t*)(ws + WS_KKT) + ((size_t)((dir * NB + b) * 4 + h) * 32 + c16) * KSEQ + 64 * pc + quad * 8;
    bf16x8 kf[2][2];
#pragma unroll
    for (int db = 0; db < 2; ++db)
#pragma unroll
        for (int ks = 0; ks < 2; ++ks) kf[db][ks] = ld16(kt + (size_t)db * 16 * KSEQ + 32 * ks);
    float* dst = (float*)(ws + WS_SLOC) + ((size_t)seq * NCHUNK + pc) * 2048;
#pragma unroll
    for (int eb = 0; eb < 4; ++eb) { const bf16x8 a0 = ld16(vt + (size_t)eb * 16 * KSEQ), a1 = ld16(vt + (size_t)eb * 16 * KSEQ + 32);
#pragma unroll
        for (int db = 0; db < 2; ++db) { f32x4 acc = MFMA16(a0, kf[db][0], ((f32x4){0.f, 0.f, 0.f, 0.f})); acc = MFMA16(a1, kf[db][1], acc);
#pragma unroll
            for (int j = 0; j < 4; ++j) dst[(16 * eb + 4 * quad + j) * 32 + 16 * db + c16] = acc[j]; } }
}
DI void gla_scan(unsigned char* ws, int gt, int NT) {
    const float* sloc = (const float*)(ws + WS_SLOC); bf16_t* sst = (bf16_t*)(ws + WS_SST); const float* blast = (const float*)(ws + WS_BLAST);
    for (int idx = gt; idx < 64 * 2048; idx += NT) {
        const int el = idx & 2047, seq = idx >> 11, d = el & 31, dir = seq & 1, h = (seq >> 1) & 3, b = seq >> 3;
        float S = 0.f;
        for (int s0 = 0; s0 < NCHUNK; s0 += 17) {
            float lv[17], dv[17];
#pragma unroll
            for (int i = 0; i < 17; ++i) { const int s = s0 + i; const int pc = (dir == 0) ? (s < 4 ? 64 + s : s - 4) : (s < 4 ? 67 - s : 67 - s);
                lv[i] = sloc[((size_t)seq * NCHUNK + pc) * 2048 + el]; dv[i] = blast[(((size_t)b * NCHUNK + pc) * 2 + dir) * 128 + h * 32 + d]; }
#pragma unroll
            for (int i = 0; i < 17; ++i) { const int s = s0 + i; const int pc = (dir == 0) ? (s < 4 ? 64 + s : s - 4) : (s < 4 ? 67 - s : 67 - s);
                sst[((size_t)seq * NCHUNK + pc) * 2048 + el] = f2bf(S); S = __expf(dv[i]) * S + lv[i]; }
        }
    }
}
DI void gla_out_unit(const Params& p, int l, int u, int lane) {
    unsigned char* ws = p.ws;
    const int c16 = lane & 15, quad = lane >> 4;
    const int ib = u & 3, pc = (u >> 2) % NCHUNK, bh = (u >> 2) / NCHUNK, h = bh & 3, b = bh >> 2;
    const bf16_t* HX = (const bf16_t*)(ws + WS_HB); bf16_t* MIX = (bf16_t*)(ws + WS_HN);
    const int row0 = chunk_row0(b, pc);
    const bf16_t* vt = (const bf16_t*)(ws + WS_GLVT) + ((size_t)(b * 4 + h) * 64 + c16) * KSEQ + 64 * pc + quad * 4;
    f32x4 o[4];
#pragma unroll
    for (int e = 0; e < 4; ++e) o[e] = (f32x4){0.f, 0.f, 0.f, 0.f};
    const int i_tok = 16 * ib + c16;
#pragma unroll
    for (int dir = 0; dir < 2; ++dir) {
        const int qc = (dir == 0 ? C_GLQ : C_GLQB) + h * 32, kc = (dir == 0 ? C_GLK : C_GLKB) + h * 32;
        const bf16x8 qf = ld16(HX + (size_t)(row0 + i_tok) * DINP + qc + quad * 8);
        const bf16_t* sp = (const bf16_t*)(ws + WS_SST) + ((size_t)((b * 4 + h) * 2 + dir) * NCHUNK + pc) * 2048 + c16 * 32 + quad * 8;
#pragma unroll
        for (int e = 0; e < 4; ++e) o[e] = MFMA16(ld16(sp + e * 16 * 32), qf, o[e]);
#pragma unroll
        for (int pr = 0; pr < 2; ++pr) {
            f32x4 s[2];
#pragma unroll
            for (int sb = 0; sb < 2; ++sb) { const int jb = 2 * pr + sb;
                const bf16x8 kf = ld16(HX + (size_t)(row0 + 16 * jb + c16) * DINP + kc + quad * 8);
                s[sb] = MFMA16(kf, qf, ((f32x4){0.f, 0.f, 0.f, 0.f}));
#pragma unroll
                for (int j = 0; j < 4; ++j) { const int jt = 16 * jb + 4 * quad + j; const bool keep = (dir == 0) ? (jt <= i_tok) : (jt >= i_tok); s[sb][j] = keep ? s[sb][j] : 0.f; } }
            const bf16x8 pf = pack8(s[0], s[1]);
#pragma unroll
            for (int e = 0; e < 4; ++e) o[e] = MFMA16(cat8(ld8(vt + (size_t)e * 16 * KSEQ + 32 * pr), ld8(vt + (size_t)e * 16 * KSEQ + 32 * pr + 16)), pf, o[e]);
        }
    }
    float ss = 0.f;
#pragma unroll
    for (int e = 0; e < 4; ++e) ss += (o[e][0] * o[e][0] + o[e][1] * o[e][1]) + (o[e][2] * o[e][2] + o[e][3] * o[e][3]);
    ss = quad_sum(ss);
    const float rstd = rsqrtf(ss * (1.0f / 64.0f) + EPS);
    const float* gain = p.in[17] + l * 64;
    const size_t row = (size_t)row0 + i_tok;
#pragma unroll
    for (int e = 0; e < 4; ++e) { const int ec = 16 * e + 4 * quad;
        const u32x2 rr = *(const u32x2*)(HX + row * DINP + C_GLR + h * 64 + ec); const f32x4 g = *(const f32x4*)(gain + ec);
        const float r0 = __uint_as_float(rr.x << 16), r1 = __uint_as_float(rr.x & 0xffff0000u), r2 = __uint_as_float(rr.y << 16), r3 = __uint_as_float(rr.y & 0xffff0000u);
        u32x2 w; w.x = pk2(o[e][0] * rstd * g[0] * pg8::silu_f(r0), o[e][1] * rstd * g[1] * pg8::silu_f(r1)); w.y = pk2(o[e][2] * rstd * g[2] * pg8::silu_f(r2), o[e][3] * rstd * g[3] * pg8::silu_f(r3));
        *(u32x2*)(MIX + row * DM + 512 + h * 64 + ec) = w; }
}

DI void gla_chunk_unit(const Params& p, int l, int u, int lane) {
    unsigned char* ws = p.ws;
    const int c16 = lane & 15, quad = lane >> 4;
    const int pc = u % NCHUNK, bh = u / NCHUNK, h = bh & 3, b = bh >> 2;
    const bf16_t* HX = (const bf16_t*)(ws + WS_HB); bf16_t* MIX = (bf16_t*)(ws + WS_HN);
    const int row0 = chunk_row0(b, pc);
    const bf16_t* vt = (const bf16_t*)(ws + WS_GLVT) + ((size_t)(b * 4 + h) * 64 + c16) * KSEQ + 64 * pc + quad * 8;
    bf16x8 vf[2][4];
#pragma unroll
    for (int pr = 0; pr < 2; ++pr)
#pragma unroll
        for (int e = 0; e < 4; ++e) vf[pr][e] = ld16(vt + (size_t)e * 16 * KSEQ + 32 * pr);
    f32x4 o[4][4];
#pragma unroll
    for (int ib = 0; ib < 4; ++ib)
#pragma unroll
        for (int e = 0; e < 4; ++e) o[ib][e] = (f32x4){0.f, 0.f, 0.f, 0.f};
    const int ktok = 8 * (c16 >> 2) + (c16 & 3);
#pragma unroll
    for (int dir = 0; dir < 2; ++dir) {
        const int qc = (dir == 0 ? C_GLQ : C_GLQB) + h * 32, kc = (dir == 0 ? C_GLK : C_GLKB) + h * 32;
        bf16x8 qf[4], sf[4], kA[2], kB[2];
#pragma unroll
        for (int ib = 0; ib < 4; ++ib) qf[ib] = ld16(HX + (size_t)(row0 + 16 * ib + c16) * DINP + qc + quad * 8);
        const bf16_t* sp = (const bf16_t*)(ws + WS_SST) + ((size_t)((b * 4 + h) * 2 + dir) * NCHUNK + pc) * 2048 + c16 * 32 + quad * 8;
#pragma unroll
        for (int e = 0; e < 4; ++e) sf[e] = ld16(sp + e * 16 * 32);
#pragma unroll
        for (int pr = 0; pr < 2; ++pr) { const bf16_t* kp = HX + (size_t)(row0 + 32 * pr + ktok) * DINP + kc + quad * 8; kA[pr] = ld16(kp); kB[pr] = ld16(kp + (size_t)4 * DINP); }
#pragma unroll
        for (int ib = 0; ib < 4; ++ib) {
#pragma unroll
            for (int e = 0; e < 4; ++e) o[ib][e] = MFMA16(sf[e], qf[ib], o[ib][e]);
            const int it = 16 * ib + c16;
#pragma unroll
            for (int pr = 0; pr < 2; ++pr) {
                const bool need = (dir == 0) ? (32 * pr <= 16 * ib + 15) : (32 * pr + 31 >= 16 * ib);
                if (!need) continue;
                f32x4 s0 = MFMA16(kA[pr], qf[ib], ((f32x4){0.f, 0.f, 0.f, 0.f})), s1 = MFMA16(kB[pr], qf[ib], ((f32x4){0.f, 0.f, 0.f, 0.f}));
#pragma unroll
                for (int j = 0; j < 4; ++j) { const int j0 = 32 * pr + 8 * quad + j, j1 = j0 + 4;
                    const bool k0 = (dir == 0) ? (j0 <= it) : (j0 >= it), k1 = (dir == 0) ? (j1 <= it) : (j1 >= it);
                    s0[j] = k0 ? s0[j] : 0.f; s1[j] = k1 ? s1[j] : 0.f; }
                const bf16x8 pf = pack8(s0, s1);
#pragma unroll
                for (int e = 0; e < 4; ++e) o[ib][e] = MFMA16(vf[pr][e], pf, o[ib][e]);
            }
        }
    }
    const float* gain = p.in[17] + l * 64;
#pragma unroll
    for (int ib = 0; ib < 4; ++ib) {
        float ss = 0.f;
#pragma unroll
        for (int e = 0; e < 4; ++e) ss += (o[ib][e][0] * o[ib][e][0] + o[ib][e][1] * o[ib][e][1]) + (o[ib][e][2] * o[ib][e][2] + o[ib][e][3] * o[ib][e][3]);
        ss = quad_sum(ss);
        const float rstd = rsqrtf(ss * (1.0f / 64.0f) + EPS);
        const size_t row = (size_t)row0 + 16 * ib + c16;
#pragma unroll
        for (int e = 0; e < 4; ++e) { const int ec = 16 * e + 4 * quad;
            const u32x2 rr = *(const u32x2*)(HX + row * DINP + C_GLR + h * 64 + ec); const f32x4 g = *(const f32x4*)(gain + ec);
            const float r0 = __uint_as_float(rr.x << 16), r1 = __uint_as_float(rr.x & 0xffff0000u), r2 = __uint_as_float(rr.y << 16), r3 = __uint_as_float(rr.y & 0xffff0000u);
            u32x2 w; w.x = pk2(o[ib][e][0] * rstd * g[0] * pg8::silu_f(r0), o[ib][e][1] * rstd * g[1] * pg8::silu_f(r1)); w.y = pk2(o[ib][e][2] * rstd * g[2] * pg8::silu_f(r2), o[ib][e][3] * rstd * g[3] * pg8::silu_f(r3));
            *(u32x2*)(MIX + row * DM + 512 + h * 64 + ec) = w; }
    }
}

DI void four1_unit(unsigned char* ws, int u, int lane) {
    const int c16 = lane & 15, quad = lane >> 4;
    const int cq = u & 3, l2 = (u >> 2) & 63, bg = u >> 8, g = bg & 3, b = bg >> 2;
    const bf16_t* HX = (const bf16_t*)(ws + WS_HB);
    const bf16_t* FC = (const bf16_t*)(ws + WS_TAB + T_FC64); const bf16_t* FSN = (const bf16_t*)(ws + WS_TAB + T_FSN64); const float* TW = (const float*)(ws + WS_TAB + T_TW);
    bf16x8 uf[2];
    const bf16_t* up = HX + ((size_t)b * SEQ + l2) * DINP + C_FOUR + g * 64 + 16 * cq + c16;
#pragma unroll
    for (int ks = 0; ks < 2; ++ks) { unsigned hh[8];
#pragma unroll
        for (int j = 0; j < 8; ++j) hh[j] = up[(size_t)(64 * (quad * 8 + j + 32 * ks)) * DINP];
        u32x4 w; w.x = hh[0] | (hh[1] << 16); w.y = hh[2] | (hh[3] << 16); w.z = hh[4] | (hh[5] << 16); w.w = hh[6] | (hh[7] << 16); uf[ks] = __builtin_bit_cast(bf16x8, w); }
    bf16_t* tr = (bf16_t*)(ws + WS_TTR); bf16_t* ti = (bf16_t*)(ws + WS_TTI);
#pragma unroll
    for (int kq = 0; kq < 4; ++kq) {
        const bf16_t* fr = FC + (16 * kq + c16) * 64 + quad * 8; const bf16_t* fi = FSN + (16 * kq + c16) * 64 + quad * 8;
        f32x4 re = MFMA16(ld16(fr), uf[0], ((f32x4){0.f, 0.f, 0.f, 0.f})); re = MFMA16(ld16(fr + 32), uf[1], re);
        f32x4 im = MFMA16(ld16(fi), uf[0], ((f32x4){0.f, 0.f, 0.f, 0.f})); im = MFMA16(ld16(fi + 32), uf[1], im);
#pragma unroll
        for (int j = 0; j < 4; ++j) { const int kb = 16 * kq + 4 * quad + j; const float cw = TW[2 * (kb * 64 + l2)], sw = TW[2 * (kb * 64 + l2) + 1];
            const float xr = re[j] * cw + im[j] * sw, xi = im[j] * cw - re[j] * sw;
            const size_t off = (((size_t)bg * 64 + kb) * 64 + l2) * 64 + 16 * cq + c16;
            tr[off] = f2bf(xr); ti[off] = f2bf(xi); }
    }
}
template <int NLB, bool CPLX> DI void four2_unit(const bf16_t* xr, const bf16_t* xi, size_t xpitch, const bf16_t* FC64, const bf16_t* FS64, const bf16_t* FSN64,
                                                  const bf16_t* FLC, const bf16_t* FLS, bf16_t* out, size_t out_rstride, float scale, int mb, int lane, int kq_lo = 0, int kq_hi = NLB) {
    const int c16 = lane & 15, quad = lane >> 4;
    bf16x8 bc[2], bs[2], bsn[2];
#pragma unroll
    for (int ks = 0; ks < 2; ++ks) { const size_t o = (size_t)(16 * mb + c16) * 64 + quad * 8 + 32 * ks; bc[ks] = ld16(FC64 + o); bs[ks] = ld16(FS64 + o); bsn[ks] = ld16(FSN64 + o); }
    bf16x8 qr[NLB / 2], qi[NLB / 2];
#pragma unroll
    for (int pr = 0; pr < NLB / 2; ++pr) {
        f32x4 tr[2], ti[2];
#pragma unroll
        for (int sb = 0; sb < 2; ++sb) { const int lb = 2 * pr + sb;
            const bf16_t* xp = xr + (size_t)(16 * lb + c16) * xpitch + quad * 8;
            const bf16x8 a0 = ld16(xp), a1 = ld16(xp + 32);
            tr[sb] = MFMA16(a0, bc[0], ((f32x4){0.f, 0.f, 0.f, 0.f})); tr[sb] = MFMA16(a1, bc[1], tr[sb]);
            ti[sb] = MFMA16(a0, bsn[0], ((f32x4){0.f, 0.f, 0.f, 0.f})); ti[sb] = MFMA16(a1, bsn[1], ti[sb]);
            if (CPLX) { const bf16_t* yp = xi + (size_t)(16 * lb + c16) * xpitch + quad * 8; const bf16x8 i0 = ld16(yp), i1 = ld16(yp + 32);
                tr[sb] = MFMA16(i0, bs[0], tr[sb]); tr[sb] = MFMA16(i1, bs[1], tr[sb]);
                ti[sb] = MFMA16(i0, bc[0], ti[sb]); ti[sb] = MFMA16(i1, bc[1], ti[sb]); } }
        qr[pr] = pack8(tr[0], tr[1]); qi[pr] = pack8(ti[0], ti[1]);
    }
    constexpr int NL = NLB * 16;
#pragma unroll 2
    for (int kq = kq_lo; kq < kq_hi; ++kq) {
        f32x4 y = {0.f, 0.f, 0.f, 0.f};
        const bf16_t* fc = FLC + (size_t)(16 * kq + c16) * NL + quad * 4; const bf16_t* fs = FLS + (size_t)(16 * kq + c16) * NL + quad * 4;
#pragma unroll
        for (int pr = 0; pr < NLB / 2; ++pr) { y = MFMA16(cat8(ld8(fc + 32 * pr), ld8(fc + 32 * pr + 16)), qr[pr], y); y = MFMA16(cat8(ld8(fs + 32 * pr), ld8(fs + 32 * pr + 16)), qi[pr], y); }
#pragma unroll
        for (int j = 0; j < 4; ++j) out[(size_t)(16 * kq + 4 * quad + j) * out_rstride + c16] = f2bf(y[j] * scale);
    }
}

DI void four2_row_unit(unsigned char* ws, int u, int lane) {
    asm volatile("" : "+v"(lane));
    const int c16 = lane & 15, quad = lane >> 4;
    const int kb = u & 63, bg = u >> 6;
    const unsigned char* tab = ws + WS_TAB;
    const bf16_t* FC = (const bf16_t*)(tab + T_FC64); const bf16_t* FS = (const bf16_t*)(tab + T_FS64); const bf16_t* FSN = (const bf16_t*)(tab + T_FSN64);
    const size_t xo = ((size_t)bg * 64 + kb) * 4096;
    const bf16_t* xr = (const bf16_t*)(ws + WS_TTR) + xo; const bf16_t* xi = (const bf16_t*)(ws + WS_TTI) + xo;
    bf16x8 tc[4][2], ts[4][2];
#pragma unroll
    for (int kq = 0; kq < 4; ++kq)
#pragma unroll
        for (int pr = 0; pr < 2; ++pr) { const size_t o = (size_t)(16 * kq + c16) * 64 + quad * 4 + 32 * pr; tc[kq][pr] = cat8(ld8(FC + o), ld8(FC + o + 16)); ts[kq][pr] = cat8(ld8(FS + o), ld8(FS + o + 16)); }
    bf16_t* out = (bf16_t*)(ws + WS_HN) + ((size_t)(bg >> 2) * SEQ + kb) * DM + (bg & 3) * 64;
#pragma unroll 1
    for (int mb = 0; mb < 4; ++mb) {
        bf16x8 bc[2], bs[2], bsn[2];
#pragma unroll
        for (int ks = 0; ks < 2; ++ks) { const size_t o = (size_t)(16 * mb + c16) * 64 + quad * 8 + 32 * ks; bc[ks] = ld16(FC + o); bs[ks] = ld16(FS + o); bsn[ks] = ld16(FSN + o); }
        bf16x8 qr[2], qi[2];
#pragma unroll
        for (int pr = 0; pr < 2; ++pr) { f32x4 tr[2], ti[2];
#pragma unroll
            for (int sb = 0; sb < 2; ++sb) { const int lb = 2 * pr + sb; const size_t o = (size_t)(16 * lb + c16) * 64 + quad * 8;
                const bf16x8 ar0 = ld16(xr + o), ar1 = ld16(xr + o + 32), ai0 = ld16(xi + o), ai1 = ld16(xi + o + 32);
                tr[sb] = MFMA16(ar0, bc[0], ((f32x4){0.f, 0.f, 0.f, 0.f})); tr[sb] = MFMA16(ar1, bc[1], tr[sb]); tr[sb] = MFMA16(ai0, bs[0], tr[sb]); tr[sb] = MFMA16(ai1, bs[1], tr[sb]);
                ti[sb] = MFMA16(ar0, bsn[0], ((f32x4){0.f, 0.f, 0.f, 0.f})); ti[sb] = MFMA16(ar1, bsn[1], ti[sb]); ti[sb] = MFMA16(ai0, bc[0], ti[sb]); ti[sb] = MFMA16(ai1, bc[1], ti[sb]); }
            qr[pr] = pack8(tr[0], tr[1]); qi[pr] = pack8(ti[0], ti[1]); }
#pragma unroll
        for (int kq = 0; kq < 4; ++kq) { f32x4 y = {0.f, 0.f, 0.f, 0.f};
#pragma unroll
            for (int pr = 0; pr < 2; ++pr) { y = MFMA16(tc[kq][pr], qr[pr], y); y = MFMA16(ts[kq][pr], qi[pr], y); }
#pragma unroll
            for (int j = 0; j < 4; ++j) out[(size_t)(16 * kq + 4 * quad + j) * 64 * DM + 16 * mb + c16] = f2bf(y[j] * (1.0f / 512.0f)); }
    }
}

#define PHASE_VARS \
    int tid = threadIdx.x; asm volatile("" : "+v"(tid)); \
    const int lane = tid & 63, wave = __builtin_amdgcn_readfirstlane(tid >> 6); \
    const int G = gridDim.x, bid = blockIdx.x, vbid = ((G & 7) == 0) ? (bid & 7) * (G >> 3) + (bid >> 3) : bid, gw = vbid * 8 + wave, NGW = G * 8, gt = bid * 512 + tid, NT = G * 512; \
    size_t ws_off0 = 0; asm volatile("" : "+s"(ws_off0)); unsigned char* ws = p.ws + ws_off0; \
    int hs = hs_loop; asm volatile("" : "+s"(hs)); \
    const int l = hs >> 1; const bool second = hs & 1; const bool lastl = (l == 1); \
    const float* mod = (const float*)(ws + WS_MOD) + (size_t)l * 9 * 9216; \
    const unsigned char* wl = ws + WS_W + (size_t)l * W_LAYER; \
    float* ZB = (float*)(ws + WS_Z); bf16_t* HN = (bf16_t*)(ws + WS_HN); bf16_t* HB = (bf16_t*)(ws + WS_HB); \
    (void)vbid; (void)lane; (void)wave; (void)gw; (void)NGW; (void)gt; (void)NT; (void)second; (void)lastl; (void)mod; (void)wl; (void)ZB; (void)HN; (void)HB; (void)bid; (void)G;

__global__ void __launch_bounds__(512, 2) mega_fwd(Params p) {
    extern __shared__ __attribute__((aligned(16))) unsigned char lds_raw[];
    LAS unsigned char* lds = (LAS unsigned char*)lds_raw;
    cg::grid_group grid = cg::this_grid();
    if (threadIdx.x < 2) ((volatile LAS unsigned*)(lds + LDS_BARST))[threadIdx.x] = 0u;
    __syncthreads();
    (void)xcd_barrier_post((unsigned*)(p.ws + WS_BAR), (volatile LAS unsigned*)(lds + LDS_BARST));
#define GRID_BAR() grid_bar_fn((unsigned*)(p.ws + WS_BAR), (unsigned)LDS_BARST)
#if DIAG_MODE
    unsigned long long t_prev = __builtin_amdgcn_s_memrealtime(); unsigned t_cat[8] = {0u, 0u, 0u, 0u, 0u, 0u, 0u, 0u};
#define STAMP(c) do { const unsigned long long t_now = __builtin_amdgcn_s_memrealtime(); t_cat[c] += (unsigned)(t_now - t_prev); t_prev = t_now; } while (0)
#else
#define STAMP(c) do {} while (0)
#endif
    { const int hs_loop = 0; PHASE_VARS
      phase_prologue<true>(p, lds, tid, lane, wave, bid, G, 0, 2); }
    grid.sync(); STAMP(0);
    { const int hs_loop = 0; PHASE_VARS
      shift_bias_mfma(ws, gw, NGW, lane);
      scale_pass(p.in[0], p.in[2], mod, 1, HN, (float*)(ws + WS_ROWSS), TT, gw, NGW, lane); }
    GRID_BAR(); STAMP(1);
    for (int rs_ = 0; rs_ < REP_SYNC; ++rs_) GRID_BAR();

#pragma unroll 1
    for (int hs_loop = 0; hs_loop < 4; ++hs_loop) {
        for (int rep = 0; rep < REP_UP; ++rep) {
        { PHASE_VARS
          const int Mrows = (hs == 3) ? TX : TT;
          const bf16_t* Ain = second ? (const bf16_t*)(ws + WS_NAVT) : HN;
          const int slot = second ? (l == 0 ? 2 : 5) : (l == 0 ? 0 : 3);
          pg8::Gemm g{Ain, (const bf16_t*)(wl + (second ? W_UP2 : W_UP1)), Mrows, 2 * DFF, DM, DM}; pg8::PrefOrder S; S.init(Mrows, 2 * DFF, G, bid);
          S.rowss = (const float*)(ws + WS_ROWSS) + (size_t)slot * TT; S.sb = (const float*)(ws + WS_SB) + (size_t)l * SB_LAYER + (second ? SB_UP2 : SB_UP1); S.sbN = 2 * DFF;
          pg8::EpiSwiglu E{HB, DFF};
          pg8::gemm_phase<pg8::EpiSwiglu, pg8::PrefOrder, true, true>(lds, g, S, E); }
        GRID_BAR(); STAMP(2); }
        { PHASE_VARS
          const float* xin = (hs == 0) ? p.in[0] : p.out;
          bf16_t* hn = (hs == 3) ? (bf16_t*)nullptr : HN;
          const float* nscale = second ? (const float*)(ws + WS_MOD) + (size_t)9 * 9216 + 1 * 1024 : mod + 4 * 1024;
          const int nslot = second ? 3 : (l == 0 ? 1 : 4);
          pg8::Gemm g{HB, (const bf16_t*)(wl + (second ? W_DN2 : W_DN1)), TX, DM, DFF, DFF}; pg8::StaticOrder S; S.init(TX, DM, G, bid);
          pg8::EpiResid E{xin, ZB, p.out, ZB, mod + (second ? 8 : 2) * 1024, 0.5f, hn, nscale, (float*)(ws + WS_ROWSS) + (size_t)nslot * TT};
          pg8::gemm_phase<pg8::EpiResid, pg8::StaticOrder, true, true>(lds, g, S, E); }
        if (hs_loop < 3) {
        { PHASE_VARS
          const int sl = bid & 3, koff = (sl == 0) ? 0 : (sl == 1) ? 768 : (sl == 2) ? 1408 : 2176, klen = (sl & 1) ? 640 : 768;
          pg8::Gemm g{HB + koff, (const bf16_t*)(wl + (second ? W_DN2 : W_DN1)) + koff, TT, DM, klen, DFF};
          pg8::OneUnit S{128 + (bid >> 4), (bid >> 2) & 3, bid < 128};
          pg8::EpiPart E{(float*)(ws + WS_TTR) + (size_t)sl * TZ * DM - (size_t)TX * DM};
          pg8::gemm_phase<pg8::EpiPart, pg8::OneUnit, false, true>(lds, g, S, E); }
        GRID_BAR();
        { PHASE_VARS
          const float* zin = (hs == 0) ? p.in[2] : ZB;
          const float* nscale = second ? (const float*)(ws + WS_MOD) + (size_t)9 * 9216 + 1 * 1024 : mod + 4 * 1024;
          const int nslot = second ? 3 : (l == 0 ? 1 : 4);
          z_finalize(ws, zin, mod + (size_t)8 * 9216 + (second ? 8 : 2) * 1024, HN + (size_t)TX * DM, nscale + (size_t)8 * 9216, (float*)(ws + WS_ROWSS) + (size_t)nslot * TT + TX, gw, NGW, lane); }
        }
        GRID_BAR(); STAMP(2);
        if (hs_loop & 1) continue;
        { PHASE_VARS
          pg8::Gemm g{HN, (const bf16_t*)(wl + W_IN), TT, DINP, DM, DM}; pg8::PrefOrder S; S.init(TT, DINP, G, bid);
          S.rowss = (const float*)(ws + WS_ROWSS) + (size_t)(l == 0 ? 1 : 4) * TT; S.sb = (const float*)(ws + WS_SB) + (size_t)l * SB_LAYER + SB_IN; S.sbN = DINP;
          pg8::EpiBf16 E{HB, DINP}; pg8::gemm_phase<pg8::EpiBf16, pg8::PrefOrder, true, true>(lds, g, S, E); }
        GRID_BAR(); STAMP(3);
        { PHASE_VARS
          for (int i = tid; i < 2048; i += 512) ((LAS float*)(lds + 65536))[i] = ((const float*)(ws + WS_TAB + T_ROPE))[i];
          __syncthreads();
          for (int t = bid; t < 544; t += G) prep_tile(p, l, t, lds, tid); }
        { PHASE_VARS
          const int n_busy = 544 - 2 * G;
          if (n_busy > 0 && n_busy < G) { if (bid >= n_busy) for (int u = (bid - n_busy) * 8 + wave; u < 8192; u += (G - n_busy) * 8) four1_unit(ws, u, lane); }
          else for (int u = gw; u < 8192; u += NGW) four1_unit(ws, u, lane); }
        GRID_BAR(); STAMP(4);
        for (int rep = 0; rep < REP_S3; ++rep) {
        { PHASE_VARS
          gla_scan(ws, gt, NT); }
        { PHASE_VARS
          const unsigned char* tab = ws + WS_TAB;
          for (int i = tid; i < 4 * 15 * 31; i += 512) ((LAS float*)lds)[i] = p.in[12][(size_t)l * 4 * 15 * 31 + i];
          __syncthreads();
          const int n_f2 = 2048, n_na = 2048, n_fz = lastl ? 0 : 512, n_naz = lastl ? 0 : 512;
          const int tot = n_f2 + n_na + n_fz + n_naz;
          for (int u = gw; u < tot; u += NGW) {
              if (u < n_na) { for (int rn = 0; rn < REP_NA; ++rn) na_row_unit(ws, (const LAS float*)lds, u, lane); }
              else if (u < n_na + n_f2) { for (int rf = 0; rf < REP_F2; ++rf) four2_row_unit(ws, u - n_na, lane); }
              else if (u < n_na + n_f2 + n_fz) { const int v = u - n_na - n_f2; const int qt = v & 3, mb = (v >> 2) & 3, bg = v >> 4;
                  const bf16_t* xr = HB + ((size_t)TX + (bg >> 2) * CTX) * DINP + C_FOUR + (bg & 3) * 64;
                  four2_unit<16, false>(xr, xr, DINP, (const bf16_t*)(tab + T_FC64), (const bf16_t*)(tab + T_FS64), (const bf16_t*)(tab + T_FSN64),
                                        (const bf16_t*)(tab + T_FC256), (const bf16_t*)(tab + T_FS256), HN + ((size_t)TX + (bg >> 2) * CTX) * DM + (bg & 3) * 64 + 16 * mb, (size_t)DM, 1.0f / 128.0f, mb, lane, 4 * qt, 4 * qt + 4); }
              else na_unit_z(ws, u - n_na - n_f2 - n_fz, lane);
          } }
        GRID_BAR(); STAMP(6); }
        for (int rep = 0; rep < REP_S4; ++rep) {
        { PHASE_VARS
          typedef attn_body::bf16 abf;
          const abf* HXb = (const abf*)HB; abf* MIXb = (abf*)HN;
          const int n_units = 512 + (lastl ? 0 : 32);
          for (int u = vbid; u < n_units; u += G) {
              const abf *Qu, *K0, *V0, *K1, *V1; abf* Ou; int NT0, NTt;
              if (u < 512) { const int b = u >> 6, h = (u >> 4) & 3, qb = u & 15, kvh = h >> 1;
                  Qu = HXb + ((size_t)b * SEQ + 256 * qb) * DINP + C_GQQ + h * 64;
                  K0 = HXb + (size_t)b * SEQ * DINP + C_GQK + kvh * 64; V0 = HXb + (size_t)b * SEQ * DINP + C_GQV + kvh * 64;
                  K1 = HXb + ((size_t)TX + b * CTX) * DINP + C_GQK + kvh * 64; V1 = HXb + ((size_t)TX + b * CTX) * DINP + C_GQV + kvh * 64;
                  NT0 = 64; NTt = 68; Ou = MIXb + ((size_t)b * SEQ + 256 * qb) * DM + 768 + h * 64; }
              else { const int v = u - 512, b = v >> 2, h = v & 3, kvh = h >> 1;
                  Qu = HXb + ((size_t)TX + b * CTX) * DINP + C_GQQ + h * 64;
                  K1 = HXb + ((size_t)TX + b * CTX) * DINP + C_GQK + kvh * 64; V1 = HXb + ((size_t)TX + b * CTX) * DINP + C_GQV + kvh * 64; K0 = K1; V0 = V1;
                  NT0 = 0; NTt = 4; Ou = MIXb + ((size_t)TX + b * CTX) * DM + 768 + h * 64; }
              attn_body::attn_unit<8>(Qu, K0, V0, K1, V1, NT0, NTt, Ou, (char*)lds_raw);
          } }
        { PHASE_VARS
          const int n_lat = 8 * 4 * 64, n_ctx = lastl ? 0 : 8 * 4 * 4 * 4;
          const int voff = (NGW > n_ctx) ? NGW - n_ctx : 0;
          for (int u = gw; u < n_lat; u += NGW) gla_chunk_unit(p, l, (u >> 6) * NCHUNK + (u & 63), lane);
          for (int v = gw - voff; v < n_ctx; v += NGW) if (v >= 0) { const int ib = v & 3, pcz = (v >> 2) & 3, bh = v >> 4; gla_out_unit(p, l, ((bh * NCHUNK + 64 + pcz) << 2) | ib, lane); } }
        GRID_BAR(); STAMP(7); }
        { PHASE_VARS
          const int Mo = lastl ? TX : TT; pg8::Gemm g{HN, (const bf16_t*)(wl + W_OUT), Mo, DM, DM, DM}; pg8::StaticOrder S; S.init(Mo, DM, G, bid);
          pg8::EpiResid E{p.out, ZB, p.out, ZB, mod + 5 * 1024, 1.0f, (bf16_t*)(ws + WS_NAVT), mod + 7 * 1024, (float*)(ws + WS_ROWSS) + (size_t)(l == 0 ? 2 : 5) * TT}; pg8::gemm_phase<pg8::EpiResid, pg8::StaticOrder, true, true>(lds, g, S, E); }
        GRID_BAR(); STAMP(3);
    }
#if DIAG_MODE
    if (blockIdx.x == 0) {
        const float ta = (float)t_cat[DIAG_A] * 0.01f, tb = (float)t_cat[DIAG_B] * 0.01f;
        if (threadIdx.x == 0) p.out[0] = 100.0f * ta;
        for (int i = threadIdx.x; i < (1 << 20); i += 512) p.out[1024 + i] = tb;
    }
#endif
}

extern "C" void kernel_launch(void* const* d_in, const int* in_sizes, int n_in, void* d_out, int out_size, void* d_ws, size_t ws_size, hipStream_t stream) {
    static int grid = 0;
    if (grid == 0) {
        int dev = 0, cus = 0, per_cu = 0;
        hipGetDevice(&dev);
        hipDeviceGetAttribute(&cus, hipDeviceAttributeMultiprocessorCount, dev);
        hipFuncSetAttribute((const void*)mega_fwd, hipFuncAttributeMaxDynamicSharedMemorySize, LDS_BYTES);
        hipOccupancyMaxActiveBlocksPerMultiprocessor(&per_cu, (const void*)mega_fwd, 512, LDS_BYTES);
        (void)hipGetLastError();
        if (per_cu < 1) per_cu = 1;
        if (per_cu > 1) per_cu = 1;
        grid = cus * per_cu;
        if (n_in != 24 || ws_size < WS_END) { fprintf(stderr, "kernel_launch: unexpected n_in %d / ws_size %zu (need %zu)\n", n_in, ws_size, (size_t)WS_END); }
    }
    (void)hipMemsetAsync((unsigned char*)d_ws + WS_BAR, 0, 16384, stream);
    Params p{};
    for (int i = 0; i < 24; ++i) p.in[i] = (const float*)d_in[i];
    p.out = (float*)d_out; p.ws = (unsigned char*)d_ws;
    void* args[] = {&p};
    hipError_t e = hipLaunchCooperativeKernel((const void*)mega_fwd, dim3(grid), dim3(512), args, LDS_BYTES, stream);
    if (e != hipSuccess) fprintf(stderr, "cooperative launch failed: %s (grid %d)\n", hipGetErrorString(e), grid);
}
```

```cpp
#include <hip/hip_runtime.h>
#include <hip/hip_cooperative_groups.h>
#include <cstdio>
#include <cstdint>
namespace cg = cooperative_groups;

namespace pg8 {
#define PG8_LAS __attribute__((address_space(3)))
typedef unsigned short bf16_t;
typedef short bf16x8 __attribute__((ext_vector_type(8)));
typedef float f32x4 __attribute__((ext_vector_type(4)));
typedef unsigned u32x4 __attribute__((ext_vector_type(4)));
constexpr int BM = 256, BK = 64, HALF = 128, HTB = HALF * BK * 2  , STAGE_BYTES = 8 * HTB, NXCD = 8, WGM = 8;

__host__ __device__ __forceinline__ int lds_byte(int r, int c) { const int st = (r >> 4) * 2 + (c >> 5), rr = r & 15, cc = c & 31, ob = rr * 64 + cc * 2; return st * 1024 + (ob ^ (((ob >> 9) & 1) << 5)); }
__host__ __device__ __forceinline__ void stage_rc(int b, int& R, int& C) { const int st = b / 1024, sb = b % 1024, swz = sb ^ (((sb >> 9) & 1) << 5); R = (st >> 1) * 16 + swz / 64; C = (st & 1) * 32 + (swz % 64) / 2; }
__host__ __device__ __forceinline__ int perm32(int rho) { const int n = rho >> 4, i = rho & 15; return 8 * (i >> 2) + 4 * n + (i & 3); }

struct Unit { int pm, pn, slot; };
struct Gemm { const bf16_t* A; const bf16_t* Bt; int M, N, K, ld; };

struct StaticOrder {
    int nM, nN, nwg, G, c;
    __host__ __device__ void init(int M, int N, int G_, int c_) { nM = M / BM; nN = N / BM; nwg = nM * nN; G = G_; c = c_; }
    __host__ __device__ bool next(int i, Unit& u) const {
        const long L = (long)i * G + c; if (L >= nwg) return false; u.slot = i & 1;
        int wgid = (int)L; { const int q = nwg / NXCD, r = nwg % NXCD, xcd = wgid % NXCD, off = wgid / NXCD; wgid = (xcd < r ? xcd * (q + 1) : r * (q + 1) + (xcd - r) * q) + off; }
        const int nig = WGM * nN, gid = wgid / nig, fm = gid * WGM, gsz = (nM - fm) < WGM ? (nM - fm) : WGM;
        u.pm = fm + ((wgid % nig) % gsz); u.pn = (wgid % nig) / gsz; return true;
    }
    __device__ __forceinline__ void a_ready(const Unit&) const {}
    __device__ __forceinline__ void done(const Unit&) const {}
};

__device__ __forceinline__ unsigned cvt_pk_bf16(float lo, float hi) {
    typedef float f32x2_t __attribute__((ext_vector_type(2))); typedef __bf16 bf16x2_t __attribute__((ext_vector_type(2)));
    f32x2_t v = {lo, hi}; bf16x2_t b = __builtin_convertvector(v, bf16x2_t); return __builtin_bit_cast(unsigned, b);
}
__device__ __forceinline__ float silu_f(float v) { return v * __builtin_amdgcn_rcpf(1.0f + __expf(-v)); }
constexpr int ROWS_X = 32768;
constexpr unsigned PREF_LDS_ADDR = 131072 + 1024;
#define PG8_PREF ((PG8_LAS float*)(size_t)PREF_LDS_ADDR)
__device__ __forceinline__ float fq_sum(float v) {
    v += __int_as_float(__builtin_amdgcn_ds_swizzle(__float_as_int(v), (16 << 10) | 0x1F));
    auto rr = __builtin_amdgcn_permlane32_swap(__float_as_uint(v), __float_as_uint(v), false, false); return __uint_as_float(rr[0]) + __uint_as_float(rr[1]); }
constexpr float NORM_EPS = 1e-6f;

struct EpiBf16 {
    static constexpr bool PERM = true, AFTER_DRAIN = false;
    bf16_t* O; int ldo;
    __device__ __forceinline__ void operator()(const f32x4 (&acc)[2][2][4][2], const Unit& u, int wr, int wc, int fr, int fq) const {
        const int row0 = u.pm * BM + wr * 64 + fr, col0 = u.pn * BM + wc * 32 + 8 * fq;
        const PG8_LAS float* ps = PG8_PREF + u.slot * 512;
        f32x4 sbv[2][2];
#pragma unroll
        for (int bj = 0; bj < 2; ++bj)
#pragma unroll
            for (int n = 0; n < 2; ++n) sbv[bj][n] = *(const PG8_LAS f32x4*)(ps + 256 + wc * 32 + 8 * fq + bj * HALF + 4 * n);
#pragma unroll
        for (int ai = 0; ai < 2; ++ai)
#pragma unroll
            for (int m = 0; m < 4; ++m) { bf16_t* rowp = O + (size_t)(row0 + ai * HALF + m * 16) * ldo + col0;
                const float rstd = rsqrtf(ps[wr * 64 + fr + ai * HALF + m * 16] * (1.0f / 1024.0f) + NORM_EPS);
#pragma unroll
                for (int bj = 0; bj < 2; ++bj) { const f32x4 v0 = acc[ai][bj][m][0] * rstd + sbv[bj][0], v1 = acc[ai][bj][m][1] * rstd + sbv[bj][1]; u32x4 w;
                    w.x = cvt_pk_bf16(v0[0], v0[1]); w.y = cvt_pk_bf16(v0[2], v0[3]); w.z = cvt_pk_bf16(v1[0], v1[1]); w.w = cvt_pk_bf16(v1[2], v1[3]);
                    *(u32x4*)(rowp + bj * HALF) = w; } }
    }
};
struct EpiSwiglu {
    static constexpr bool PERM = true, AFTER_DRAIN = false;
    bf16_t* O; int ldo;
    __device__ __forceinline__ void operator()(const f32x4 (&acc)[2][2][4][2], const Unit& u, int wr, int wc, int fr, int fq) const {
        const int row0 = u.pm * BM + wr * 64 + fr, col0 = u.pn * HALF + wc * 32 + 8 * fq;
        const PG8_LAS float* ps = PG8_PREF + u.slot * 512;
        f32x4 sbv[2][2];
#pragma unroll
        for (int bj = 0; bj < 2; ++bj)
#pragma unroll
            for (int n = 0; n < 2; ++n) sbv[bj][n] = *(const PG8_LAS f32x4*)(ps + 256 + bj * HALF + wc * 32 + 8 * fq + 4 * n);
#pragma unroll
        for (int ai = 0; ai < 2; ++ai)
#pragma unroll
            for (int m = 0; m < 4; ++m) { bf16_t* rowp = O + (size_t)(row0 + ai * HALF + m * 16) * ldo + col0;
                const float rstd = rsqrtf(ps[wr * 64 + fr + ai * HALF + m * 16] * (1.0f / 1024.0f) + NORM_EPS);
                const f32x4 g0 = acc[ai][0][m][0] * rstd + sbv[0][0], g1 = acc[ai][0][m][1] * rstd + sbv[0][1], u0 = acc[ai][1][m][0] * rstd + sbv[1][0], u1 = acc[ai][1][m][1] * rstd + sbv[1][1]; u32x4 w;
                w.x = cvt_pk_bf16(silu_f(g0[0]) * u0[0], silu_f(g0[1]) * u0[1]); w.y = cvt_pk_bf16(silu_f(g0[2]) * u0[2], silu_f(g0[3]) * u0[3]);
                w.z = cvt_pk_bf16(silu_f(g1[0]) * u1[0], silu_f(g1[1]) * u1[1]); w.w = cvt_pk_bf16(silu_f(g1[2]) * u1[2], silu_f(g1[3]) * u1[3]);
                *(u32x4*)rowp = w; }
    }
};
struct EpiResid {
    static constexpr bool PERM = false, AFTER_DRAIN = false;
    const float* inx; const float* inz; float* outx; float* outz; const float* gate;   float s;
    bf16_t* hn; const float* nscale; float* rowss;
    __device__ __forceinline__ void operator()(const f32x4 (&acc)[2][2][4][2], const Unit& u, int wr, int wc, int fr, int fq) const {
        const int trow = u.pm * BM; const bool isx = trow < ROWS_X; const int mi = isx ? (trow >> 12) : 8;
        const float* ib = isx ? inx + (size_t)trow * 1024 : inz + (size_t)(trow - ROWS_X) * 1024;
        float* ob = isx ? outx + (size_t)trow * 1024 : outz + (size_t)(trow - ROWS_X) * 1024;
        const int col0 = u.pn * BM + wc * 32 + 4 * fq; const float* gp = gate + (size_t)mi * 9216 + col0;
        f32x4 gv[2][2], sv[2][2];
        const bool fuse = hn != nullptr;
#pragma unroll
        for (int bj = 0; bj < 2; ++bj)
#pragma unroll
            for (int n = 0; n < 2; ++n) { gv[bj][n] = *(const f32x4*)(gp + bj * HALF + n * 16) * s;
                sv[bj][n] = fuse ? *(const f32x4*)(nscale + (size_t)mi * 9216 + col0 + bj * HALF + n * 16) + 1.0f : (f32x4){1.f, 1.f, 1.f, 1.f}; }
#pragma unroll
        for (int am = 0; am < 4; ++am) { const int ai = am >> 1;
            f32x4 pre[2][2][2];
#pragma unroll
            for (int mm = 0; mm < 2; ++mm)
#pragma unroll
                for (int bj = 0; bj < 2; ++bj)
#pragma unroll
                    for (int n = 0; n < 2; ++n) pre[mm][bj][n] = *(const f32x4*)(ib + (unsigned)((ai * HALF + wr * 64 + ((am & 1) * 2 + mm) * 16 + fr) * 1024 + col0 + bj * HALF + n * 16));
#pragma unroll
            for (int mm = 0; mm < 2; ++mm) { const int m = (am & 1) * 2 + mm; const int rt = ai * HALF + wr * 64 + m * 16 + fr; const unsigned off = (unsigned)(rt * 1024 + col0); float ssq = 0.f;
#pragma unroll
                for (int bj = 0; bj < 2; ++bj)
#pragma unroll
                    for (int n = 0; n < 2; ++n) { const f32x4 bs = pre[mm][bj][n];
                        const f32x4 xn = bs + gv[bj][n] * acc[ai][bj][m][n];
                        *(f32x4*)(ob + off + bj * HALF + n * 16) = xn;
                        if (fuse) { const f32x4 a = xn * sv[bj][n]; typedef unsigned u32x2e __attribute__((ext_vector_type(2))); u32x2e w; w.x = cvt_pk_bf16(a[0], a[1]); w.y = cvt_pk_bf16(a[2], a[3]);
                            *(u32x2e*)(hn + (size_t)trow * 1024 + (off + bj * HALF + n * 16)) = w;
                            ssq += (xn[0] * xn[0] + xn[1] * xn[1]) + (xn[2] * xn[2] + xn[3] * xn[3]); } }
                if (fuse) { ssq = fq_sum(ssq); if (fq == 0) __hip_atomic_fetch_add(rowss + trow + rt, ssq, __ATOMIC_RELAXED, __HIP_MEMORY_SCOPE_AGENT); } } }
    }
};

struct OneUnit {
    int pm, pn; bool have;
    __device__ __forceinline__ bool next(int i, Unit& u) const { if (i != 0 || !have) return false; u.pm = pm; u.pn = pn; u.slot = 0; return true; }
    __device__ __forceinline__ void a_ready(const Unit&) const {}
    __device__ __forceinline__ void done(const Unit&) const {}
};
struct EpiPart {
    static constexpr bool PERM = false, AFTER_DRAIN = false;
    float* P;
    __device__ __forceinline__ void operator()(const f32x4 (&acc)[2][2][4][2], const Unit& u, int wr, int wc, int fr, int fq) const {
        const int col0 = u.pn * BM + wc * 32 + 4 * fq;
#pragma unroll
        for (int ai = 0; ai < 2; ++ai)
#pragma unroll
            for (int m = 0; m < 4; ++m) { float* rp = P + (size_t)(u.pm * BM + ai * HALF + wr * 64 + m * 16 + fr) * 1024 + col0;
#pragma unroll
                for (int bj = 0; bj < 2; ++bj)
#pragma unroll
                    for (int n = 0; n < 2; ++n) *(f32x4*)(rp + bj * HALF + n * 16) = acc[ai][bj][m][n]; }
    }
};
struct PrefOrder : StaticOrder {
    const float* rowss; const float* sb; int sbN;
    __device__ __forceinline__ void a_ready(const Unit& u) const {
        const int wid = __builtin_amdgcn_readfirstlane((int)threadIdx.x >> 6); const unsigned voff = (threadIdx.x & 63u) * 16u;
        const int mi = (u.pm * BM < ROWS_X) ? ((u.pm * BM) >> 12) : 8;
        const float* src = (wid == 0) ? rowss + (size_t)u.pm * BM : sb + (size_t)mi * sbN + (size_t)u.pn * BM;
        const unsigned dst = PREF_LDS_ADDR + (unsigned)u.slot * 2048u + (wid == 0 ? 0u : 1024u);
        if (wid < 2) { unsigned keep; asm volatile("s_mov_b32 %0, m0\n\ts_mov_b32 m0, %2\n\ts_nop 0\n\tglobal_load_lds_dwordx4 %1, %3\n\ts_mov_b32 m0, %0" : "=&s"(keep) : "v"(voff), "s"(dst), "s"(src) : "memory"); }
    }
};
template <class Epi, class Sched, bool ALIGN_EPI = false, bool SP2 = false>
__device__ __forceinline__ void gemm_phase(PG8_LAS unsigned char* lds, const Gemm g, const Sched& S, const Epi& E) {
    int tid = threadIdx.x; asm volatile("" : "+v"(tid)); const int wid = __builtin_amdgcn_readfirstlane(tid >> 6), lane = tid & 63, wr = wid >> 2, wc = wid & 3, fr = lane & 15, fq = lane >> 4;
    const int K = g.K, nt = K / BK, LD = g.ld;
    unsigned voffA[2], voffB[2];
#pragma unroll
    for (int i = 0; i < 2; ++i) { int R, C; stage_rc(tid * 16 + i * 8192, R, C); const int Rb = Epi::PERM ? ((R & ~31) + perm32(R & 31)) : R;
        voffA[i] = (unsigned)(R * LD + C) * 2u; voffB[i] = (unsigned)(Rb * LD + C) * 2u; }
    const size_t kstep = (size_t)(BK * 2);
    const size_t hstep = (size_t)HALF * LD * 2;
    const size_t tstep = 2 * hstep;
    const unsigned ldsw = (unsigned)wid * 1024u;
    const int aoff = lds_byte(wr * 64 + fr, fq * 8), boff = lds_byte(wc * 32 + fr, fq * 8);
#define PG8_SA(b, h) (((b) * 2 + (h)) * HTB)
#define PG8_SB(b, h) ((4 + (b) * 2 + (h)) * HTB)
#define PG8_STAGE(bufoff, gbase, voff) do { _Pragma("unroll") for (int _i = 0; _i < 2; ++_i) \
        __builtin_amdgcn_global_load_lds((const unsigned*)((const char*)(gbase) + (voff)[_i]), (PG8_LAS unsigned*)(lds + (bufoff) + ldsw + _i * 8192), 16, 0, 0); } while (0)
#define PG8_LDA(dst, b, h) do { _Pragma("unroll") for (int m = 0; m < 4; ++m) _Pragma("unroll") for (int k = 0; k < 2; ++k) dst[m][k] = *(const PG8_LAS bf16x8*)(lds + PG8_SA(b, h) + aoff + m * 2048 + k * 1024); } while (0)
#define PG8_LDB(dst, b, h) do { _Pragma("unroll") for (int n = 0; n < 2; ++n) _Pragma("unroll") for (int k = 0; k < 2; ++k) dst[n][k] = *(const PG8_LAS bf16x8*)(lds + PG8_SB(b, h) + boff + n * 2048 + k * 1024); } while (0)
#define PG8_MMA(ai, bj, At, Bt) do { __builtin_amdgcn_s_setprio(1); _Pragma("unroll") for (int m = 0; m < 4; ++m) _Pragma("unroll") for (int n = 0; n < 2; ++n) _Pragma("unroll") for (int k = 0; k < 2; ++k) \
        acc[ai][bj][m][n] = __builtin_amdgcn_mfma_f32_16x16x32_bf16(Bt[n][k], At[m][k], acc[ai][bj][m][n], 0, 0, 0); __builtin_amdgcn_s_setprio(0); } while (0)
#define PG8_WAIT_V(n) asm volatile("s_waitcnt vmcnt(" #n ")" ::: "memory")
#define PG8_WAIT_L(n) asm volatile("s_waitcnt lgkmcnt(" #n ")" ::: "memory")
#define PG8_BAR __builtin_amdgcn_s_barrier()
#define PG8_SCHED __builtin_amdgcn_sched_barrier(0)
    Unit cur, nxt; int ui = 0;
    if (!S.next(0, cur)) return;
    f32x4 acc[2][2][4][2];
#pragma unroll
    for (int a = 0; a < 2; ++a)
#pragma unroll
        for (int b = 0; b < 2; ++b)
#pragma unroll
            for (int m = 0; m < 4; ++m)
#pragma unroll
                for (int n = 0; n < 2; ++n) acc[a][b][m][n] = (f32x4){0.f, 0.f, 0.f, 0.f};
    bf16x8 At[4][2], B0[2][2], B1[2][2];
    const char* cA = (const char*)g.A + (size_t)cur.pm * tstep; const char* cB = (const char*)g.Bt + (size_t)cur.pn * tstep;
    S.a_ready(cur);
    if constexpr (SP2) {
        PG8_STAGE(PG8_SB(0, 0), cB, voffB); PG8_STAGE(PG8_SB(0, 1), cB + hstep, voffB); PG8_STAGE(PG8_SA(0, 0), cA, voffA); PG8_STAGE(PG8_SA(0, 1), cA + hstep, voffA);
        if (wr == 1) PG8_BAR;
        PG8_WAIT_V(2); PG8_BAR;
        PG8_STAGE(PG8_SB(1, 0), cB + kstep, voffB); PG8_STAGE(PG8_SA(1, 0), cA + kstep, voffA); PG8_STAGE(PG8_SB(1, 1), cB + hstep + kstep, voffB);
        PG8_WAIT_V(6); PG8_BAR;
    } else {
        PG8_STAGE(PG8_SB(0, 0), cB, voffB); PG8_STAGE(PG8_SA(0, 0), cA, voffA); PG8_STAGE(PG8_SB(0, 1), cB + hstep, voffB); PG8_STAGE(PG8_SA(0, 1), cA + hstep, voffA);
        if (wr == 1) PG8_BAR;
        PG8_WAIT_V(4); PG8_BAR;
        PG8_STAGE(PG8_SB(1, 0), cB + kstep, voffB); PG8_STAGE(PG8_SA(1, 0), cA + kstep, voffA); PG8_STAGE(PG8_SB(1, 1), cB + hstep + kstep, voffB);
        PG8_WAIT_V(6); PG8_BAR;
    }
    for (;;) {
        const bool has_next = S.next(ui + 1, nxt);
        const char* nA = has_next ? (const char*)g.A + (size_t)nxt.pm * tstep : cA; const char* nB = has_next ? (const char*)g.Bt + (size_t)nxt.pn * tstep : cB;
        for (int t = 0; t < nt; t += 2) {
            const bool last = (t == nt - 2);
            const char* a1 = cA + (size_t)(t + 1) * kstep;
            const char* a2 = last ? nA : cA + (size_t)(t + 2) * kstep; const char* b2 = last ? nB : cB + (size_t)(t + 2) * kstep;
            const char* a3 = a2 + kstep; const char* b3 = b2 + kstep;
            if (last && has_next) S.a_ready(nxt);
            if constexpr (SP2) {
            PG8_LDB(B0, 0, 0); PG8_LDB(B1, 0, 1); PG8_SCHED; PG8_LDA(At, 0, 0); PG8_STAGE(PG8_SA(1, 1), a1 + hstep, voffA);
            PG8_WAIT_V(8); PG8_WAIT_L(0); PG8_BAR; PG8_MMA(0, 0, At, B0); PG8_MMA(0, 1, At, B1); PG8_BAR; PG8_SCHED;
            PG8_LDA(At, 0, 1); PG8_STAGE(PG8_SB(0, 0), b2, voffB); PG8_STAGE(PG8_SB(0, 1), b2 + hstep, voffB); PG8_STAGE(PG8_SA(0, 0), a2, voffA);
            PG8_WAIT_V(8); PG8_WAIT_L(0); PG8_BAR; PG8_MMA(1, 0, At, B0); PG8_MMA(1, 1, At, B1); PG8_BAR; PG8_SCHED;
            PG8_LDB(B0, 1, 0); PG8_LDB(B1, 1, 1); PG8_SCHED; PG8_LDA(At, 1, 0); PG8_STAGE(PG8_SA(0, 1), a2 + hstep, voffA);
            PG8_WAIT_V(8); PG8_WAIT_L(0); PG8_BAR; PG8_MMA(0, 0, At, B0); PG8_MMA(0, 1, At, B1); PG8_BAR; PG8_SCHED;
            PG8_LDA(At, 1, 1); PG8_STAGE(PG8_SB(1, 0), b3, voffB); PG8_STAGE(PG8_SB(1, 1), b3 + hstep, voffB); PG8_STAGE(PG8_SA(1, 0), a3, voffA);
            PG8_WAIT_V(8); PG8_WAIT_L(0); PG8_BAR; PG8_MMA(1, 0, At, B0); PG8_MMA(1, 1, At, B1); PG8_BAR; PG8_SCHED;
            } else {
            PG8_LDB(B0, 0, 0); PG8_SCHED; PG8_LDA(At, 0, 0); PG8_STAGE(PG8_SA(1, 1), a1 + hstep, voffA);
            PG8_WAIT_L(8); PG8_BAR; PG8_WAIT_L(0); PG8_MMA(0, 0, At, B0); PG8_BAR; PG8_SCHED;
            PG8_LDB(B1, 0, 1); PG8_STAGE(PG8_SB(0, 0), b2, voffB);
            PG8_BAR; PG8_WAIT_L(0); PG8_MMA(0, 1, At, B1); PG8_BAR;
            PG8_LDA(At, 0, 1); PG8_STAGE(PG8_SA(0, 0), a2, voffA);
            PG8_BAR; PG8_WAIT_L(0); PG8_MMA(1, 0, At, B0); PG8_BAR; PG8_SCHED;
            PG8_STAGE(PG8_SB(0, 1), b2 + hstep, voffB);
            PG8_WAIT_V(6); PG8_BAR; PG8_MMA(1, 1, At, B1); PG8_BAR;
            PG8_LDB(B0, 1, 0); PG8_SCHED; PG8_LDA(At, 1, 0); PG8_STAGE(PG8_SA(0, 1), a2 + hstep, voffA);
            PG8_WAIT_L(8); PG8_BAR; PG8_WAIT_L(0); PG8_MMA(0, 0, At, B0); PG8_BAR; PG8_SCHED;
            PG8_LDB(B1, 1, 1); PG8_STAGE(PG8_SB(1, 0), b3, voffB);
            PG8_BAR; PG8_WAIT_L(0); PG8_MMA(0, 1, At, B1); PG8_BAR;
            PG8_LDA(At, 1, 1); PG8_STAGE(PG8_SA(1, 0), a3, voffA);
            PG8_BAR; PG8_WAIT_L(0); PG8_MMA(1, 0, At, B0); PG8_BAR; PG8_SCHED;
            PG8_STAGE(PG8_SB(1, 1), b3 + hstep, voffB);
            PG8_WAIT_V(6); PG8_BAR; PG8_MMA(1, 1, At, B1); PG8_BAR;
            }
        }
        if constexpr (ALIGN_EPI) { if (wr == 0) PG8_BAR; }
        if constexpr (!Epi::AFTER_DRAIN) { E(acc, cur, wr, wc, fr, fq); S.done(cur); }
        if (!has_next) break;
#pragma unroll
        for (int a = 0; a < 2; ++a)
#pragma unroll
            for (int b = 0; b < 2; ++b)
#pragma unroll
                for (int m = 0; m < 4; ++m)
#pragma unroll
                    for (int n = 0; n < 2; ++n) acc[a][b][m][n] = (f32x4){0.f, 0.f, 0.f, 0.f};
        cur = nxt; cA = nA; cB = nB; ++ui;
        if constexpr (ALIGN_EPI) { if (wr == 1) PG8_BAR; }
    }
    PG8_WAIT_V(0);
    if constexpr (!ALIGN_EPI) { if (wr == 0) PG8_BAR; }
    PG8_BAR;
    if constexpr (Epi::AFTER_DRAIN) { E.fused(acc, cur, wr, wc, fr, fq, lds, wid, lane); S.done(cur); }
#undef PG8_SA
#undef PG8_SB
#undef PG8_STAGE
#undef PG8_LDA
#undef PG8_LDB
#undef PG8_MMA
#undef PG8_WAIT_V
#undef PG8_WAIT_L
#undef PG8_BAR
#undef PG8_SCHED
}
}
#include <hip/hip_bf16.h>
#include <cmath>
namespace attn_body {
using bf16=__hip_bfloat16;
using bf16x8=__attribute__((ext_vector_type(8)))short;
using s16x4=__attribute__((ext_vector_type(4)))short;
using f32x16=__attribute__((ext_vector_type(16)))float;
using u32x4=__attribute__((ext_vector_type(4)))unsigned;
constexpr int D=64,QP=2560,KP=2560,OP=1024;
constexpr int NW=8,QBLK=32,QB=QBLK*NW,KVBLK=64;
__device__ __forceinline__ int crow(int r,int hi){return (r&3)+8*(r>>2)+4*hi;}
#define SBAR() __builtin_amdgcn_sched_barrier(0)
__device__ __forceinline__ void cmask(f32x16&p0,f32x16&p1,int jb,int qrel,int hi){
  const float NEG=-INFINITY; int kb=64*jb+4*hi;
  #pragma unroll
  for(int r=0;r<16;++r){int kv=kb+(r&3)+8*(r>>2); if(kv>qrel)p0[r]=NEG; if(kv+32>qrel)p1[r]=NEG;}
}

constexpr int NSLOT=3, SLOTB=8192;
constexpr int LDS_K=0, LDS_V=NSLOT*SLOTB, LDS_WS=2*NSLOT*SLOTB, LDS_OST=LDS_WS+NW*64*4, LDS_BYTES=LDS_OST+NW*4096;
constexpr float C2=0.125f*1.4426950408889634f;
__device__ __forceinline__ void glds16(const void*gbase,unsigned voff,unsigned lds_dst){unsigned keep;
  asm volatile("s_mov_b32 %0, m0\n\ts_mov_b32 m0, %2\n\ts_nop 0\n\tglobal_load_lds_dwordx4 %1, %3\n\ts_mov_b32 m0, %0":"=&s"(keep):"v"(voff),"s"(lds_dst),"s"(gbase):"memory");}
__device__ __forceinline__ float max3f(float a,float b,float c){float r;asm("v_max3_f32 %0, %1, %2, %3":"=v"(r):"v"(a),"v"(b),"v"(c));return r;}
__device__ __forceinline__ float max2f(float a,float b){float r;asm("v_max_f32_e32 %0, %1, %2":"=v"(r):"v"(a),"v"(b));return r;}
__device__ __forceinline__ float fadd_s(float a,float b){float r;asm("v_add_f32_e32 %0, %1, %2":"=v"(r):"v"(a),"v"(b));return r;}
__device__ __forceinline__ float fsub_s(float a,float b){float r;asm("v_sub_f32_e32 %0, %1, %2":"=v"(r):"v"(a),"v"(b));return r;}
typedef float f32x2_t __attribute__((ext_vector_type(2))); typedef __bf16 bf16x2_t __attribute__((ext_vector_type(2)));
__device__ __forceinline__ unsigned cvtpk_s(float lo,float hi){f32x2_t v={lo,hi};bf16x2_t b=__builtin_convertvector(v,bf16x2_t);return __builtin_bit_cast(unsigned,b);}
#define WAIT_BAR(N) asm volatile("s_waitcnt vmcnt(" #N ") lgkmcnt(0)\n\ts_barrier":::"memory")

__device__ __forceinline__ void qkt(f32x16&p0,f32x16&p1,const char*Kslot,const bf16x8*qr,const f32x16&negm,int r32,int hi){
  const char*kb=Kslot+hi*1024+r32*16;
  #pragma unroll
  for(int d0=0;d0<4;++d0){
    const bf16x8 b0=*reinterpret_cast<const bf16x8*>(kb+d0*2048);
    const bf16x8 b1=*reinterpret_cast<const bf16x8*>(kb+d0*2048+512);
    if(d0==0){p0=__builtin_amdgcn_mfma_f32_32x32x16_bf16(b0,qr[0],negm,0,0,0);p1=__builtin_amdgcn_mfma_f32_32x32x16_bf16(b1,qr[0],negm,0,0,0);}
    else{p0=__builtin_amdgcn_mfma_f32_32x32x16_bf16(b0,qr[d0],p0,0,0,0);p1=__builtin_amdgcn_mfma_f32_32x32x16_bf16(b1,qr[d0],p1,0,0,0);}}
}
typedef __attribute__((address_space(3))) const char* lds_cptr;
typedef short v4i16_t __attribute__((ext_vector_type(4)));
__device__ __forceinline__ void kload8(bf16x8*kf,lds_cptr kp){
  kf[0]=*(const __attribute__((address_space(3))) bf16x8*)(kp);      kf[1]=*(const __attribute__((address_space(3))) bf16x8*)(kp+512);
  kf[2]=*(const __attribute__((address_space(3))) bf16x8*)(kp+2048); kf[3]=*(const __attribute__((address_space(3))) bf16x8*)(kp+2560);
  kf[4]=*(const __attribute__((address_space(3))) bf16x8*)(kp+4096); kf[5]=*(const __attribute__((address_space(3))) bf16x8*)(kp+4608);
  kf[6]=*(const __attribute__((address_space(3))) bf16x8*)(kp+6144); kf[7]=*(const __attribute__((address_space(3))) bf16x8*)(kp+6656);
}
__device__ __forceinline__ void kload2(bf16x8*kf,lds_cptr kp,int j){ kf[2*j]=*(const __attribute__((address_space(3))) bf16x8*)(kp+j*2048); kf[2*j+1]=*(const __attribute__((address_space(3))) bf16x8*)(kp+j*2048+512); }
__device__ __forceinline__ s16x4 vtr(lds_cptr p){ return __builtin_bit_cast(s16x4,__builtin_amdgcn_ds_read_tr16_b64_v4i16((__attribute__((address_space(3))) v4i16_t*)p)); }
__device__ __forceinline__ float rowmax(const f32x16&p0,const f32x16&p1){
  float a=max3f(p0[0],p0[1],p1[0]),b=max3f(p0[2],p0[3],p1[1]);a=max3f(a,p1[2],p1[3]);
  #pragma unroll
  for(int r=4;r<16;r+=4){a=max3f(a,p0[r],p0[r+1]);b=max3f(b,p0[r+2],p0[r+3]);a=max3f(a,p1[r],p1[r+1]);b=max3f(b,p1[r+2],p1[r+3]);}
  const float m=max2f(a,b);
  auto rr=__builtin_amdgcn_permlane32_swap(__float_as_uint(m),__float_as_uint(m),false,false);
  return max2f(__uint_as_float(rr[0]),__uint_as_float(rr[1]));
}
__device__ __forceinline__ void pv(f32x16*o,int vb,bf16x8 pa0,bf16x8 pa1,bf16x8 pa2,bf16x8 pa3){
  #pragma unroll
  for(int d0=0;d0<2;++d0){s16x4 lo[4],hi[4];
    #pragma unroll
    for(int ks=0;ks<4;++ks){
      asm volatile("ds_read_b64_tr_b16 %0,%1 offset:%c2":"=&v"(lo[ks]):"v"(vb),"i"(d0*4096+ks*1024):"memory");
      asm volatile("ds_read_b64_tr_b16 %0,%1 offset:%c2":"=&v"(hi[ks]):"v"(vb),"i"(d0*4096+ks*1024+512):"memory");}
    asm volatile("s_waitcnt lgkmcnt(0)":::"memory");SBAR();
    #define PK(k) (bf16x8){lo[k][0],lo[k][1],lo[k][2],lo[k][3],hi[k][0],hi[k][1],hi[k][2],hi[k][3]}
    o[d0]=__builtin_amdgcn_mfma_f32_32x32x16_bf16(pa0,PK(0),o[d0],0,0,0);
    o[d0]=__builtin_amdgcn_mfma_f32_32x32x16_bf16(pa1,PK(1),o[d0],0,0,0);
    o[d0]=__builtin_amdgcn_mfma_f32_32x32x16_bf16(pa2,PK(2),o[d0],0,0,0);
    o[d0]=__builtin_amdgcn_mfma_f32_32x32x16_bf16(pa3,PK(3),o[d0],0,0,0);
    #undef PK
  }
}

#ifndef ATTN_STORE16
#define ATTN_STORE16(p,v) (*(u32x4*)(p)=(v))
#endif
template<int THRL> __device__ __forceinline__ void attn_unit(const bf16*Qu,const bf16*__restrict__ K0,const bf16*__restrict__ V0,const bf16*__restrict__ K1,const bf16*__restrict__ V1,int NT0,int NT,bf16*Ou,char*shm){
  int tid=threadIdx.x; asm volatile("":"+v"(tid)); const int lane=tid&63,r32=lane&31,hi=lane>>5; const int wid=__builtin_amdgcn_readfirstlane(tid>>6);
  const bf16*Qw=Qu+(long)(wid*QBLK)*QP;
  const unsigned lds0=(unsigned)(uintptr_t)shm;
  float*wsf=(float*)(shm+LDS_WS)+wid*64;
  const unsigned koff=(unsigned)(lane*KP+wid*8)*2u;
  const unsigned voff=(unsigned)((16*(wid&3)+(lane>>2))*KP+(wid>>2)*32+(lane&3)*8)*2u;
  const unsigned kdst=lds0+LDS_K+wid*1024, vdst=lds0+LDS_V+wid*1024;
  #define DMA_K(t,slot) glds16(((t)<NT0?K0+(long)(t)*KVBLK*KP:K1+(long)((t)-NT0)*KVBLK*KP),koff,(unsigned)__builtin_amdgcn_readfirstlane(kdst+(slot)))
  #define DMA_V(t,slot) glds16(((t)<NT0?V0+(long)(t)*KVBLK*KP:V1+(long)((t)-NT0)*KVBLK*KP),voff,(unsigned)__builtin_amdgcn_readfirstlane(vdst+(slot)))
  const int vb0=(int)(lds0+LDS_V)+((lane>>4)&1)*32+(lane&3)*8+(4*hi+((lane&15)>>2))*64;
  const char*Kbase=shm+LDS_K; bf16x8 kf[8];
  const lds_cptr shm3=(lds_cptr)shm; const lds_cptr kp0=shm3+LDS_K+hi*1024+r32*16; const lds_cptr vp0=shm3+LDS_V+((lane>>4)&1)*32+(lane&3)*8+(4*hi+((lane&15)>>2))*64;
  DMA_K(0,0);DMA_V(0,0);DMA_K(1,SLOTB);
  bf16x8 qr[4];
  #pragma unroll
  for(int d0=0;d0<4;++d0)qr[d0]=*reinterpret_cast<const bf16x8*>(&Qw[(long)r32*QP+d0*16+hi*8]);
  float mhat=0.f,l_reg=0.f;f32x16 o[2];o[0]=f32x16{};o[1]=f32x16{};
  #define CMASK(P0,P1,t) do{}while(0)
  bool resc=false;
  #define START(P0,P1) do{ const float rm=rowmax(P0,P1); resc=false; \
    { const float dl=rm; mhat=fadd_s(mhat,dl); \
      _Pragma("unroll") for(int r=0;r<16;++r){P0[r]=fsub_s(P0[r],dl);P1[r]=fsub_s(P1[r],dl);} \
 } \
    _Pragma("unroll") for(int r=0;r<16;++r)P0[r]=__builtin_amdgcn_exp2f(P0[r]); }while(0)
  #define RESC() do{ if(resc){ asm volatile("s_waitcnt lgkmcnt(0)":::"memory"); \
      _Pragma("unroll") for(int d_=0;d_<2;++d_) _Pragma("unroll") for(int r=0;r<16;++r)o[d_][r]*=wsf[crow(r,hi)]; } }while(0)
  f32x16 pA0,pA1,pB0,pB1;
  int sl_prev=0,sl_cur=0,sl_next=SLOTB;
  #define ROT() do{sl_prev=sl_cur;sl_cur=sl_next;sl_next=(sl_next==(NSLOT-1)*SLOTB)?0:sl_next+SLOTB;}while(0)
  DMA_K(2,2*SLOTB);
  WAIT_BAR(3);
  qkt(pA0,pA1,Kbase,qr,f32x16{},r32,hi);asm volatile("s_nop 15\n\ts_nop 7":"+v"(pA0),"+v"(pA1));CMASK(pA0,pA1,0);
  START(pA0,pA1);
  _Pragma("unroll") for(int r=0;r<16;++r)pA1[r]=__builtin_amdgcn_exp2f(pA1[r]);
  WAIT_BAR(0);
  DMA_K(3,0);DMA_V(1,SLOTB);
  ROT();
  kload8(kf,kp0+sl_cur);
  WAIT_BAR(2);
  s16x4 vlo[8],vhi[8]; u32x4 pw0,pw1,pw2,pw3;
  #define PKW(P,B) cvtpk_s(P[B],P[B+1])
  #define PAF(k) __builtin_bit_cast(bf16x8,pw##k)
  #define VFR(i) (bf16x8){vlo[i][0],vlo[i][1],vlo[i][2],vlo[i][3],vhi[i][0],vhi[i][1],vhi[i][2],vhi[i][3]}
  #define PIN(x) asm volatile("":"+v"(x))
  #define MX3(a,b,c) __builtin_fmaxf(__builtin_fmaxf((a),(b)),(c))
  #define GAPA(MF,A0,A1,A2,A3,W0,W1,PW) do{ MF; sacc+=A0; sacc+=A1; sacc+=A2; sacc+=A3; PIN(sacc); W0; W1; PIN(PW); SBAR(); }while(0)
  #define EX(v) __builtin_amdgcn_exp2f(v)
  #define GAPB(MF,X,B) do{ MF; X[B]=EX(X[B]); X[B+1]=EX(X[B+1]); X[B+2]=EX(X[B+2]); X[B+3]=EX(X[B+3]); PIN(X); SBAR(); }while(0)
  #define VRD(i) do{ vlo[i]=vtr(vp_+(((i)>>2)*4096+((i)&3)*1024)); vhi[i]=vtr(vp_+(((i)>>2)*4096+((i)&3)*1024+512)); }while(0)
  #define KRD(G,j) do{ if(G){ kload2(kf,kp0+sl_next,j); SBAR(); } }while(0)
  #define STEP(C0,C1,P0,P1,t,GK,GV,GL) do{ SBAR(); \
    const lds_cptr vp_=vp0+sl_prev; \
    VRD(0); SBAR(); float sacc=(P0[0]+P0[1]); \
    GAPA(C0=__builtin_amdgcn_mfma_f32_32x32x16_bf16(kf[0],qr[0],f32x16{},0,0,0), P0[2],P0[3],P0[4],P0[5],     pw0[0]=PKW(P0,0), pw0[1]=PKW(P0,2), pw0); \
    VRD(4); SBAR(); GAPA(C1=__builtin_amdgcn_mfma_f32_32x32x16_bf16(kf[1],qr[0],f32x16{},0,0,0), P0[6],P0[7],P0[8],P0[9],     pw0[2]=PKW(P0,4), pw0[3]=PKW(P0,6), pw0); \
    VRD(1); SBAR(); GAPA(C0=__builtin_amdgcn_mfma_f32_32x32x16_bf16(kf[2],qr[1],C0,0,0,0),   P0[10],P0[11],P0[12],P0[13], pw1[0]=PKW(P0,8), pw1[1]=PKW(P0,10), pw1); \
    VRD(5); SBAR(); GAPA(C1=__builtin_amdgcn_mfma_f32_32x32x16_bf16(kf[3],qr[1],C1,0,0,0),   P0[14],P0[15],P1[0],P1[1],   pw1[2]=PKW(P0,12),pw1[3]=PKW(P0,14), pw1); \
    VRD(2); SBAR(); GAPA(C0=__builtin_amdgcn_mfma_f32_32x32x16_bf16(kf[4],qr[2],C0,0,0,0),   P1[2],P1[3],P1[4],P1[5],     pw2[0]=PKW(P1,0), pw2[1]=PKW(P1,2), pw2); \
    VRD(6); SBAR(); GAPA(C1=__builtin_amdgcn_mfma_f32_32x32x16_bf16(kf[5],qr[2],C1,0,0,0),   P1[6],P1[7],P1[8],P1[9],     pw2[2]=PKW(P1,4), pw2[3]=PKW(P1,6), pw2); \
    VRD(3); SBAR(); GAPA(C0=__builtin_amdgcn_mfma_f32_32x32x16_bf16(kf[6],qr[3],C0,0,0,0),   P1[10],P1[11],P1[12],P1[13], pw3[0]=PKW(P1,8), pw3[1]=PKW(P1,10), pw3); \
    VRD(7); SBAR(); GAPA(C1=__builtin_amdgcn_mfma_f32_32x32x16_bf16(kf[7],qr[3],C1,0,0,0),   P1[14],P1[15],0.f,0.f,       pw3[2]=PKW(P1,12),pw3[3]=PKW(P1,14), pw3); \
    l_reg+=sacc; \
    if(GK){DMA_K((t)+3,sl_cur);} if(GV){DMA_V((t)+1,sl_next);} \
    _Pragma("unroll") for(int r=0;r<16;++r){C0[r]-=mhat;C1[r]-=mhat;} \
    { float a=MX3(C0[0],C0[1],C1[0]),b=MX3(C0[2],C0[3],C1[1]); a=MX3(a,C1[2],C1[3]); \
      _Pragma("unroll") for(int r=4;r<16;r+=4){a=MX3(a,C0[r],C0[r+1]);b=MX3(b,C0[r+2],C0[r+3]);a=MX3(a,C1[r],C1[r+1]);b=MX3(b,C1[r+2],C1[r+3]);} \
      float rm=__builtin_fmaxf(a,b); { auto rr=__builtin_amdgcn_permlane32_swap(__float_as_uint(rm),__float_as_uint(rm),false,false); rm=__builtin_fmaxf(__uint_as_float(rr[0]),__uint_as_float(rr[1])); } \
      resc=false; \
      if(__builtin_expect(__any(rm>(float)THRL),0)){ const float dl=__builtin_fmaxf(rm,0.f); mhat+=dl; \
        _Pragma("unroll") for(int r=0;r<16;++r){C0[r]-=dl;C1[r]-=dl;} \
        const float f=__builtin_amdgcn_exp2f(-dl); l_reg*=f; if(hi==0)wsf[r32]=f; resc=true; } } \
    SBAR(); \
    GAPB(o[0]=__builtin_amdgcn_mfma_f32_32x32x16_bf16(PAF(0),VFR(0),o[0],0,0,0), C0,0); \
    GAPB(o[1]=__builtin_amdgcn_mfma_f32_32x32x16_bf16(PAF(0),VFR(4),o[1],0,0,0), C0,4); \
    KRD(GL,0); GAPB(o[0]=__builtin_amdgcn_mfma_f32_32x32x16_bf16(PAF(1),VFR(1),o[0],0,0,0), C0,8); \
    KRD(GL,1); GAPB(o[1]=__builtin_amdgcn_mfma_f32_32x32x16_bf16(PAF(1),VFR(5),o[1],0,0,0), C0,12); \
    KRD(GL,2); GAPB(o[0]=__builtin_amdgcn_mfma_f32_32x32x16_bf16(PAF(2),VFR(2),o[0],0,0,0), C1,0); \
    KRD(GL,3); GAPB(o[1]=__builtin_amdgcn_mfma_f32_32x32x16_bf16(PAF(2),VFR(6),o[1],0,0,0), C1,4); \
    GAPB(o[0]=__builtin_amdgcn_mfma_f32_32x32x16_bf16(PAF(3),VFR(3),o[0],0,0,0), C1,8); \
    GAPB(o[1]=__builtin_amdgcn_mfma_f32_32x32x16_bf16(PAF(3),VFR(7),o[1],0,0,0), C1,12); \
    }while(0)
  int t=1;
  #undef CMASK
  #define CMASK(P0,P1,t) do{}while(0)
  for(;t+5<NT;t+=2){
    STEP(pB0,pB1,pA0,pA1,t,true,true,true);     WAIT_BAR(2); RESC(); ROT();
    STEP(pA0,pA1,pB0,pB1,t+1,true,true,true);   WAIT_BAR(2); RESC(); ROT();
  }
  #undef CMASK
  #define CMASK(P0,P1,t) do{}while(0)
  #define ENDW(tt) do{ if((tt)+3<NT){WAIT_BAR(2);} else if((tt)+2<NT){WAIT_BAR(1);} else {WAIT_BAR(0);} }while(0)
  for(;t+1<NT;t+=2){
    STEP(pB0,pB1,pA0,pA1,t,(t+3<NT),(t+1<NT),(t+1<NT));       ENDW(t);   RESC(); ROT();
    STEP(pA0,pA1,pB0,pB1,t+1,(t+4<NT),(t+2<NT),(t+2<NT));     ENDW(t+1); RESC(); ROT();
  }
  STEP(pB0,pB1,pA0,pA1,NT-1,false,false,false); RESC();
  { float sacc=pB0[0]+pB0[1]; _Pragma("unroll") for(int r=2;r<16;++r)sacc+=pB0[r]; _Pragma("unroll") for(int r=0;r<16;++r)sacc+=pB1[r]; l_reg+=sacc;
    pw0=(u32x4){PKW(pB0,0),PKW(pB0,2),PKW(pB0,4),PKW(pB0,6)};pw1=(u32x4){PKW(pB0,8),PKW(pB0,10),PKW(pB0,12),PKW(pB0,14)};pw2=(u32x4){PKW(pB1,0),PKW(pB1,2),PKW(pB1,4),PKW(pB1,6)};pw3=(u32x4){PKW(pB1,8),PKW(pB1,10),PKW(pB1,12),PKW(pB1,14)};
    SBAR(); pv(o,vb0+sl_cur,PAF(0),PAF(1),PAF(2),PAF(3)); }
  #undef PKW
  #undef PAF
  #undef VFR
  #undef PIN
  #undef MX3
  #undef GAPA
  #undef GAPB
  #undef EX
  #undef VRD
  #undef KRD
  #undef STEP
  #undef ENDW
  {auto rr=__builtin_amdgcn_permlane32_swap(__float_as_uint(l_reg),__float_as_uint(l_reg),false,false);l_reg=__uint_as_float(rr[0])+__uint_as_float(rr[1]);}
  if(hi==0)wsf[32+r32]=l_reg;asm volatile("s_waitcnt lgkmcnt(0)":::"memory");
  float rli[16];
  #pragma unroll
  for(int r=0;r<16;++r)rli[r]=__builtin_amdgcn_rcpf(wsf[32+crow(r,hi)]);
  bf16*Ow=Ou+(long)(wid*QBLK)*OP;
  { bf16*stg=(bf16*)(shm+LDS_OST)+wid*2048;
    #pragma unroll
    for(int r=0;r<16;++r){const int orow=crow(r,hi);
      #pragma unroll
      for(int d0=0;d0<2;++d0)stg[orow*64+d0*32+r32]=__float2bfloat16(o[d0][r]*rli[r]);}
    asm volatile("s_waitcnt lgkmcnt(0)":::"memory");
    #pragma unroll
    for(int i=0;i<4;++i){const int row=i*8+(lane>>3),ch=lane&7; const u32x4 v=*(const u32x4*)(stg+row*64+ch*8); ATTN_STORE16(Ow+(long)row*OP+ch*8,v);} }
  asm volatile("s_waitcnt lgkmcnt(0)\n\ts_barrier":::"memory");
  #undef DMA_K
  #undef DMA_V
  #undef CMASK
  #undef START
  #undef RESC
  #undef ROT
}
constexpr int ATTN_LDS_BYTES=LDS_BYTES;
#undef SBAR
#undef WAIT_BAR
}
#define DI __device__ __forceinline__
#define LAS __attribute__((address_space(3)))
typedef unsigned short bf16_t;
typedef short bf16x8 __attribute__((ext_vector_type(8)));
typedef float f32x4 __attribute__((ext_vector_type(4)));
typedef unsigned u32x4 __attribute__((ext_vector_type(4)));
typedef unsigned u32x2 __attribute__((ext_vector_type(2)));
typedef unsigned long long u64;
typedef unsigned long long u64x2 __attribute__((ext_vector_type(2)));

constexpr int NB = 8, SEQ = 4096, DM = 1024, CTX = 256, DFF = 2816, DIN = 2336, DINP = 2560, KSEQ = 4352, NCHUNK = 68;
constexpr int TX = NB * SEQ, TZ = NB * CTX, TT = TX + TZ;
constexpr float EPS = 1e-6f;
constexpr float QSCALE = 0.125f * 1.4426950408889634f;
constexpr float LOG2E = 1.4426950408889634f;
constexpr int C_FOUR = 0, C_NAQ = 256, C_NAK = 512, C_NAV = 768, C_GLQ = 1024, C_GLK = 1152, C_GLV = 1280, C_GLR = 1536, C_GF = 1792, C_GB = 1808, C_GQQ = 1824, C_GQK = 2080, C_GQV = 2208;
constexpr int C_GLQB = 768, C_GLKB = 896;

constexpr size_t MiB = 1u << 20;
constexpr size_t WS_W = 0;
constexpr size_t W_UP1 = 0, W_DN1 = 11 * MiB, W_IN = W_DN1 + 5 * MiB + MiB / 2, W_OUT = W_IN + 5 * MiB, W_UP2 = W_OUT + 2 * MiB, W_DN2 = W_UP2 + 11 * MiB, W_LAYER = 40 * MiB;
constexpr size_t WS_MOD = 80 * MiB;
constexpr size_t WS_TAB = 81 * MiB;
constexpr size_t T_FC64 = 0, T_FS64 = 8192, T_FSN64 = 16384, T_TW = 32768, T_ROPE = 65536, T_FC256 = 131072, T_FS256 = 262144, T_FSN256 = 393216;
constexpr size_t WS_Z = 82 * MiB;
constexpr size_t WS_HN = 90 * MiB;
constexpr size_t WS_HB = 158 * MiB;
constexpr size_t WS_NAVT = 345 * MiB;
constexpr size_t WS_GVT = WS_NAVT + 17 * MiB;
constexpr size_t WS_GLVT = WS_GVT + 9 * MiB;
constexpr size_t WS_KKT = WS_GLVT + 17 * MiB;
constexpr size_t WS_SLOC = WS_KKT + 17 * MiB;
constexpr size_t WS_SST = WS_SLOC + 34 * MiB;
constexpr size_t WS_TTR = WS_SST + 17 * MiB;
constexpr size_t WS_TTI = WS_TTR + 16 * MiB;
constexpr size_t WS_BLAST = WS_TTI + 16 * MiB;
constexpr size_t WS_ROWSS = WS_BLAST + 1 * MiB;
constexpr size_t WS_SB = WS_ROWSS + 1 * MiB;
constexpr int SB_UP1 = 0, SB_IN = 9 * 5632, SB_UP2 = 9 * (5632 + 2560), SB_LAYER = 9 * (5632 + 2560 + 5632);
constexpr size_t WS_BAR = WS_SB + 2 * MiB;
constexpr size_t WS_END = WS_BAR + 1 * MiB;
constexpr int LDS_PREF = 131072 + 1024; static_assert(LDS_PREF == (int)pg8::PREF_LDS_ADDR, "prefetch slots");
constexpr int LDS_BARST = 131072 + 256;
static_assert(WS_END <= 512 * MiB, "workspace map");
static_assert(WS_HB + (size_t)TT * DFF * 2 <= WS_NAVT && WS_HN + (size_t)TT * DM * 2 <= WS_HB, "workspace map 2");
constexpr int LDS_BYTES = 147456;
#ifndef REP_NA
#define REP_NA 1
#endif
#ifndef REP_F2
#define REP_F2 1
#endif
#ifndef REP_SYNC
#define REP_SYNC 0
#endif
#ifndef REP_PRO
#define REP_PRO 1
#endif
#ifndef REP_S2
#define REP_S2 1
#endif
#ifndef REP_S3
#define REP_S3 1
#endif
#ifndef REP_S4
#define REP_S4 1
#endif
#ifndef REP_UP
#define REP_UP 1
#endif
#ifndef REP_NORM
#define REP_NORM 1
#endif
#ifndef DIAG_MODE
#define DIAG_MODE 0
#endif
#ifndef DIAG_A
#define DIAG_A 2
#define DIAG_B 7
#endif

struct Params { const float* in[24]; float* out; unsigned char* ws; };
#define XB_TMO      128
#define XB_XCNT(j)  (256  + 64 * (j))
#define XB_XSUB(j)  (1280 + 64 * (j))
#define XB_XGEN(j)  (2304 + 64 * (j))
#define XB_TOP      3328
#define XB_TOPGEN   3392
#define XCD_BAR_WORDS 3456
#define XB_SPIN_CAP (1u << 18)

__device__ __forceinline__ unsigned xb_ld(unsigned* p)              { return __hip_atomic_load(p, __ATOMIC_RELAXED, __HIP_MEMORY_SCOPE_AGENT); }
__device__ __forceinline__ unsigned xb_add(unsigned* p, unsigned v) { return __hip_atomic_fetch_add(p, v, __ATOMIC_RELAXED, __HIP_MEMORY_SCOPE_AGENT); }
__device__ __forceinline__ unsigned xb_xcc_id() { return (unsigned)__builtin_amdgcn_s_getreg((3 << 11) | 20) & 0xFu; }
#define XB_SPIN(cond, bar) do { unsigned _sp = 0; while (cond) { __builtin_amdgcn_s_sleep(1); \
    if ((++_sp & 255u) == 0u) { if (xb_ld(&(bar)[XB_TMO])) break; if (_sp > XB_SPIN_CAP) { atomicAdd(&(bar)[XB_TMO], 1u); break; } } } } while (0)

struct XcdBarrier {
    unsigned* bar; unsigned x;
    volatile LAS unsigned* st;
};

__device__ __forceinline__ XcdBarrier xcd_barrier_post(unsigned* bar, volatile LAS unsigned* st) {
    XcdBarrier b; b.bar = bar; b.x = xb_xcc_id(); b.st = st;
    if (threadIdx.x == 0) (void)xb_add(&bar[XB_XCNT(b.x)], 1u);
    return b;
}
__device__ __forceinline__ void xcd_barrier_complete(unsigned* bar, unsigned x, unsigned& nloc, unsigned& nx) {
    const unsigned G = gridDim.x * gridDim.y * gridDim.z;
    unsigned sum, cnt, mine, sp = 0u;
    for (;;) {
        sum = 0u; cnt = 0u; mine = 0u;
#pragma unroll
        for (unsigned j = 0; j < 16; ++j) { const unsigned c = xb_ld(&bar[XB_XCNT(j)]); sum += c; cnt += (c > 0u) ? 1u : 0u; mine = (j == x) ? c : mine; }
        if (sum == G) break;
        __builtin_amdgcn_s_sleep(1);
        if ((++sp & 255u) == 0u) { if (xb_ld(&bar[XB_TMO])) break; if (sp > XB_SPIN_CAP) { atomicAdd(&bar[XB_TMO], 1u); break; } }
    }
    nloc = mine > 0u ? mine : 1u; nx = cnt > 0u ? cnt : 1u;
}

__device__ __forceinline__ void xcd_barrier(const XcdBarrier& b) {
    asm volatile("s_waitcnt vmcnt(0)" ::: "memory");
    __syncthreads();
    if (threadIdx.x == 0) {
        unsigned* bar = b.bar;
        __builtin_amdgcn_s_waitcnt(0);
        unsigned nloc = b.st[0], nx = b.st[1];
        if (nloc == 0u) { xcd_barrier_complete(bar, b.x, nloc, nx); b.st[0] = nloc; b.st[1] = nx; }
        const unsigned old = xb_add(&bar[XB_XSUB(b.x)], 1u);
        const unsigned gen = old / nloc;
        if (old + 1u == (gen + 1u) * nloc) {
            __builtin_amdgcn_fence(__ATOMIC_RELEASE, "agent");
            asm volatile("s_waitcnt vmcnt(0)" ::: "memory");
            const unsigned og = xb_add(&bar[XB_TOP], 1u);
            const unsigned tg = og / nx;
            if (og + 1u == (tg + 1u) * nx) xb_add(&bar[XB_TOPGEN], 1u);
            else XB_SPIN(xb_ld(&bar[XB_TOPGEN]) == tg, bar);
            __builtin_amdgcn_fence(__ATOMIC_ACQUIRE, "agent");
            xb_add(&bar[XB_XGEN(b.x)], 1u);
            asm volatile("s_waitcnt vmcnt(0)" ::: "memory");
        } else {
            XB_SPIN(xb_ld(&bar[XB_XGEN(b.x)]) == gen, bar);
            __builtin_amdgcn_fence(__ATOMIC_ACQUIRE, "agent");
            asm volatile("s_waitcnt vmcnt(0)" ::: "memory");
        }
    }
    __syncthreads();
}
__device__ __attribute__((noinline)) void grid_bar_fn(unsigned* bar, unsigned st_addr) { XcdBarrier xb_; xb_.bar = bar; xb_.x = xb_xcc_id(); xb_.st = (volatile LAS unsigned*)(size_t)st_addr; xcd_barrier(xb_); }

DI float bf2f(bf16_t h) { return __uint_as_float(((unsigned)h) << 16); }
DI unsigned pk2(float lo, float hi) { return pg8::cvt_pk_bf16(lo, hi); }
DI bf16_t f2bf(float f) { return (bf16_t)(pk2(f, 0.f) & 0xffffu); }
DI bf16x8 ld16(const bf16_t* p) { return *(const bf16x8*)p; }
DI u64 ld8(const bf16_t* p) { return *(const u64*)p; }
DI bf16x8 cat8(u64 a, u64 b) { u64x2 v = {a, b}; return __builtin_bit_cast(bf16x8, v); }
DI bf16x8 pack8(const f32x4& a, const f32x4& b) { u32x4 w; w.x = pk2(a[0], a[1]); w.y = pk2(a[2], a[3]); w.z = pk2(b[0], b[1]); w.w = pk2(b[2], b[3]); return __builtin_bit_cast(bf16x8, w); }
DI bf16x8 neg8(bf16x8 v) { u32x4 w = __builtin_bit_cast(u32x4, v); w ^= 0x80008000u; return __builtin_bit_cast(bf16x8, w); }
#define MFMA16(a, b, c) __builtin_amdgcn_mfma_f32_16x16x32_bf16((a), (b), (c), 0, 0, 0)
template <int M> DI float swz_xor(float v) { return __int_as_float(__builtin_amdgcn_ds_swizzle(__float_as_int(v), (M << 10) | 0x1F)); }
DI float half_sum(float v) { auto rr = __builtin_amdgcn_permlane32_swap(__float_as_uint(v), __float_as_uint(v), false, false); return __uint_as_float(rr[0]) + __uint_as_float(rr[1]); }
DI float half_max(float v) { auto rr = __builtin_amdgcn_permlane32_swap(__float_as_uint(v), __float_as_uint(v), false, false); return fmaxf(__uint_as_float(rr[0]), __uint_as_float(rr[1])); }
DI float quad_sum(float v) { v += swz_xor<16>(v); return half_sum(v); }
DI float quad_max(float v) { v = fmaxf(v, swz_xor<16>(v)); return half_max(v); }

DI void transpose_item(const float* W, int K, int N, bf16_t* WT, int mode, LAS float* scr, int item, int lane) {
    const int nblk = N / 32, kb = item / nblk, nb = item % nblk, k0 = 64 * kb, n0 = 32 * nb;
    { const int kr = lane >> 3, nq = lane & 7;
      f32x4 wv[8];
#pragma unroll
      for (int i = 0; i < 8; ++i) wv[i] = *(const f32x4*)(W + (size_t)(k0 + 8 * i + kr) * N + n0 + 4 * nq);
#pragma unroll
      for (int i = 0; i < 8; ++i) { LAS float* d = scr + (8 * i + kr) * 33 + 4 * nq; d[0] = wv[i][0]; d[1] = wv[i][1]; d[2] = wv[i][2]; d[3] = wv[i][3]; } }
    asm volatile("s_waitcnt lgkmcnt(0)" ::: "memory");
    const int c = lane & 7;
    const int d0 = (mode == 0) ? n0 : ((n0 >> 7) * 256 + (n0 & 127) + (mode == 2 ? 128 : 0));
#pragma unroll
    for (int j = 0; j < 4; ++j) { const int n = (lane >> 3) + 8 * j; const LAS float* s = scr + (8 * c) * 33 + n;
        u32x4 o; o.x = pk2(s[0 * 33], s[1 * 33]); o.y = pk2(s[2 * 33], s[3 * 33]); o.z = pk2(s[4 * 33], s[5 * 33]); o.w = pk2(s[6 * 33], s[7 * 33]);
        *(u32x4*)(WT + (size_t)(d0 + n) * K + k0 + 8 * c) = o; }
    asm volatile("s_waitcnt lgkmcnt(0)" ::: "memory");
}

template <bool FIRST> DI void phase_prologue(const Params& p, LAS unsigned char* lds, int tid, int lane, int wave, int bid, int G, int l_lo, int l_hi) {
    constexpr bool first = FIRST;
    const int gw = bid * 8 + wave, NGW = G * 8;
    unsigned char* ws = p.ws;
    {
        LAS float* scr = (LAS float*)(lds + wave * 8704);
        constexpr int I_UP = 16 * 88, I_DN = 44 * 32, I_IN = 16 * 73, I_OUT = 16 * 32;
        constexpr int PER_L = 4 * I_UP + 2 * I_DN + I_IN + I_OUT;
        for (int it = gw; it < (l_hi - l_lo) * PER_L; it += NGW) {
            const int l = l_lo + it / PER_L; int r = it % PER_L;
            bf16_t* wl = (bf16_t*)(ws + WS_W + (size_t)l * W_LAYER);
            if (r < I_UP) { transpose_item(p.in[6] + (size_t)l * DM * DFF, DM, DFF, (bf16_t*)((unsigned char*)wl + W_UP1), 1, scr, r, lane); continue; } r -= I_UP;
            if (r < I_UP) { transpose_item(p.in[7] + (size_t)l * DM * DFF, DM, DFF, (bf16_t*)((unsigned char*)wl + W_UP1), 2, scr, r, lane); continue; } r -= I_UP;
            if (r < I_DN) { transpose_item(p.in[8] + (size_t)l * DM * DFF, DFF, DM, (bf16_t*)((unsigned char*)wl + W_DN1), 0, scr, r, lane); continue; } r -= I_DN;
            if (r < I_IN) { transpose_item(p.in[9] + (size_t)l * DM * DIN, DM, DIN, (bf16_t*)((unsigned char*)wl + W_IN), 0, scr, r, lane); continue; } r -= I_IN;
            if (r < I_OUT) { transpose_item(p.in[20] + (size_t)l * DM * DM, DM, DM, (bf16_t*)((unsigned char*)wl + W_OUT), 0, scr, r, lane); continue; } r -= I_OUT;
            if (r < I_UP) { transpose_item(p.in[21] + (size_t)l * DM * DFF, DM, DFF, (bf16_t*)((unsigned char*)wl + W_UP2), 1, scr, r, lane); continue; } r -= I_UP;
            if (r < I_UP) { transpose_item(p.in[22] + (size_t)l * DM * DFF, DM, DFF, (bf16_t*)((unsigned char*)wl + W_UP2), 2, scr, r, lane); continue; } r -= I_UP;
            transpose_item(p.in[23] + (size_t)l * DM * DFF, DFF, DM, (bf16_t*)((unsigned char*)wl + W_DN2), 0, scr, r, lane);
        }
        const int gt = bid * 512 + tid, NT = G * 512;
        for (int i = gt; i < (l_hi - l_lo) * (DINP - DIN) * DM / 8; i += NT) { const int l = l_lo + i / ((DINP - DIN) * DM / 8), r = i % ((DINP - DIN) * DM / 8);
            *(u32x4*)((bf16_t*)(ws + WS_W + (size_t)l * W_LAYER + W_IN) + (size_t)DIN * DM + (size_t)r * 8) = (u32x4){0u, 0u, 0u, 0u}; }
        if (first) {
        for (int i = gt; i < 5 * TT; i += NT) ((float*)(ws + WS_ROWSS))[TT + i] = 0.f;
        unsigned char* tab = ws + WS_TAB;
        for (int i = gt; i < 4096; i += NT) { const int a = i >> 6, b = i & 63; const float x = (float)((a * b) & 63) * (1.0f / 32.0f);
            const float c = cospif(x), s = sinpif(x);
            ((bf16_t*)(tab + T_FC64))[i] = f2bf(c); ((bf16_t*)(tab + T_FS64))[i] = f2bf(s); ((bf16_t*)(tab + T_FSN64))[i] = f2bf(-s);
            const float y = (float)(a * b) * (1.0f / 2048.0f);
            ((float*)(tab + T_TW))[2 * i] = cospif(y); ((float*)(tab + T_TW))[2 * i + 1] = sinpif(y); }
        for (int i = gt; i < 65536; i += NT) { const int a = i >> 8, b = i & 255; const float x = (float)((a * b) & 255) * (1.0f / 128.0f);
            const float c = cospif(x), s = sinpif(x);
            ((bf16_t*)(tab + T_FC256))[i] = f2bf(c); ((bf16_t*)(tab + T_FS256))[i] = f2bf(s); ((bf16_t*)(tab + T_FSN256))[i] = f2bf(-s); }
        for (int i = gt; i < 1024; i += NT) { const int pp = i >> 4, f = i & 15; const float inv = powf(10000.0f, -(float)f / 16.0f); const float ang = (float)pp * inv;
            ((float*)(tab + T_ROPE))[2 * i] = cosf(ang); ((float*)(tab + T_ROPE))[2 * i + 1] = sinf(ang); }
        }
    }
    if (!FIRST) return;
    __syncthreads();
    {
        LAS float* S = (LAS float*)lds;
        LAS float* red = (LAS float*)(lds + 9 * 1024 * 4);
        for (int i = tid; i < 9 * 1024; i += 512) { const int r = i >> 10, k = i & 1023; const float v = (r < 8) ? p.in[1][r * 1024 + k] : p.in[3][k]; S[i] = v / (1.0f + __expf(-v)); }
        __syncthreads();
        for (int it = bid; it < 2 * 144; it += G) {
            const int l = it / 144, nb = it % 144, n = nb * 64 + lane;
            const float* W = p.in[4] + (size_t)l * DM * 9216 + n;
            float acc[9];
#pragma unroll
            for (int r = 0; r < 9; ++r) acc[r] = 0.f;
            const int kbeg = wave * 128;
#pragma unroll 8
            for (int k = 0; k < 128; ++k) { const float w = W[(size_t)(kbeg + k) * 9216];
#pragma unroll
                for (int r = 0; r < 9; ++r) acc[r] += S[r * 1024 + kbeg + k] * w; }
#pragma unroll
            for (int r = 0; r < 9; ++r) red[(wave * 9 + r) * 64 + lane] = acc[r];
            __syncthreads();
            for (int i = tid; i < 9 * 64; i += 512) { const int r = i >> 6, c = i & 63; float s = 0.f;
#pragma unroll
                for (int w = 0; w < 8; ++w) s += red[(w * 9 + r) * 64 + c];
                const int nn = nb * 64 + c;
                ((float*)(ws + WS_MOD))[((size_t)l * 9 + r) * 9216 + nn] = s + p.in[5][(size_t)l * 9216 + nn]; }
            __syncthreads();
        }
    }
}

DI void scale_pass(const float* xx, const float* xz, const float* mod  , int iscale, bf16_t* HN, float* rowss, int nrows, int gw, int NGW, int lane) {
    for (int row = gw; row < nrows; row += NGW) {
        const bool isx = row < TX; const int mi = isx ? (row >> 12) : 8;
        const float* src = isx ? xx + (size_t)row * DM : xz + (size_t)(row - TX) * DM;
        const float* sc = mod + (size_t)mi * 9216 + iscale * 1024;
        f32x4 v[4]; float ss = 0.f;
#pragma unroll
        for (int j = 0; j < 4; ++j) { v[j] = *(const f32x4*)(src + 4 * lane + 256 * j); ss += (v[j][0] * v[j][0] + v[j][1] * v[j][1]) + (v[j][2] * v[j][2] + v[j][3] * v[j][3]); }
        ss += swz_xor<1>(ss); ss += swz_xor<2>(ss); ss += swz_xor<4>(ss); ss += swz_xor<8>(ss); ss += swz_xor<16>(ss); ss = half_sum(ss);
        if (lane == 0) rowss[row] = ss;
#pragma unroll
        for (int j = 0; j < 4; ++j) { const f32x4 a = *(const f32x4*)(sc + 4 * lane + 256 * j);
            const f32x4 y = v[j] * (a + 1.0f); u32x2 w; w.x = pk2(y[0], y[1]); w.y = pk2(y[2], y[3]);
            *(u32x2*)(HN + (size_t)row * DM + 4 * lane + 256 * j) = w; }
    }
}
DI void shift_bias_pass(unsigned char* ws, int gw, int NGW, int lane, int l, int n_lo, int n_hi) {
    for (int it = n_lo + gw; it < n_hi; it += NGW) {
        int n = it; int g, N; size_t woff, sboff;
        if (n < 5632) { g = 0; N = 5632; woff = W_UP1; sboff = SB_UP1; } else if (n < 5632 + 2560) { g = 1; N = 2560; n -= 5632; woff = W_IN; sboff = SB_IN; } else { g = 2; N = 5632; n -= 5632 + 2560; woff = W_UP2; sboff = SB_UP2; }
        const bf16_t* wrow = (const bf16_t*)(ws + WS_W + (size_t)l * W_LAYER + woff) + (size_t)n * DM + 16 * lane;
        const bf16x8 w0 = ld16(wrow), w1 = ld16(wrow + 8);
        float wf[16];
#pragma unroll
        for (int j = 0; j < 8; ++j) { wf[j] = bf2f((bf16_t)w0[j]); wf[8 + j] = bf2f((bf16_t)w1[j]); }
        const float* modl = (const float*)(ws + WS_MOD) + (size_t)l * 9 * 9216 + (3 * g) * 1024 + 16 * lane;
        float* sb = (float*)(ws + WS_SB) + (size_t)l * SB_LAYER + sboff;
#pragma unroll
        for (int mi = 0; mi < 9; ++mi) { float s = 0.f;
#pragma unroll
            for (int j4 = 0; j4 < 4; ++j4) { const f32x4 sh = *(const f32x4*)(modl + (size_t)mi * 9216 + 4 * j4); s += (sh[0] * wf[4 * j4] + sh[1] * wf[4 * j4 + 1]) + (sh[2] * wf[4 * j4 + 2] + sh[3] * wf[4 * j4 + 3]); }
            s += swz_xor<1>(s); s += swz_xor<2>(s); s += swz_xor<4>(s); s += swz_xor<8>(s); s += swz_xor<16>(s); s = half_sum(s);
            if (lane == 0) sb[(size_t)mi * N + n] = s; }
    }
}

DI void norm_pass(const float* xx, const float* xz, const float* mod  , int ishift, int iscale, bf16_t* HN, int nrows, int gw, int NGW, int lane) {
    for (int row = gw; row < nrows; row += NGW) {
        const bool isx = row < TX; const int mi = isx ? (row >> 12) : 8;
        const float* src = isx ? xx + (size_t)row * DM : xz + (size_t)(row - TX) * DM;
        const float* sh = mod + (size_t)mi * 9216 + ishift * 1024; const float* sc = mod + (size_t)mi * 9216 + iscale * 1024;
        f32x4 v[4]; float ss = 0.f;
#pragma unroll
        for (int j = 0; j < 4; ++j) { v[j] = *(const f32x4*)(src + 4 * lane + 256 * j); ss += (v[j][0] * v[j][0] + v[j][1] * v[j][1]) + (v[j][2] * v[j][2] + v[j][3] * v[j][3]); }
        ss += swz_xor<1>(ss); ss += swz_xor<2>(ss); ss += swz_xor<4>(ss); ss += swz_xor<8>(ss); ss += swz_xor<16>(ss); ss = half_sum(ss);
        const float rstd = rsqrtf(ss * (1.0f / DM) + EPS);
#pragma unroll
        for (int j = 0; j < 4; ++j) { const f32x4 a = *(const f32x4*)(sc + 4 * lane + 256 * j), b = *(const f32x4*)(sh + 4 * lane + 256 * j);
            const f32x4 y = v[j] * rstd * (a + 1.0f) + b; u32x2 w; w.x = pk2(y[0], y[1]); w.y = pk2(y[2], y[3]);
            *(u32x2*)(HN + (size_t)row * DM + 4 * lane + 256 * j) = w; }
    }
}

DI void shift_bias_mfma(unsigned char* ws, int gw, int NGW, int lane) {
    const int c16 = lane & 15, quad = lane >> 4;
    constexpr int NBLK = (5632 + 2560 + 5632) / 16;
    for (int it = gw; it < 2 * NBLK; it += NGW) {
        const int l = it / NBLK; int n0 = (it % NBLK) * 16; int g, N; size_t woff, sboff;
        if (n0 < 5632) { g = 0; N = 5632; woff = W_UP1; sboff = SB_UP1; } else if (n0 < 5632 + 2560) { g = 1; N = 2560; n0 -= 5632; woff = W_IN; sboff = SB_IN; } else { g = 2; N = 5632; n0 -= 5632 + 2560; woff = W_UP2; sboff = SB_UP2; }
        const bf16_t* wrow = (const bf16_t*)(ws + WS_W + (size_t)l * W_LAYER + woff) + (size_t)(n0 + c16) * DM + quad * 8;
        const float* shp = (const float*)(ws + WS_MOD) + (size_t)l * 9 * 9216 + (3 * g) * 1024 + (size_t)min(c16, 8) * 9216 + quad * 8;
        f32x4 acc = {0.f, 0.f, 0.f, 0.f};
#pragma unroll 8
        for (int ks = 0; ks < 32; ++ks) { const bf16x8 a = ld16(wrow + 32 * ks); const f32x4 s0 = *(const f32x4*)(shp + 32 * ks), s1 = *(const f32x4*)(shp + 32 * ks + 4);
            bf16x8 b = pack8(s0, s1); if (c16 >= 9) b = (bf16x8){0, 0, 0, 0, 0, 0, 0, 0};
            acc = MFMA16(a, b, acc); }
        if (c16 < 9) *(f32x4*)((float*)(ws + WS_SB) + (size_t)l * SB_LAYER + sboff + (size_t)c16 * N + n0 + quad * 4) = acc;
    }
}
DI void z_finalize(unsigned char* ws, const float* zin, const float* gate8  , bf16_t* hnz  , const float* nscale8, float* rowssz, int gw, int NGW, int lane) {
    const float* part = (const float*)(ws + WS_TTR);
    float* ZB = (float*)(ws + WS_Z);
    for (int r = gw; r < TZ; r += NGW) {
        f32x4 a[4], g[4], zi[4], sc[4];
#pragma unroll
        for (int j = 0; j < 4; ++j) { const size_t o = (size_t)r * DM + 4 * lane + 256 * j;
            a[j] = *(const f32x4*)(part + o);
#pragma unroll
            for (int s = 1; s < 4; ++s) a[j] += *(const f32x4*)(part + (size_t)s * TZ * DM + o);
            g[j] = *(const f32x4*)(gate8 + 4 * lane + 256 * j); zi[j] = *(const f32x4*)(zin + o);
            sc[j] = hnz ? *(const f32x4*)(nscale8 + 4 * lane + 256 * j) + 1.0f : (f32x4){1.f, 1.f, 1.f, 1.f}; }
        float ss = 0.f;
#pragma unroll
        for (int j = 0; j < 4; ++j) { const size_t o = (size_t)r * DM + 4 * lane + 256 * j;
            const f32x4 zn = zi[j] + g[j] * 0.5f * a[j];
            *(f32x4*)(ZB + o) = zn;
            if (hnz) { const f32x4 y = zn * sc[j]; u32x2 w; w.x = pk2(y[0], y[1]); w.y = pk2(y[2], y[3]); *(u32x2*)(hnz + o) = w;
                ss += (zn[0] * zn[0] + zn[1] * zn[1]) + (zn[2] * zn[2] + zn[3] * zn[3]); } }
        if (hnz) { ss += swz_xor<1>(ss); ss += swz_xor<2>(ss); ss += swz_xor<4>(ss); ss += swz_xor<8>(ss); ss += swz_xor<16>(ss); ss = half_sum(ss); if (lane == 0) rowssz[r] = ss; }
    }
}

DI float log_sigmoid(float x) { return fminf(x, 0.f) - __logf(1.0f + __expf(-fabsf(x))); }

template <bool ROPE> DI void prep_vec(u32x2 raw, bf16_t* ptr, const float* gain, float scale, bool rp, int li, int gr, int t, const LAS float* ropeL) {
    float x[4] = {__uint_as_float(raw.x << 16), __uint_as_float(raw.x & 0xffff0000u), __uint_as_float(raw.y << 16), __uint_as_float(raw.y & 0xffff0000u)};
    float ss = (x[0] * x[0] + x[1] * x[1]) + (x[2] * x[2] + x[3] * x[3]);
    ss += swz_xor<1>(ss); ss += swz_xor<2>(ss); ss += swz_xor<4>(ss); ss += swz_xor<8>(ss);
    const float rstd = rsqrtf(ss * (1.0f / 64.0f) + EPS);
    const f32x4 g = *(const f32x4*)(gain + 4 * li);
    float o[4];
#pragma unroll
    for (int j = 0; j < 4; ++j) { const float y = x[j] * rstd * g[j];
        if (ROPE) { const float partner = swz_xor<8>(y);
            const int d = 4 * li + j, i = d & 31; const int pp = (i < 16) ? gr : t, f = i & 15;
            const float cs = ropeL[2 * (pp * 16 + f)], sn = ropeL[2 * (pp * 16 + f) + 1];
            const float rot = (li < 8) ? (y * cs - partner * sn) : (partner * sn + y * cs);
            o[j] = (rp ? rot : y) * scale; }
        else o[j] = y * scale; }
    u32x2 w; w.x = pk2(o[0], o[1]); w.y = pk2(o[2], o[3]);
    *(u32x2*)ptr = w;
}

DI void gla_local_unit(unsigned char* ws, int u, int lane);
DI void prep_tile(const Params& p, int l, int tile, LAS unsigned char* lds, int tid) {
    unsigned char* ws = p.ws;
    bf16_t* HX = (bf16_t*)(ws + WS_HB);
    int b, row0, pos0, gr; bool isx;
    if (tile < 512) { b = tile >> 6; gr = tile & 63; row0 = b * SEQ + 64 * gr; pos0 = 64 * gr; isx = true; }
    else { const int tz = tile - 512; b = tz >> 2; gr = tz & 3; row0 = TX + b * CTX + 64 * gr; pos0 = SEQ + 64 * gr; isx = false; }
    const LAS float* ropeL = (const LAS float*)(lds + 65536);
    {
        const int li = tid & 15, jg = tid >> 4;
#pragma unroll
        for (int hb = 0; hb < 2; ++hb) {
            const int t = hb * 32 + jg;
            bf16_t* rowp = HX + (size_t)(row0 + t) * DINP + 4 * li;
            u32x2 raw[14];
#pragma unroll
            for (int v = 0; v < 14; ++v) { const int col = (v < 4) ? C_NAQ + 64 * v : (v < 8) ? C_NAK + 64 * (v - 4) : (v < 12) ? C_GQQ + 64 * (v - 8) : C_GQK + 64 * (v - 12);
                raw[v] = *(const u32x2*)(rowp + col); }
#pragma unroll
            for (int v = 0; v < 14; ++v) { const int col = (v < 4) ? C_NAQ + 64 * v : (v < 8) ? C_NAK + 64 * (v - 4) : (v < 12) ? C_GQQ + 64 * (v - 8) : C_GQK + 64 * (v - 12);
                if (v < 4) prep_vec<false>(raw[v], rowp + col, p.in[10] + l * 64, QSCALE, false, li, gr, t, ropeL);
                else if (v < 8) prep_vec<false>(raw[v], rowp + col, p.in[11] + l * 64, 1.0f, false, li, gr, t, ropeL);
                else if (v < 12) prep_vec<true>(raw[v], rowp + col, p.in[18] + l * 64, QSCALE, isx, li, gr, t, ropeL);
                else prep_vec<true>(raw[v], rowp + col, p.in[19] + l * 64, 1.0f, isx, li, gr, t, ropeL); }
        }
    }
    {
#pragma unroll
        for (int k0 = 0; k0 < 2; ++k0) {
            unsigned h[4][8]; bf16_t* dstp[4];
#pragma unroll
            for (int k = 0; k < 4; ++k) { const int job = tid + 512 * (k0 * 4 + k); const int cc = job & 511, tg = job >> 9;
                int col; bf16_t* dst;
                if (cc < 256) { col = C_NAV + cc; dst = (bf16_t*)(ws + WS_NAVT) + ((size_t)(b * 256 + cc)) * KSEQ; }
                else { col = C_GLV + (cc - 256); dst = (bf16_t*)(ws + WS_GLVT) + ((size_t)(b * 256 + (cc - 256))) * KSEQ; }
                const bf16_t* src = HX + (size_t)(row0 + 8 * tg) * DINP + col;
#pragma unroll
                for (int i = 0; i < 8; ++i) h[k][i] = src[(size_t)i * DINP];
                dstp[k] = dst + pos0 + 8 * tg; }
#pragma unroll
            for (int k = 0; k < 4; ++k) { u32x4 w; w.x = h[k][0] | (h[k][1] << 16); w.y = h[k][2] | (h[k][3] << 16); w.z = h[k][4] | (h[k][5] << 16); w.w = h[k][6] | (h[k][7] << 16);
                *(u32x4*)dstp[k] = w; }
        }
    }
    LAS float* A = (LAS float*)lds;
    {
        const int colid = tid & 255, half = tid >> 8, dir = colid >> 7, hd = colid & 127;
        const float* wg = (dir == 0 ? p.in[13] : p.in[15]) + l * 16 * 128 + hd;
        const float bg = (dir == 0 ? p.in[14] : p.in[16])[l * 128 + hd];
        float w[16];
#pragma unroll
        for (int r = 0; r < 16; ++r) w[r] = wg[r * 128];
#pragma unroll 4
        for (int t = half * 32; t < half * 32 + 32; ++t) {
            const bf16_t* gp = HX + (size_t)(row0 + t) * DINP + (dir == 0 ? C_GF : C_GB);
            const bf16x8 g0 = ld16(gp), g1 = ld16(gp + 8);
            float acc = bg;
#pragma unroll
            for (int r = 0; r < 8; ++r) { acc += bf2f((bf16_t)g0[r]) * w[r]; acc += bf2f((bf16_t)g1[r]) * w[8 + r]; }
            A[(dir * 64 + t) * 128 + hd] = log_sigmoid(acc) * (1.0f / 16.0f);
        }
    }
    __syncthreads();
    if (tid < 256) {
        const int dir = tid >> 7, hd = tid & 127; float s = 0.f;
        if (dir == 0) {
#pragma unroll 8
            for (int t = 0; t < 64; ++t) { s += A[t * 128 + hd]; A[t * 128 + hd] = s; } }
        else {
#pragma unroll 8
            for (int t = 63; t >= 0; --t) { s += A[(64 + t) * 128 + hd]; A[(64 + t) * 128 + hd] = s; } }
        ((float*)(ws + WS_BLAST))[(((size_t)b * NCHUNK + (pos0 >> 6)) * 2 + dir) * 128 + hd] = s;
    }
    __syncthreads();
    {
        unsigned short kraw[4][8];
#pragma unroll
        for (int k = 0; k < 4; ++k) { const int job = tid + 512 * k; const int hd = job & 127, tg = (job >> 7) & 7;
            const bf16_t* src = HX + (size_t)(row0 + 8 * tg) * DINP + C_GLK + hd;
#pragma unroll
            for (int i = 0; i < 8; ++i) kraw[k][i] = src[(size_t)i * DINP]; }
#pragma unroll
        for (int k = 0; k < 4; ++k) { const int job = tid + 512 * k; const int hd = job & 127, tg = (job >> 7) & 7, dir = job >> 10;
            const float bl = A[(dir * 64 + (dir == 0 ? 63 : 0)) * 128 + hd];
            unsigned h[8];
#pragma unroll
            for (int i = 0; i < 8; ++i) h[i] = f2bf(bf2f(kraw[k][i]) * __expf(bl - A[(dir * 64 + 8 * tg + i) * 128 + hd]));
            u32x4 w; w.x = h[0] | (h[1] << 16); w.y = h[2] | (h[3] << 16); w.z = h[4] | (h[5] << 16); w.w = h[6] | (h[7] << 16);
            *(u32x4*)((bf16_t*)(ws + WS_KKT) + ((size_t)(dir * NB + b) * 128 + hd) * KSEQ + pos0 + 8 * tg) = w; }
    }
    __syncthreads();
    {
        const float qs = 0.17677669529663687f;
        unsigned qraw[8], kraw[8];
#pragma unroll
        for (int k = 0; k < 8; ++k) { const int e = tid + 512 * k; const int t = e >> 6, hp = (e & 63) * 2; const bf16_t* rowp = HX + (size_t)(row0 + t) * DINP;
            qraw[k] = *(const unsigned*)(rowp + C_GLQ + hp); kraw[k] = *(const unsigned*)(rowp + C_GLK + hp); }
#pragma unroll
        for (int k = 0; k < 8; ++k) { const int e = tid + 512 * k; const int t = e >> 6, hp = (e & 63) * 2; bf16_t* rowp = HX + (size_t)(row0 + t) * DINP;
            const float q0 = __uint_as_float(qraw[k] << 16), q1 = __uint_as_float(qraw[k] & 0xffff0000u), k0 = __uint_as_float(kraw[k] << 16), k1 = __uint_as_float(kraw[k] & 0xffff0000u);
            const float bf0 = A[t * 128 + hp], bf1 = A[t * 128 + hp + 1], bb0 = A[(64 + t) * 128 + hp], bb1 = A[(64 + t) * 128 + hp + 1];
            *(unsigned*)(rowp + C_GLQ + hp) = pk2(q0 * qs * __expf(bf0), q1 * qs * __expf(bf1));
            *(unsigned*)(rowp + C_GLK + hp) = pk2(k0 * __expf(-bf0), k1 * __expf(-bf1));
            *(unsigned*)(rowp + C_GLQB + hp) = pk2(q0 * qs * __expf(bb0), q1 * qs * __expf(bb1));
            *(unsigned*)(rowp + C_GLKB + hp) = pk2(k0 * __expf(-bb0), k1 * __expf(-bb1)); }
    }
    asm volatile("s_waitcnt vmcnt(0)" ::: "memory");
    __syncthreads();
    { const int wv = __builtin_amdgcn_readfirstlane(tid >> 6), h = wv >> 1, dir = wv & 1;
      gla_local_unit(ws, ((b * 4 + h) * 2 + dir) * NCHUNK + (pos0 >> 6), tid & 63); }
}

template <int NG> struct AttnState { float m[NG], l[NG]; f32x4 o[NG][4]; bf16x8 q[NG][2]; };

template <int NG> DI void attn_init(AttnState<NG>& st) {
#pragma unroll
    for (int g = 0; g < NG; ++g) { st.m[g] = -1e30f; st.l[g] = 0.f;
#pragma unroll
        for (int d = 0; d < 4; ++d) st.o[g][d] = (f32x4){0.f, 0.f, 0.f, 0.f}; }
}
template <int NG, bool BIAS> DI void attn_block(AttnState<NG>& st, const bf16_t* kp0, const bf16_t* kp1, const bf16_t* vp0, const bf16_t* vp1, const f32x4& bias0, const f32x4& bias1) {
    const bf16x8 k00 = ld16(kp0), k01 = ld16(kp0 + 32), k10 = ld16(kp1), k11 = ld16(kp1 + 32);
    u64 v0[4], v1[4];
#pragma unroll
    for (int d = 0; d < 4; ++d) { v0[d] = ld8(vp0 + (size_t)d * 16 * KSEQ); v1[d] = ld8(vp1 + (size_t)d * 16 * KSEQ); }
#pragma unroll
    for (int g = 0; g < NG; ++g) {
        f32x4 s0 = MFMA16(k00, st.q[g][0], ((f32x4){0.f, 0.f, 0.f, 0.f})); s0 = MFMA16(k01, st.q[g][1], s0);
        f32x4 s1 = MFMA16(k10, st.q[g][0], ((f32x4){0.f, 0.f, 0.f, 0.f})); s1 = MFMA16(k11, st.q[g][1], s1);
        if (BIAS) { s0 += bias0; s1 += bias1; }
        float mx = fmaxf(fmaxf(fmaxf(s0[0], s0[1]), fmaxf(s0[2], s0[3])), fmaxf(fmaxf(s1[0], s1[1]), fmaxf(s1[2], s1[3])));
        mx = quad_max(mx);
        const float mn = fmaxf(st.m[g], mx), corr = __builtin_amdgcn_exp2f(st.m[g] - mn); st.m[g] = mn;
        f32x4 p0, p1;
#pragma unroll
        for (int j = 0; j < 4; ++j) { p0[j] = __builtin_amdgcn_exp2f(s0[j] - mn); p1[j] = __builtin_amdgcn_exp2f(s1[j] - mn); }
        st.l[g] = st.l[g] * corr + ((p0[0] + p0[1]) + (p0[2] + p0[3])) + ((p1[0] + p1[1]) + (p1[2] + p1[3]));
        const bf16x8 pf = pack8(p0, p1);
#pragma unroll
        for (int d = 0; d < 4; ++d) { st.o[g][d] = st.o[g][d] * corr; st.o[g][d] = MFMA16(cat8(v0[d], v1[d]), pf, st.o[g][d]); }
    }
}
template <int NG> DI void attn_run(AttnState<NG>& st, const bf16_t* kl, size_t kpitch, const bf16_t* vl, int nblk) {
    const f32x4 z = {0.f, 0.f, 0.f, 0.f};
#pragma unroll 2
    for (int i = 0; i < nblk; ++i) { const bf16_t* kp0 = kl + (size_t)(32 * i) * kpitch; attn_block<NG, false>(st, kp0, kp0 + 16 * kpitch, vl + 32 * i, vl + 32 * i + 16, z, z); }
}
template <int NG> DI void attn_finish(AttnState<NG>& st, bf16_t* orow  , int hstride, int quad) {
#pragma unroll
    for (int g = 0; g < NG; ++g) { const float inv = 1.0f / quad_sum(st.l[g]);
#pragma unroll
        for (int d = 0; d < 4; ++d) { const f32x4 o = st.o[g][d] * inv; u32x2 w; w.x = pk2(o[0], o[1]); w.y = pk2(o[2], o[3]);
            *(u32x2*)(orow + g * hstride + 16 * d + 4 * quad) = w; } }
}

DI void gqa_unit_x(unsigned char* ws, int u, int lane) {
    const int c16 = lane & 15, quad = lane >> 4;
    const int qb = u & 255, kvh = (u >> 8) & 1, b = u >> 9;
    const bf16_t* HX = (const bf16_t*)(ws + WS_HB); bf16_t* MIX = (bf16_t*)(ws + WS_HN);
    const size_t qrow = (size_t)b * SEQ + 16 * qb + c16;
    AttnState<2> st; attn_init(st);
#pragma unroll
    for (int g = 0; g < 2; ++g) { const bf16_t* qp = HX + qrow * DINP + C_GQQ + (2 * kvh + g) * 64 + quad * 8; st.q[g][0] = ld16(qp); st.q[g][1] = ld16(qp + 32); }
    const bf16_t* vt = (const bf16_t*)(ws + WS_GVT) + ((size_t)(b * 2 + kvh) * 64 + c16) * KSEQ + quad * 4;
    attn_run<2>(st, HX + ((size_t)b * SEQ + c16) * DINP + C_GQK + kvh * 64 + quad * 8, DINP, vt, SEQ / 32);
    attn_run<2>(st, HX + ((size_t)TX + b * CTX + c16) * DINP + C_GQK + kvh * 64 + quad * 8, DINP, vt + SEQ, CTX / 32);
    attn_finish<2>(st, MIX + qrow * DM + 768 + (2 * kvh) * 64, 64, quad);
}
DI void gqa_unit_z(unsigned char* ws, int u, int lane) {
    const int c16 = lane & 15, quad = lane >> 4;
    const int qb = u & 15, kvh = (u >> 4) & 1, b = u >> 5;
    const bf16_t* HX = (const bf16_t*)(ws + WS_HB); bf16_t* MIX = (bf16_t*)(ws + WS_HN);
    const size_t qrow = (size_t)TX + b * CTX + 16 * qb + c16;
    AttnState<2> st; attn_init(st);
#pragma unroll
    for (int g = 0; g < 2; ++g) { const bf16_t* qp = HX + qrow * DINP + C_GQQ + (2 * kvh + g) * 64 + quad * 8; st.q[g][0] = ld16(qp); st.q[g][1] = ld16(qp + 32); }
    const bf16_t* vt = (const bf16_t*)(ws + WS_GVT) + ((size_t)(b * 2 + kvh) * 64 + c16) * KSEQ + quad * 4;
    attn_run<2>(st, HX + ((size_t)TX + b * CTX + c16) * DINP + C_GQK + kvh * 64 + quad * 8, DINP, vt + SEQ, CTX / 32);
    attn_finish<2>(st, MIX + qrow * DM + 768 + (2 * kvh) * 64, 64, quad);
}
DI void na_unit_z(unsigned char* ws, int u, int lane) {
    const int c16 = lane & 15, quad = lane >> 4;
    const int qb = u & 15, h = (u >> 4) & 3, b = u >> 6;
    const bf16_t* HX = (const bf16_t*)(ws + WS_HB); bf16_t* MIX = (bf16_t*)(ws + WS_HN);
    const size_t qrow = (size_t)TX + b * CTX + 16 * qb + c16;
    AttnState<1> st; attn_init(st);
    { const bf16_t* qp = HX + qrow * DINP + C_NAQ + h * 64 + quad * 8; st.q[0][0] = ld16(qp); st.q[0][1] = ld16(qp + 32); }
    const bf16_t* vt = (const bf16_t*)(ws + WS_NAVT) + ((size_t)(b * 4 + h) * 64 + c16) * KSEQ + quad * 4;
    attn_run<1>(st, HX + ((size_t)TX + b * CTX + c16) * DINP + C_NAK + h * 64 + quad * 8, DINP, vt + SEQ, CTX / 32);
    attn_finish<1>(st, MIX + qrow * DM + 256 + h * 64, 64, quad);
}
DI void na_unit_x(unsigned char* ws, const LAS float* rpbL, int u, int lane) {
    const int c16 = lane & 15, quad = lane >> 4;
    const int cb = u & 3, r = (u >> 2) & 63, h = (u >> 8) & 3, b = u >> 10;
    const bf16_t* HX = (const bf16_t*)(ws + WS_HB); bf16_t* MIX = (bf16_t*)(ws + WS_HN);
    const int c = 16 * cb + c16;
    const size_t qrow = (size_t)b * SEQ + 64 * r + c;
    AttnState<1> st; attn_init(st);
    { const bf16_t* qp = HX + qrow * DINP + C_NAQ + h * 64 + quad * 8; st.q[0][0] = ld16(qp); st.q[0][1] = ld16(qp + 32); }
    const bf16_t* vt = (const bf16_t*)(ws + WS_NAVT) + ((size_t)(b * 4 + h) * 64 + c16) * KSEQ + quad * 4;
    const int rs = min(max(r - 4, 0), 56), cbase = min(max(16 * cb - 8, 0), 32), cs = min(max(c - 8, 0), 48);
    const LAS float* rpb = rpbL + h * 15 * 31;
#pragma unroll 2
    for (int wr = 0; wr < 8; ++wr) {
        const int krow = rs + wr, t0 = krow * 64 + cbase;
        const LAS float* bp = rpb + (krow - r + 7) * 31;
        f32x4 b0, b1;
#pragma unroll
        for (int j = 0; j < 4; ++j) { const int kc0 = cbase + 4 * quad + j, kc1 = kc0 + 16;
            const bool ok0 = (kc0 >= cs) && (kc0 < cs + 16), ok1 = (kc1 >= cs) && (kc1 < cs + 16);
            const float w0 = bp[min(max(kc0 - c + 15, 0), 30)], w1 = bp[min(max(kc1 - c + 15, 0), 30)];
            b0[j] = ok0 ? w0 * LOG2E : -1e30f; b1[j] = ok1 ? w1 * LOG2E : -1e30f; }
        const bf16_t* kp0 = HX + ((size_t)b * SEQ + t0 + c16) * DINP + C_NAK + h * 64 + quad * 8;
        attn_block<1, true>(st, kp0, kp0 + (size_t)16 * DINP, vt + t0, vt + t0 + 16, b0, b1);
    }
    attn_run<1>(st, HX + ((size_t)TX + b * CTX + c16) * DINP + C_NAK + h * 64 + quad * 8, DINP, vt + SEQ, CTX / 32);
    attn_finish<1>(st, MIX + qrow * DM + 256 + h * 64, 64, quad);
}

DI void na_row_unit(unsigned char* ws, const LAS float* rpbL, int u, int lane) {
    const int c16 = lane & 15, quad = lane >> 4;
    const int r = u & 63, h = (u >> 6) & 3, b = u >> 8;
    const bf16_t* HX = (const bf16_t*)(ws + WS_HB); bf16_t* MIX = (bf16_t*)(ws + WS_HN);
    const size_t qrow0 = (size_t)b * SEQ + 64 * r;
    float m[4], l[4]; f32x4 o[4][4]; bf16x8 q[4][2];
#pragma unroll
    for (int g = 0; g < 4; ++g) { m[g] = -1e30f; l[g] = 0.f;
#pragma unroll
        for (int d = 0; d < 4; ++d) o[g][d] = (f32x4){0.f, 0.f, 0.f, 0.f};
        const bf16_t* qp = HX + (qrow0 + 16 * g + c16) * DINP + C_NAQ + h * 64 + quad * 8; q[g][0] = ld16(qp); q[g][1] = ld16(qp + 32); }
    const bf16_t* vt = (const bf16_t*)(ws + WS_NAVT) + ((size_t)(b * 4 + h) * 64 + c16) * KSEQ + quad * 8;
    const int tokoff = 8 * (c16 >> 2) + (c16 & 3);
    const int rs = min(max(r - 4, 0), 56);
    const LAS float* rpb = rpbL + h * 15 * 31;
#pragma unroll 1
    for (int blk = 0; blk < 24; ++blk) {
        const bool win = blk < 16; const int wr = blk >> 1, cblk = blk & 1;
        const int t0 = win ? (rs + wr) * 64 + 32 * cblk : SEQ + 32 * (blk - 16);
        const bf16_t* kbase = (win ? HX + ((size_t)b * SEQ + t0 + tokoff) * DINP : HX + ((size_t)TX + b * CTX + (t0 - SEQ) + tokoff) * DINP) + C_NAK + h * 64 + quad * 8;
        const bf16x8 kA0 = ld16(kbase), kA1 = ld16(kbase + 32), kB0 = ld16(kbase + (size_t)4 * DINP), kB1 = ld16(kbase + (size_t)4 * DINP + 32);
        bf16x8 vf[4];
#pragma unroll
        for (int d = 0; d < 4; ++d) vf[d] = ld16(vt + t0 + (size_t)d * 16 * KSEQ);
        const LAS float* bp = rpb + (win ? (rs + wr - r + 7) : 0) * 31;
#pragma unroll
        for (int g = 0; g < 4; ++g) {
            if (win && ((g == 0 && cblk == 1) || (g == 3 && cblk == 0))) continue;
            f32x4 s0 = MFMA16(kA0, q[g][0], ((f32x4){0.f, 0.f, 0.f, 0.f})); s0 = MFMA16(kA1, q[g][1], s0);
            f32x4 s1 = MFMA16(kB0, q[g][0], ((f32x4){0.f, 0.f, 0.f, 0.f})); s1 = MFMA16(kB1, q[g][1], s1);
            if (win) { const int c = 16 * g + c16, cs = min(max(c - 8, 0), 48);
                const int kc0 = 32 * cblk + 8 * quad, lo = cs - kc0; const LAS float* bq = bp + (kc0 - c + 15);
#pragma unroll
                for (int j = 0; j < 4; ++j) { const float w0 = bq[j], w1 = bq[j + 4];
                    const bool ok0 = (unsigned)(j - lo) < 16u, ok1 = (unsigned)(j + 4 - lo) < 16u;
                    s0[j] = ok0 ? s0[j] + w0 * LOG2E : -INFINITY; s1[j] = ok1 ? s1[j] + w1 * LOG2E : -INFINITY; } }
            float mx = fmaxf(fmaxf(fmaxf(s0[0], s0[1]), fmaxf(s0[2], s0[3])), fmaxf(fmaxf(s1[0], s1[1]), fmaxf(s1[2], s1[3])));
            mx = quad_max(mx);
            if (__any(mx > m[g] + 8.0f)) { const float mn = fmaxf(m[g], mx), corr = __builtin_amdgcn_exp2f(m[g] - mn); m[g] = mn; l[g] *= corr;
#pragma unroll
                for (int d = 0; d < 4; ++d) o[g][d] = o[g][d] * corr; }
            const float mr = m[g];
            f32x4 p0, p1;
#pragma unroll
            for (int j = 0; j < 4; ++j) { p0[j] = __builtin_amdgcn_exp2f(s0[j] - mr); p1[j] = __builtin_amdgcn_exp2f(s1[j] - mr); }
            l[g] += ((p0[0] + p0[1]) + (p0[2] + p0[3])) + ((p1[0] + p1[1]) + (p1[2] + p1[3]));
            const bf16x8 pf = pack8(p0, p1);
#pragma unroll
            for (int d = 0; d < 4; ++d) o[g][d] = MFMA16(vf[d], pf, o[g][d]);
        }
    }
#pragma unroll
    for (int g = 0; g < 4; ++g) { const float inv = 1.0f / quad_sum(l[g]); bf16_t* orow = MIX + (qrow0 + 16 * g + c16) * DM + 256 + h * 64;
#pragma unroll
        for (int d = 0; d < 4; ++d) { const f32x4 ov = o[g][d] * inv; u32x2 w; w.x = pk2(ov[0], ov[1]); w.y = pk2(ov[2], ov[3]);
            *(u32x2*)(orow + 16 * d + 4 * quad) = w; } }
}

DI int chunk_row0(int b, int pc) { return pc < 64 ? b * SEQ + 64 * pc : TX + b * CTX + 64 * (pc - 64); }
DI void gla_local_unit(unsigned char* ws, int u, int lane) {
    const int c16 = lane & 15, quad = lane >> 4;
    const int pc = u % NCHUNK; const int seq = u / NCHUNK; const int dir = seq & 1, h = (seq >> 1) & 3, b = seq >> 3;
    const bf16_t* vt = (const bf16_t*)(ws + WS_GLVT) + ((size_t)(b * 4 + h) * 64 + c16) * KSEQ + 64 * pc + quad * 8;
    const bf16_t* kt = (const bf16_t*)(ws + WS_KKT) + ((size_t)((dir * NB + b) * 4 + h) * 32 + c16) * KSEQ + 64 * pc + quad * 8;
    bf16x8 kf[2][2];
#pragma unroll
    for (int db = 0; db < 2; ++db)
#pragma unroll
        for (int ks = 0; ks < 2; ++ks) kf[db][ks] = ld16(kt + (size_t)db * 16 * KSEQ + 32 * ks);
    float* dst = (float*)(ws + WS_SLOC) + ((size_t)seq * NCHUNK + pc) * 2048;
#pragma unroll
    for (int eb = 0; eb < 4; ++eb) { const bf16x8 a0 = ld16(vt + (size_t)eb * 16 * KSEQ), a1 = ld16(vt + (size_t)eb * 16 * KSEQ + 32);
#pragma unroll
        for (int db = 0; db < 2; ++db) { f32x4 acc = MFMA16(a0, kf[db][0], ((f32x4){0.f, 0.f, 0.f, 0.f})); acc = MFMA16(a1, kf[db][1], acc);
#pragma unroll
            for (int j = 0; j < 4; ++j) dst[(16 * eb + 4 * quad + j) * 32 + 16 * db + c16] = acc[j]; } }
}
DI void gla_scan(unsigned char* ws, int gt, int NT) {
    const float* sloc = (const float*)(ws + WS_SLOC); bf16_t* sst = (bf16_t*)(ws + WS_SST); const float* blast = (const float*)(ws + WS_BLAST);
    for (int idx = gt; idx < 64 * 2048; idx += NT) {
        const int el = idx & 2047, seq = idx >> 11, d = el & 31, dir = seq & 1, h = (seq >> 1) & 3, b = seq >> 3;
        float S = 0.f;
        for (int s0 = 0; s0 < NCHUNK; s0 += 17) {
            float lv[17], dv[17];
#pragma unroll
            for (int i = 0; i < 17; ++i) { const int s = s0 + i; const int pc = (dir == 0) ? (s < 4 ? 64 + s : s - 4) : (s < 4 ? 67 - s : 67 - s);
                lv[i] = sloc[((size_t)seq * NCHUNK + pc) * 2048 + el]; dv[i] = blast[(((size_t)b * NCHUNK + pc) * 2 + dir) * 128 + h * 32 + d]; }
#pragma unroll
            for (int i = 0; i < 17; ++i) { const int s = s0 + i; const int pc = (dir == 0) ? (s < 4 ? 64 + s : s - 4) : (s < 4 ? 67 - s : 67 - s);
                sst[((size_t)seq * NCHUNK + pc) * 2048 + el] = f2bf(S); S = __expf(dv[i]) * S + lv[i]; }
        }
    }
}
DI void gla_out_unit(const Params& p, int l, int u, int lane) {
    unsigned char* ws = p.ws;
    const int c16 = lane & 15, quad = lane >> 4;
    const int ib = u & 3, pc = (u >> 2) % NCHUNK, bh = (u >> 2) / NCHUNK, h = bh & 3, b = bh >> 2;
    const bf16_t* HX = (const bf16_t*)(ws + WS_HB); bf16_t* MIX = (bf16_t*)(ws + WS_HN);
    const int row0 = chunk_row0(b, pc);
    const bf16_t* vt = (const bf16_t*)(ws + WS_GLVT) + ((size_t)(b * 4 + h) * 64 + c16) * KSEQ + 64 * pc + quad * 4;
    f32x4 o[4];
#pragma unroll
    for (int e = 0; e < 4; ++e) o[e] = (f32x4){0.f, 0.f, 0.f, 0.f};
    const int i_tok = 16 * ib + c16;
#pragma unroll
    for (int dir = 0; dir < 2; ++dir) {
        const int qc = (dir == 0 ? C_GLQ : C_GLQB) + h * 32, kc = (dir == 0 ? C_GLK : C_GLKB) + h * 32;
        const bf16x8 qf = ld16(HX + (size_t)(row0 + i_tok) * DINP + qc + quad * 8);
        const bf16_t* sp = (const bf16_t*)(ws + WS_SST) + ((size_t)((b * 4 + h) * 2 + dir) * NCHUNK + pc) * 2048 + c16 * 32 + quad * 8;
#pragma unroll
        for (int e = 0; e < 4; ++e) o[e] = MFMA16(ld16(sp + e * 16 * 32), qf, o[e]);
#pragma unroll
        for (int pr = 0; pr < 2; ++pr) {
            f32x4 s[2];
#pragma unroll
            for (int sb = 0; sb < 2; ++sb) { const int jb = 2 * pr + sb;
                const bf16x8 kf = ld16(HX + (size_t)(row0 + 16 * jb + c16) * DINP + kc + quad * 8);
                s[sb] = MFMA16(kf, qf, ((f32x4){0.f, 0.f, 0.f, 0.f}));
#pragma unroll
                for (int j = 0; j < 4; ++j) { const int jt = 16 * jb + 4 * quad + j; const bool keep = (dir == 0) ? (jt <= i_tok) : (jt >= i_tok); s[sb][j] = keep ? s[sb][j] : 0.f; } }
            const bf16x8 pf = pack8(s[0], s[1]);
#pragma unroll
            for (int e = 0; e < 4; ++e) o[e] = MFMA16(cat8(ld8(vt + (size_t)e * 16 * KSEQ + 32 * pr), ld8(vt + (size_t)e * 16 * KSEQ + 32 * pr + 16)), pf, o[e]);
        }
    }
    float ss = 0.f;
#pragma unroll
    for (int e = 0; e < 4; ++e) ss += (o[e][0] * o[e][0] + o[e][1] * o[e][1]) + (o[e][2] * o[e][2] + o[e][3] * o[e][3]);
    ss = quad_sum(ss);
    const float rstd = rsqrtf(ss * (1.0f / 64.0f) + EPS);
    const float* gain = p.in[17] + l * 64;
    const size_t row = (size_t)row0 + i_tok;
#pragma unroll
    for (int e = 0; e < 4; ++e) { const int ec = 16 * e + 4 * quad;
        const u32x2 rr = *(const u32x2*)(HX + row * DINP + C_GLR + h * 64 + ec); const f32x4 g = *(const f32x4*)(gain + ec);
        const float r0 = __uint_as_float(rr.x << 16), r1 = __uint_as_float(rr.x & 0xffff0000u), r2 = __uint_as_float(rr.y << 16), r3 = __uint_as_float(rr.y & 0xffff0000u);
        u32x2 w; w.x = pk2(o[e][0] * rstd * g[0] * pg8::silu_f(r0), o[e][1] * rstd * g[1] * pg8::silu_f(r1)); w.y = pk2(o[e][2] * rstd * g[2] * pg8::silu_f(r2), o[e][3] * rstd * g[3] * pg8::silu_f(r3));
        *(u32x2*)(MIX + row * DM + 512 + h * 64 + ec) = w; }
}

DI void gla_chunk_unit(const Params& p, int l, int u, int lane) {
    unsigned char* ws = p.ws;
    const int c16 = lane & 15, quad = lane >> 4;
    const int pc = u % NCHUNK, bh = u / NCHUNK, h = bh & 3, b = bh >> 2;
    const bf16_t* HX = (const bf16_t*)(ws + WS_HB); bf16_t* MIX = (bf16_t*)(ws + WS_HN);
    const int row0 = chunk_row0(b, pc);
    const bf16_t* vt = (const bf16_t*)(ws + WS_GLVT) + ((size_t)(b * 4 + h) * 64 + c16) * KSEQ + 64 * pc + quad * 8;
    bf16x8 vf[2][4];
#pragma unroll
    for (int pr = 0; pr < 2; ++pr)
#pragma unroll
        for (int e = 0; e < 4; ++e) vf[pr][e] = ld16(vt + (size_t)e * 16 * KSEQ + 32 * pr);
    f32x4 o[4][4];
#pragma unroll
    for (int ib = 0; ib < 4; ++ib)
#pragma unroll
        for (int e = 0; e < 4; ++e) o[ib][e] = (f32x4){0.f, 0.f, 0.f, 0.f};
    const int ktok = 8 * (c16 >> 2) + (c16 & 3);
#pragma unroll
    for (int dir = 0; dir < 2; ++dir) {
        const int qc = (dir == 0 ? C_GLQ : C_GLQB) + h * 32, kc = (dir == 0 ? C_GLK : C_GLKB) + h * 32;
        bf16x8 qf[4], sf[4], kA[2], kB[2];
#pragma unroll
        for (int ib = 0; ib < 4; ++ib) qf[ib] = ld16(HX + (size_t)(row0 + 16 * ib + c16) * DINP + qc + quad * 8);
        const bf16_t* sp = (const bf16_t*)(ws + WS_SST) + ((size_t)((b * 4 + h) * 2 + dir) * NCHUNK + pc) * 2048 + c16 * 32 + quad * 8;
#pragma unroll
        for (int e = 0; e < 4; ++e) sf[e] = ld16(sp + e * 16 * 32);
#pragma unroll
        for (int pr = 0; pr < 2; ++pr) { const bf16_t* kp = HX + (size_t)(row0 + 32 * pr + ktok) * DINP + kc + quad * 8; kA[pr] = ld16(kp); kB[pr] = ld16(kp + (size_t)4 * DINP); }
#pragma unroll
        for (int ib = 0; ib < 4; ++ib) {
#pragma unroll
            for (int e = 0; e < 4; ++e) o[ib][e] = MFMA16(sf[e], qf[ib], o[ib][e]);
            const int it = 16 * ib + c16;
#pragma unroll
            for (int pr = 0; pr < 2; ++pr) {
                const bool need = (dir == 0) ? (32 * pr <= 16 * ib + 15) : (32 * pr + 31 >= 16 * ib);
                if (!need) continue;
                f32x4 s0 = MFMA16(kA[pr], qf[ib], ((f32x4){0.f, 0.f, 0.f, 0.f})), s1 = MFMA16(kB[pr], qf[ib], ((f32x4){0.f, 0.f, 0.f, 0.f}));
#pragma unroll
                for (int j = 0; j < 4; ++j) { const int j0 = 32 * pr + 8 * quad + j, j1 = j0 + 4;
                    const bool k0 = (dir == 0) ? (j0 <= it) : (j0 >= it), k1 = (dir == 0) ? (j1 <= it) : (j1 >= it);
                    s0[j] = k0 ? s0[j] : 0.f; s1[j] = k1 ? s1[j] : 0.f; }
                const bf16x8 pf = pack8(s0, s1);
#pragma unroll
                for (int e = 0; e < 4; ++e) o[ib][e] = MFMA16(vf[pr][e], pf, o[ib][e]);
            }
        }
    }
    const float* gain = p.in[17] + l * 64;
#pragma unroll
    for (int ib = 0; ib < 4; ++ib) {
        float ss = 0.f;
#pragma unroll
        for (int e = 0; e < 4; ++e) ss += (o[ib][e][0] * o[ib][e][0] + o[ib][e][1] * o[ib][e][1]) + (o[ib][e][2] * o[ib][e][2] + o[ib][e][3] * o[ib][e][3]);
        ss = quad_sum(ss);
        const float rstd = rsqrtf(ss * (1.0f / 64.0f) + EPS);
        const size_t row = (size_t)row0 + 16 * ib + c16;
#pragma unroll
        for (int e = 0; e < 4; ++e) { const int ec = 16 * e + 4 * quad;
            const u32x2 rr = *(const u32x2*)(HX + row * DINP + C_GLR + h * 64 + ec); const f32x4 g = *(const f32x4*)(gain + ec);
            const float r0 = __uint_as_float(rr.x << 16), r1 = __uint_as_float(rr.x & 0xffff0000u), r2 = __uint_as_float(rr.y << 16), r3 = __uint_as_float(rr.y & 0xffff0000u);
            u32x2 w; w.x = pk2(o[ib][e][0] * rstd * g[0] * pg8::silu_f(r0), o[ib][e][1] * rstd * g[1] * pg8::silu_f(r1)); w.y = pk2(o[ib][e][2] * rstd * g[2] * pg8::silu_f(r2), o[ib][e][3] * rstd * g[3] * pg8::silu_f(r3));
            *(u32x2*)(MIX + row * DM + 512 + h * 64 + ec) = w; }
    }
}

DI void four1_unit(unsigned char* ws, int u, int lane) {
    const int c16 = lane & 15, quad = lane >> 4;
    const int cq = u & 3, l2 = (u >> 2) & 63, bg = u >> 8, g = bg & 3, b = bg >> 2;
    const bf16_t* HX = (const bf16_t*)(ws + WS_HB);
    const bf16_t* FC = (const bf16_t*)(ws + WS_TAB + T_FC64); const bf16_t* FSN = (const bf16_t*)(ws + WS_TAB + T_FSN64); const float* TW = (const float*)(ws + WS_TAB + T_TW);
    bf16x8 uf[2];
    const bf16_t* up = HX + ((size_t)b * SEQ + l2) * DINP + C_FOUR + g * 64 + 16 * cq + c16;
#pragma unroll
    for (int ks = 0; ks < 2; ++ks) { unsigned hh[8];
#pragma unroll
        for (int j = 0; j < 8; ++j) hh[j] = up[(size_t)(64 * (quad * 8 + j + 32 * ks)) * DINP];
        u32x4 w; w.x = hh[0] | (hh[1] << 16); w.y = hh[2] | (hh[3] << 16); w.z = hh[4] | (hh[5] << 16); w.w = hh[6] | (hh[7] << 16); uf[ks] = __builtin_bit_cast(bf16x8, w); }
    bf16_t* tr = (bf16_t*)(ws + WS_TTR); bf16_t* ti = (bf16_t*)(ws + WS_TTI);
#pragma unroll
    for (int kq = 0; kq < 4; ++kq) {
        const bf16_t* fr = FC + (16 * kq + c16) * 64 + quad * 8; const bf16_t* fi = FSN + (16 * kq + c16) * 64 + quad * 8;
        f32x4 re = MFMA16(ld16(fr), uf[0], ((f32x4){0.f, 0.f, 0.f, 0.f})); re = MFMA16(ld16(fr + 32), uf[1], re);
        f32x4 im = MFMA16(ld16(fi), uf[0], ((f32x4){0.f, 0.f, 0.f, 0.f})); im = MFMA16(ld16(fi + 32), uf[1], im);
#pragma unroll
        for (int j = 0; j < 4; ++j) { const int kb = 16 * kq + 4 * quad + j; const float cw = TW[2 * (kb * 64 + l2)], sw = TW[2 * (kb * 64 + l2) + 1];
            const float xr = re[j] * cw + im[j] * sw, xi = im[j] * cw - re[j] * sw;
            const size_t off = (((size_t)bg * 64 + kb) * 64 + l2) * 64 + 16 * cq + c16;
            tr[off] = f2bf(xr); ti[off] = f2bf(xi); }
    }
}
template <int NLB, bool CPLX> DI void four2_unit(const bf16_t* xr, const bf16_t* xi, size_t xpitch, const bf16_t* FC64, const bf16_t* FS64, const bf16_t* FSN64,
                                                  const bf16_t* FLC, const bf16_t* FLS, bf16_t* out, size_t out_rstride, float scale, int mb, int lane, int kq_lo = 0, int kq_hi = NLB) {
    const int c16 = lane & 15, quad = lane >> 4;
    bf16x8 bc[2], bs[2], bsn[2];
#pragma unroll
    for (int ks = 0; ks < 2; ++ks) { const size_t o = (size_t)(16 * mb + c16) * 64 + quad * 8 + 32 * ks; bc[ks] = ld16(FC64 + o); bs[ks] = ld16(FS64 + o); bsn[ks] = ld16(FSN64 + o); }
    bf16x8 qr[NLB / 2], qi[NLB / 2];
#pragma unroll
    for (int pr = 0; pr < NLB / 2; ++pr) {
        f32x4 tr[2], ti[2];
#pragma unroll
        for (int sb = 0; sb < 2; ++sb) { const int lb = 2 * pr + sb;
            const bf16_t* xp = xr + (size_t)(16 * lb + c16) * xpitch + quad * 8;
            const bf16x8 a0 = ld16(xp), a1 = ld16(xp + 32);
            tr[sb] = MFMA16(a0, bc[0], ((f32x4){0.f, 0.f, 0.f, 0.f})); tr[sb] = MFMA16(a1, bc[1], tr[sb]);
            ti[sb] = MFMA16(a0, bsn[0], ((f32x4){0.f, 0.f, 0.f, 0.f})); ti[sb] = MFMA16(a1, bsn[1], ti[sb]);
            if (CPLX) { const bf16_t* yp = xi + (size_t)(16 * lb + c16) * xpitch + quad * 8; const bf16x8 i0 = ld16(yp), i1 = ld16(yp + 32);
                tr[sb] = MFMA16(i0, bs[0], tr[sb]); tr[sb] = MFMA16(i1, bs[1], tr[sb]);
                ti[sb] = MFMA16(i0, bc[0], ti[sb]); ti[sb] = MFMA16(i1, bc[1], ti[sb]); } }
        qr[pr] = pack8(tr[0], tr[1]); qi[pr] = pack8(ti[0], ti[1]);
    }
    constexpr int NL = NLB * 16;
#pragma unroll 2
    for (int kq = kq_lo; kq < kq_hi; ++kq) {
        f32x4 y = {0.f, 0.f, 0.f, 0.f};
        const bf16_t* fc = FLC + (size_t)(16 * kq + c16) * NL + quad * 4; const bf16_t* fs = FLS + (size_t)(16 * kq + c16) * NL + quad * 4;
#pragma unroll
        for (int pr = 0; pr < NLB / 2; ++pr) { y = MFMA16(cat8(ld8(fc + 32 * pr), ld8(fc + 32 * pr + 16)), qr[pr], y); y = MFMA16(cat8(ld8(fs + 32 * pr), ld8(fs + 32 * pr + 16)), qi[pr], y); }
#pragma unroll
        for (int j = 0; j < 4; ++j) out[(size_t)(16 * kq + 4 * quad + j) * out_rstride + c16] = f2bf(y[j] * scale);
    }
}

DI void four2_row_unit(unsigned char* ws, int u, int lane) {
    asm volatile("" : "+v"(lane));
    const int c16 = lane & 15, quad = lane >> 4;
    const int kb = u & 63, bg = u >> 6;
    const unsigned char* tab = ws + WS_TAB;
    const bf16_t* FC = (const bf16_t*)(tab + T_FC64); const bf16_t* FS = (const bf16_t*)(tab + T_FS64); const bf16_t* FSN = (const bf16_t*)(tab + T_FSN64);
    const size_t xo = ((size_t)bg * 64 + kb) * 4096;
    const bf16_t* xr = (const bf16_t*)(ws + WS_TTR) + xo; const bf16_t* xi = (const bf16_t*)(ws + WS_TTI) + xo;
    bf16x8 tc[4][2], ts[4][2];
#pragma unroll
    for (int kq = 0; kq < 4; ++kq)
#pragma unroll
        for (int pr = 0; pr < 2; ++pr) { const size_t o = (size_t)(16 * kq + c16) * 64 + quad * 4 + 32 * pr; tc[kq][pr] = cat8(ld8(FC + o), ld8(FC + o + 16)); ts[kq][pr] = cat8(ld8(FS + o), ld8(FS + o + 16)); }
    bf16_t* out = (bf16_t*)(ws + WS_HN) + ((size_t)(bg >> 2) * SEQ + kb) * DM + (bg & 3) * 64;
#pragma unroll 1
    for (int mb = 0; mb < 4; ++mb) {
        bf16x8 bc[2], bs[2], bsn[2];
#pragma unroll
        for (int ks = 0; ks < 2; ++ks) { const size_t o = (size_t)(16 * mb + c16) * 64 + quad * 8 + 32 * ks; bc[ks] = ld16(FC + o); bs[ks] = ld16(FS + o); bsn[ks] = ld16(FSN + o); }
        bf16x8 qr[2], qi[2];
#pragma unroll
        for (int pr = 0; pr < 2; ++pr) { f32x4 tr[2], ti[2];
#pragma unroll
            for (int sb = 0; sb < 2; ++sb) { const int lb = 2 * pr + sb; const size_t o = (size_t)(16 * lb + c16) * 64 + quad * 8;
                const bf16x8 ar0 = ld16(xr + o), ar1 = ld16(xr + o + 32), ai0 = ld16(xi + o), ai1 = ld16(xi + o + 32);
                tr[sb] = MFMA16(ar0, bc[0], ((f32x4){0.f, 0.f, 0.f, 0.f})); tr[sb] = MFMA16(ar1, bc[1], tr[sb]); tr[sb] = MFMA16(ai0, bs[0], tr[sb]); tr[sb] = MFMA16(ai1, bs[1], tr[sb]);
                ti[sb] = MFMA16(ar0, bsn[0], ((f32x4){0.f, 0.f, 0.f, 0.f})); ti[sb] = MFMA16(ar1, bsn[1], ti[sb]); ti[sb] = MFMA16(ai0, bc[0], ti[sb]); ti[sb] = MFMA16(ai1, bc[1], ti[sb]); }
            qr[pr] = pack8(tr[0], tr[1]); qi[pr] = pack8(ti[0], ti[1]); }
#pragma unroll
        for (int kq = 0; kq < 4; ++kq) { f32x4 y = {0.f, 0.f, 0.f, 0.f};
#pragma unroll
            for (int pr = 0; pr < 2; ++pr) { y = MFMA16(tc[kq][pr], qr[pr], y); y = MFMA16(ts[kq][pr], qi[pr], y); }
#pragma unroll
            for (int j = 0; j < 4; ++j) out[(size_t)(16 * kq + 4 * quad + j) * 64 * DM + 16 * mb + c16] = f2bf(y[j] * (1.0f / 512.0f)); }
    }
}

#define PHASE_VARS \
    int tid = threadIdx.x; asm volatile("" : "+v"(tid)); \
    const int lane = tid & 63, wave = __builtin_amdgcn_readfirstlane(tid >> 6); \
    const int G = gridDim.x, bid = blockIdx.x, vbid = ((G & 7) == 0) ? (bid & 7) * (G >> 3) + (bid >> 3) : bid, gw = vbid * 8 + wave, NGW = G * 8, gt = bid * 512 + tid, NT = G * 512; \
    size_t ws_off0 = 0; asm volatile("" : "+s"(ws_off0)); unsigned char* ws = p.ws + ws_off0; \
    int hs = hs_loop; asm volatile("" : "+s"(hs)); \
    const int l = hs >> 1; const bool second = hs & 1; const bool lastl = (l == 1); \
    const float* mod = (const float*)(ws + WS_MOD) + (size_t)l * 9 * 9216; \
    const unsigned char* wl = ws + WS_W + (size_t)l * W_LAYER; \
    float* ZB = (float*)(ws + WS_Z); bf16_t* HN = (bf16_t*)(ws + WS_HN); bf16_t* HB = (bf16_t*)(ws + WS_HB); \
    (void)vbid; (void)lane; (void)wave; (void)gw; (void)NGW; (void)gt; (void)NT; (void)second; (void)lastl; (void)mod; (void)wl; (void)ZB; (void)HN; (void)HB; (void)bid; (void)G;

__global__ void __launch_bounds__(512, 2) mega_fwd(Params p) {
    extern __shared__ __attribute__((aligned(16))) unsigned char lds_raw[];
    LAS unsigned char* lds = (LAS unsigned char*)lds_raw;
    cg::grid_group grid = cg::this_grid();
    if (threadIdx.x < 2) ((volatile LAS unsigned*)(lds + LDS_BARST))[threadIdx.x] = 0u;
    __syncthreads();
    (void)xcd_barrier_post((unsigned*)(p.ws + WS_BAR), (volatile LAS unsigned*)(lds + LDS_BARST));
#define GRID_BAR() grid_bar_fn((unsigned*)(p.ws + WS_BAR), (unsigned)LDS_BARST)
#if DIAG_MODE
    unsigned long long t_prev = __builtin_amdgcn_s_memrealtime(); unsigned t_cat[8] = {0u, 0u, 0u, 0u, 0u, 0u, 0u, 0u};
#define STAMP(c) do { const unsigned long long t_now = __builtin_amdgcn_s_memrealtime(); t_cat[c] += (unsigned)(t_now - t_prev); t_prev = t_now; } while (0)
#else
#define STAMP(c) do {} while (0)
#endif
    { const int hs_loop = 0; PHASE_VARS
      phase_prologue<true>(p, lds, tid, lane, wave, bid, G, 0, 2); }
    grid.sync(); STAMP(0);
    { const int hs_loop = 0; PHASE_VARS
      shift_bias_mfma(ws, gw, NGW, lane);
      scale_pass(p.in[0], p.in[2], mod, 1, HN, (float*)(ws + WS_ROWSS), TT, gw, NGW, lane); }
    GRID_BAR(); STAMP(1);
    for (int rs_ = 0; rs_ < REP_SYNC; ++rs_) GRID_BAR();

#pragma unroll 1
    for (int hs_loop = 0; hs_loop < 4; ++hs_loop) {
        for (int rep = 0; rep < REP_UP; ++rep) {
        { PHASE_VARS
          const int Mrows = (hs == 3) ? TX : TT;
          const bf16_t* Ain = second ? (const bf16_t*)(ws + WS_NAVT) : HN;
          const int slot = second ? (l == 0 ? 2 : 5) : (l == 0 ? 0 : 3);
          pg8::Gemm g{Ain, (const bf16_t*)(wl + (second ? W_UP2 : W_UP1)), Mrows, 2 * DFF, DM, DM}; pg8::PrefOrder S; S.init(Mrows, 2 * DFF, G, bid);
          S.rowss = (const float*)(ws + WS_ROWSS) + (size_t)slot * TT; S.sb = (const float*)(ws + WS_SB) + (size_t)l * SB_LAYER + (second ? SB_UP2 : SB_UP1); S.sbN = 2 * DFF;
          pg8::EpiSwiglu E{HB, DFF};
          pg8::gemm_phase<pg8::EpiSwiglu, pg8::PrefOrder, true, true>(lds, g, S, E); }
        GRID_BAR(); STAMP(2); }
        { PHASE_VARS
          const float* xin = (hs == 0) ? p.in[0] : p.out;
          bf16_t* hn = (hs == 3) ? (bf16_t*)nullptr : HN;
          const float* nscale = second ? (const float*)(ws + WS_MOD) + (size_t)9 * 9216 + 1 * 1024 : mod + 4 * 1024;
          const int nslot = second ? 3 : (l == 0 ? 1 : 4);
          pg8::Gemm g{HB, (const bf16_t*)(wl + (second ? W_DN2 : W_DN1)), TX, DM, DFF, DFF}; pg8::StaticOrder S; S.init(TX, DM, G, bid);
          pg8::EpiResid E{xin, ZB, p.out, ZB, mod + (second ? 8 : 2) * 1024, 0.5f, hn, nscale, (float*)(ws + WS_ROWSS) + (size_t)nslot * TT};
          pg8::gemm_phase<pg8::EpiResid, pg8::StaticOrder, true, true>(lds, g, S, E); }
        if (hs_loop < 3) {
        { PHASE_VARS
          const int sl = bid & 3, koff = (sl == 0) ? 0 : (sl == 1) ? 768 : (sl == 2) ? 1408 : 2176, klen = (sl & 1) ? 640 : 768;
          pg8::Gemm g{HB + koff, (const bf16_t*)(wl + (second ? W_DN2 : W_DN1)) + koff, TT, DM, klen, DFF};
          pg8::OneUnit S{128 + (bid >> 4), (bid >> 2) & 3, bid < 128};
          pg8::EpiPart E{(float*)(ws + WS_TTR) + (size_t)sl * TZ * DM - (size_t)TX * DM};
          pg8::gemm_phase<pg8::EpiPart, pg8::OneUnit, false, true>(lds, g, S, E); }
        GRID_BAR();
        { PHASE_VARS
          const float* zin = (hs == 0) ? p.in[2] : ZB;
          const float* nscale = second ? (const float*)(ws + WS_MOD) + (size_t)9 * 9216 + 1 * 1024 : mod + 4 * 1024;
          const int nslot = second ? 3 : (l == 0 ? 1 : 4);
          z_finalize(ws, zin, mod + (size_t)8 * 9216 + (second ? 8 : 2) * 1024, HN + (size_t)TX * DM, nscale + (size_t)8 * 9216, (float*)(ws + WS_ROWSS) + (size_t)nslot * TT + TX, gw, NGW, lane); }
        }
        GRID_BAR(); STAMP(2);
        if (hs_loop & 1) continue;
        { PHASE_VARS
          pg8::Gemm g{HN, (const bf16_t*)(wl + W_IN), TT, DINP, DM, DM}; pg8::PrefOrder S; S.init(TT, DINP, G, bid);
          S.rowss = (const float*)(ws + WS_ROWSS) + (size_t)(l == 0 ? 1 : 4) * TT; S.sb = (const float*)(ws + WS_SB) + (size_t)l * SB_LAYER + SB_IN; S.sbN = DINP;
          pg8::EpiBf16 E{HB, DINP}; pg8::gemm_phase<pg8::EpiBf16, pg8::PrefOrder, true, true>(lds, g, S, E); }
        GRID_BAR(); STAMP(3);
        { PHASE_VARS
          for (int i = tid; i < 2048; i += 512) ((LAS float*)(lds + 65536))[i] = ((const float*)(ws + WS_TAB + T_ROPE))[i];
          __syncthreads();
          for (int t = bid; t < 544; t += G) prep_tile(p, l, t, lds, tid); }
        { PHASE_VARS
          const int n_busy = 544 - 2 * G;
          if (n_busy > 0 && n_busy < G) { if (bid >= n_busy) for (int u = (bid - n_busy) * 8 + wave; u < 8192; u += (G - n_busy) * 8) four1_unit(ws, u, lane); }
          else for (int u = gw; u < 8192; u += NGW) four1_unit(ws, u, lane); }
        GRID_BAR(); STAMP(4);
        for (int rep = 0; rep < REP_S3; ++rep) {
        { PHASE_VARS
          gla_scan(ws, gt, NT); }
        { PHASE_VARS
          const unsigned char* tab = ws + WS_TAB;
          for (int i = tid; i < 4 * 15 * 31; i += 512) ((LAS float*)lds)[i] = p.in[12][(size_t)l * 4 * 15 * 31 + i];
          __syncthreads();
          const int n_f2 = 2048, n_na = 2048, n_fz = lastl ? 0 : 512, n_naz = lastl ? 0 : 512;
          const int tot = n_f2 + n_na + n_fz + n_naz;
          for (int u = gw; u < tot; u += NGW) {
              if (u < n_na) { for (int rn = 0; rn < REP_NA; ++rn) na_row_unit(ws, (const LAS float*)lds, u, lane); }
              else if (u < n_na + n_f2) { for (int rf = 0; rf < REP_F2; ++rf) four2_row_unit(ws, u - n_na, lane); }
              else if (u < n_na + n_f2 + n_fz) { const int v = u - n_na - n_f2; const int qt = v & 3, mb = (v >> 2) & 3, bg = v >> 4;
                  const bf16_t* xr = HB + ((size_t)TX + (bg >> 2) * CTX) * DINP + C_FOUR + (bg & 3) * 64;
                  four2_unit<16, false>(xr, xr, DINP, (const bf16_t*)(tab + T_FC64), (const bf16_t*)(tab + T_FS64), (const bf16_t*)(tab + T_FSN64),
                                        (const bf16_t*)(tab + T_FC256), (const bf16_t*)(tab + T_FS256), HN + ((size_t)TX + (bg >> 2) * CTX) * DM + (bg & 3) * 64 + 16 * mb, (size_t)DM, 1.0f / 128.0f, mb, lane, 4 * qt, 4 * qt + 4); }
              else na_unit_z(ws, u - n_na - n_f2 - n_fz, lane);
          } }
        GRID_BAR(); STAMP(6); }
        for (int rep = 0; rep < REP_S4; ++rep) {
        { PHASE_VARS
          typedef attn_body::bf16 abf;
          const abf* HXb = (const abf*)HB; abf* MIXb = (abf*)HN;
          const int n_units = 512 + (lastl ? 0 : 32);
          for (int u = vbid; u < n_units; u += G) {
              const abf *Qu, *K0, *V0, *K1, *V1; abf* Ou; int NT0, NTt;
              if (u < 512) { const int b = u >> 6, h = (u >> 4) & 3, qb = u & 15, kvh = h >> 1;
                  Qu = HXb + ((size_t)b * SEQ + 256 * qb) * DINP + C_GQQ + h * 64;
                  K0 = HXb + (size_t)b * SEQ * DINP + C_GQK + kvh * 64; V0 = HXb + (size_t)b * SEQ * DINP + C_GQV + kvh * 64;
                  K1 = HXb + ((size_t)TX + b * CTX) * DINP + C_GQK + kvh * 64; V1 = HXb + ((size_t)TX + b * CTX) * DINP + C_GQV + kvh * 64;
                  NT0 = 64; NTt = 68; Ou = MIXb + ((size_t)b * SEQ + 256 * qb) * DM + 768 + h * 64; }
              else { const int v = u - 512, b = v >> 2, h = v & 3, kvh = h >> 1;
                  Qu = HXb + ((size_t)TX + b * CTX) * DINP + C_GQQ + h * 64;
                  K1 = HXb + ((size_t)TX + b * CTX) * DINP + C_GQK + kvh * 64; V1 = HXb + ((size_t)TX + b * CTX) * DINP + C_GQV + kvh * 64; K0 = K1; V0 = V1;
                  NT0 = 0; NTt = 4; Ou = MIXb + ((size_t)TX + b * CTX) * DM + 768 + h * 64; }
              attn_body::attn_unit<8>(Qu, K0, V0, K1, V1, NT0, NTt, Ou, (char*)lds_raw);
          } }
        { PHASE_VARS
          const int n_lat = 8 * 4 * 64, n_ctx = lastl ? 0 : 8 * 4 * 4 * 4;
          const int voff = (NGW > n_ctx) ? NGW - n_ctx : 0;
          for (int u = gw; u < n_lat; u += NGW) gla_chunk_unit(p, l, (u >> 6) * NCHUNK + (u & 63), lane);
          for (int v = gw - voff; v < n_ctx; v += NGW) if (v >= 0) { const int ib = v & 3, pcz = (v >> 2) & 3, bh = v >> 4; gla_out_unit(p, l, ((bh * NCHUNK + 64 + pcz) << 2) | ib, lane); } }
        GRID_BAR(); STAMP(7); }
        { PHASE_VARS
          const int Mo = lastl ? TX : TT; pg8::Gemm g{HN, (const bf16_t*)(wl + W_OUT), Mo, DM, DM, DM}; pg8::StaticOrder S; S.init(Mo, DM, G, bid);
          pg8::EpiResid E{p.out, ZB, p.out, ZB, mod + 5 * 1024, 1.0f, (bf16_t*)(ws + WS_NAVT), mod + 7 * 1024, (float*)(ws + WS_ROWSS) + (size_t)(l == 0 ? 2 : 5) * TT}; pg8::gemm_phase<pg8::EpiResid, pg8::StaticOrder, true, true>(lds, g, S, E); }
        GRID_BAR(); STAMP(3);
    }
#if DIAG_MODE
    if (blockIdx.x == 0) {
        const float ta = (float)t_cat[DIAG_A] * 0.01f, tb = (float)t_cat[DIAG_B] * 0.01f;
        if (threadIdx.x == 0) p.out[0] = 100.0f * ta;
        for (int i = threadIdx.x; i < (1 << 20); i += 512) p.out[1024 + i] = tb;
    }
#endif
}

extern "C" void kernel_launch(void* const* d_in, const int* in_sizes, int n_in, void* d_out, int out_size, void* d_ws, size_t ws_size, hipStream_t stream) {
    static int grid = 0;
    if (grid == 0) {
        int dev = 0, cus = 0, per_cu = 0;
        hipGetDevice(&dev);
        hipDeviceGetAttribute(&cus, hipDeviceAttributeMultiprocessorCount, dev);
        hipFuncSetAttribute((const void*)mega_fwd, hipFuncAttributeMaxDynamicSharedMemorySize, LDS_BYTES);
        hipOccupancyMaxActiveBlocksPerMultiprocessor(&per_cu, (const void*)mega_fwd, 512, LDS_BYTES);
        (void)hipGetLastError();
        if (per_cu < 1) per_cu = 1;
        if (per_cu > 1) per_cu = 1;
        grid = cus * per_cu;
        if (n_in != 24 || ws_size < WS_END) { fprintf(stderr, "kernel_launch: unexpected n_in %d / ws_size %zu (need %zu)\n", n_in, ws_size, (size_t)WS_END); }
    }
    (void)hipMemsetAsync((unsigned char*)d_ws + WS_BAR, 0, 16384, stream);
    Params p{};
    for (int i = 0; i < 24; ++i) p.in[i] = (const float*)d_in[i];
    p.out = (float*)d_out; p.ws = (unsigned char*)d_ws;
    void* args[] = {&p};
    hipError_t e = hipLaunchCooperativeKernel((const void*)mega_fwd, dim3(grid), dim3(512), args, LDS_BYTES, stream);
    if (e != hipSuccess) fprintf(stderr, "cooperative launch failed: %s (grid %d)\n", hipGetErrorString(e), grid);
}
```

```cpp
#include <hip/hip_runtime.h>
#include <hip/hip_cooperative_groups.h>
#include <cstdio>
#include <cstdint>
namespace cg = cooperative_groups;

namespace pg8 {
#define PG8_LAS __attribute__((address_space(3)))
typedef unsigned short bf16_t;
typedef short bf16x8 __attribute__((ext_vector_type(8)));
typedef float f32x4 __attribute__((ext_vector_type(4)));
typedef unsigned u32x4 __attribute__((ext_vector_type(4)));
constexpr int BM = 256, BK = 64, HALF = 128, HTB = HALF * BK * 2  , STAGE_BYTES = 8 * HTB, NXCD = 8, WGM = 8;

__host__ __device__ __forceinline__ int lds_byte(int r, int c) { const int st = (r >> 4) * 2 + (c >> 5), rr = r & 15, cc = c & 31, ob = rr * 64 + cc * 2; return st * 1024 + (ob ^ (((ob >> 9) & 1) << 5)); }
__host__ __device__ __forceinline__ void stage_rc(int b, int& R, int& C) { const int st = b / 1024, sb = b % 1024, swz = sb ^ (((sb >> 9) & 1) << 5); R = (st >> 1) * 16 + swz / 64; C = (st & 1) * 32 + (swz % 64) / 2; }
__host__ __device__ __forceinline__ int perm32(int rho) { const int n = rho >> 4, i = rho & 15; return 8 * (i >> 2) + 4 * n + (i & 3); }

struct Unit { int pm, pn, slot; };
struct Gemm { const bf16_t* A; const bf16_t* Bt; int M, N, K, ld; };

struct StaticOrder {
    int nM, nN, nwg, G, c;
    __host__ __device__ void init(int M, int N, int G_, int c_) { nM = M / BM; nN = N / BM; nwg = nM * nN; G = G_; c = c_; }
    __host__ __device__ bool next(int i, Unit& u) const {
        const long L = (long)i * G + c; if (L >= nwg) return false; u.slot = i & 1;
        int wgid = (int)L; { const int q = nwg / NXCD, r = nwg % NXCD, xcd = wgid % NXCD, off = wgid / NXCD; wgid = (xcd < r ? xcd * (q + 1) : r * (q + 1) + (xcd - r) * q) + off; }
        const int nig = WGM * nN, gid = wgid / nig, fm = gid * WGM, gsz = (nM - fm) < WGM ? (nM - fm) : WGM;
        u.pm = fm + ((wgid % nig) % gsz); u.pn = (wgid % nig) / gsz; return true;
    }
    __device__ __forceinline__ void a_ready(const Unit&) const {}
    __device__ __forceinline__ void done(const Unit&) const {}
};

__device__ __forceinline__ unsigned cvt_pk_bf16(float lo, float hi) {
    typedef float f32x2_t __attribute__((ext_vector_type(2))); typedef __bf16 bf16x2_t __attribute__((ext_vector_type(2)));
    f32x2_t v = {lo, hi}; bf16x2_t b = __builtin_convertvector(v, bf16x2_t); return __builtin_bit_cast(unsigned, b);
}
__device__ __forceinline__ float silu_f(float v) { return v * __builtin_amdgcn_rcpf(1.0f + __expf(-v)); }
constexpr int ROWS_X = 32768;
constexpr unsigned PREF_LDS_ADDR = 131072 + 1024;
#define PG8_PREF ((PG8_LAS float*)(size_t)PREF_LDS_ADDR)
__device__ __forceinline__ float fq_sum(float v) {
    v += __int_as_float(__builtin_amdgcn_ds_swizzle(__float_as_int(v), (16 << 10) | 0x1F));
    auto rr = __builtin_amdgcn_permlane32_swap(__float_as_uint(v), __float_as_uint(v), false, false); return __uint_as_float(rr[0]) + __uint_as_float(rr[1]); }
constexpr float NORM_EPS = 1e-6f;

struct EpiBf16 {
    static constexpr bool PERM = true, AFTER_DRAIN = false;
    bf16_t* O; int ldo;
    __device__ __forceinline__ void operator()(const f32x4 (&acc)[2][2][4][2], const Unit& u, int wr, int wc, int fr, int fq) const {
        const int row0 = u.pm * BM + wr * 64 + fr, col0 = u.pn * BM + wc * 32 + 8 * fq;
        const PG8_LAS float* ps = PG8_PREF + u.slot * 512;
        f32x4 sbv[2][2];
#pragma unroll
        for (int bj = 0; bj < 2; ++bj)
#pragma unroll
            for (int n = 0; n < 2; ++n) sbv[bj][n] = *(const PG8_LAS f32x4*)(ps + 256 + wc * 32 + 8 * fq + bj * HALF + 4 * n);
#pragma unroll
        for (int ai = 0; ai < 2; ++ai)
#pragma unroll
            for (int m = 0; m < 4; ++m) { bf16_t* rowp = O + (size_t)(row0 + ai * HALF + m * 16) * ldo + col0;
                const float rstd = rsqrtf(ps[wr * 64 + fr + ai * HALF + m * 16] * (1.0f / 1024.0f) + NORM_EPS);
#pragma unroll
                for (int bj = 0; bj < 2; ++bj) { const f32x4 v0 = acc[ai][bj][m][0] * rstd + sbv[bj][0], v1 = acc[ai][bj][m][1] * rstd + sbv[bj][1]; u32x4 w;
                    w.x = cvt_pk_bf16(v0[0], v0[1]); w.y = cvt_pk_bf16(v0[2], v0[3]); w.z = cvt_pk_bf16(v1[0], v1[1]); w.w = cvt_pk_bf16(v1[2], v1[3]);
                    *(u32x4*)(rowp + bj * HALF) = w; } }
    }
};
struct EpiSwiglu {
    static constexpr bool PERM = true, AFTER_DRAIN = false;
    bf16_t* O; int ldo;
    __device__ __forceinline__ void operator()(const f32x4 (&acc)[2][2][4][2], const Unit& u, int wr, int wc, int fr, int fq) const {
        const int row0 = u.pm * BM + wr * 64 + fr, col0 = u.pn * HALF + wc * 32 + 8 * fq;
        const PG8_LAS float* ps = PG8_PREF + u.slot * 512;
        f32x4 sbv[2][2];
#pragma unroll
        for (int bj = 0; bj < 2; ++bj)
#pragma unroll
            for (int n = 0; n < 2; ++n) sbv[bj][n] = *(const PG8_LAS f32x4*)(ps + 256 + bj * HALF + wc * 32 + 8 * fq + 4 * n);
#pragma unroll
        for (int ai = 0; ai < 2; ++ai)
#pragma unroll
            for (int m = 0; m < 4; ++m) { bf16_t* rowp = O + (size_t)(row0 + ai * HALF + m * 16) * ldo + col0;
                const float rstd = rsqrtf(ps[wr * 64 + fr + ai * HALF + m * 16] * (1.0f / 1024.0f) + NORM_EPS);
                const f32x4 g0 = acc[ai][0][m][0] * rstd + sbv[0][0], g1 = acc[ai][0][m][1] * rstd + sbv[0][1], u0 = acc[ai][1][m][0] * rstd + sbv[1][0], u1 = acc[ai][1][m][1] * rstd + sbv[1][1]; u32x4 w;
                w.x = cvt_pk_bf16(silu_f(g0[0]) * u0[0], silu_f(g0[1]) * u0[1]); w.y = cvt_pk_bf16(silu_f(g0[2]) * u0[2], silu_f(g0[3]) * u0[3]);
                w.z = cvt_pk_bf16(silu_f(g1[0]) * u1[0], silu_f(g1[1]) * u1[1]); w.w = cvt_pk_bf16(silu_f(g1[2]) * u1[2], silu_f(g1[3]) * u1[3]);
                *(u32x4*)rowp = w; }
    }
};
struct EpiResid {
    static constexpr bool PERM = false, AFTER_DRAIN = false;
    const float* inx; const float* inz; float* outx; float* outz; const float* gate;   float s;
    bf16_t* hn; const float* nscale; float* rowss;
    __device__ __forceinline__ void operator()(const f32x4 (&acc)[2][2][4][2], const Unit& u, int wr, int wc, int fr, int fq) const {
        const int trow = u.pm * BM; const bool isx = trow < ROWS_X; const int mi = isx ? (trow >> 12) : 8;
        const float* ib = isx ? inx + (size_t)trow * 1024 : inz + (size_t)(trow - ROWS_X) * 1024;
        float* ob = isx ? outx + (size_t)trow * 1024 : outz + (size_t)(trow - ROWS_X) * 1024;
        const int col0 = u.pn * BM + wc * 32 + 4 * fq; const float* gp = gate + (size_t)mi * 9216 + col0;
        f32x4 gv[2][2]; unsigned svp[2][2][2];
        const bool fuse = hn != nullptr;
#pragma unroll
        for (int bj = 0; bj < 2; ++bj)
#pragma unroll
            for (int n = 0; n < 2; ++n) { gv[bj][n] = *(const f32x4*)(gp + bj * HALF + n * 16) * s;
                const f32x4 svf = fuse ? *(const f32x4*)(nscale + (size_t)mi * 9216 + col0 + bj * HALF + n * 16) + 1.0f : (f32x4){1.f, 1.f, 1.f, 1.f};
                svp[bj][n][0] = cvt_pk_bf16(svf[0], svf[1]); svp[bj][n][1] = cvt_pk_bf16(svf[2], svf[3]); }
#pragma unroll
        for (int ch = 0; ch < 3; ++ch) {
            constexpr int NRG = 3;
            f32x4 pre[NRG][2][2];
#pragma unroll
            for (int k = 0; k < NRG; ++k) { const int rg = 3 * ch + k; if (rg < 8) { const int ai = rg >> 2, m = rg & 3;
#pragma unroll
                for (int bj = 0; bj < 2; ++bj)
#pragma unroll
                    for (int n = 0; n < 2; ++n) pre[k][bj][n] = *(const f32x4*)(ib + (unsigned)((ai * HALF + wr * 64 + m * 16 + fr) * 1024 + col0 + bj * HALF + n * 16)); } }
#pragma unroll
            for (int k = 0; k < NRG; ++k) { const int rg = 3 * ch + k; if (rg < 8) { const int ai = rg >> 2, m = rg & 3; const int rt = ai * HALF + wr * 64 + m * 16 + fr; const unsigned off = (unsigned)(rt * 1024 + col0); float ssq = 0.f;
#pragma unroll
                for (int bj = 0; bj < 2; ++bj)
#pragma unroll
                    for (int n = 0; n < 2; ++n) { const f32x4 bs = pre[k][bj][n];
                        const f32x4 xn = bs + gv[bj][n] * acc[ai][bj][m][n];
                        *(f32x4*)(ob + off + bj * HALF + n * 16) = xn;
                        if (fuse) { const unsigned p0 = svp[bj][n][0], p1 = svp[bj][n][1];
                            const f32x4 a = xn * (f32x4){__uint_as_float(p0 << 16), __uint_as_float(p0 & 0xffff0000u), __uint_as_float(p1 << 16), __uint_as_float(p1 & 0xffff0000u)}; typedef unsigned u32x2e __attribute__((ext_vector_type(2))); u32x2e w; w.x = cvt_pk_bf16(a[0], a[1]); w.y = cvt_pk_bf16(a[2], a[3]);
                            *(u32x2e*)(hn + (size_t)trow * 1024 + (off + bj * HALF + n * 16)) = w;
                            ssq += (xn[0] * xn[0] + xn[1] * xn[1]) + (xn[2] * xn[2] + xn[3] * xn[3]); } }
                if (fuse) { ssq = fq_sum(ssq); if (fq == 0) __hip_atomic_fetch_add(rowss + trow + rt, ssq, __ATOMIC_RELAXED, __HIP_MEMORY_SCOPE_AGENT); } } } }
    }
};

struct OneUnit {
    int pm, pn; bool have;
    __device__ __forceinline__ bool next(int i, Unit& u) const { if (i != 0 || !have) return false; u.pm = pm; u.pn = pn; u.slot = 0; return true; }
    __device__ __forceinline__ void a_ready(const Unit&) const {}
    __device__ __forceinline__ void done(const Unit&) const {}
};
struct EpiPart {
    static constexpr bool PERM = false, AFTER_DRAIN = false;
    float* P;
    __device__ __forceinline__ void operator()(const f32x4 (&acc)[2][2][4][2], const Unit& u, int wr, int wc, int fr, int fq) const {
        const int col0 = u.pn * BM + wc * 32 + 4 * fq;
#pragma unroll
        for (int ai = 0; ai < 2; ++ai)
#pragma unroll
            for (int m = 0; m < 4; ++m) { float* rp = P + (size_t)(u.pm * BM + ai * HALF + wr * 64 + m * 16 + fr) * 1024 + col0;
#pragma unroll
                for (int bj = 0; bj < 2; ++bj)
#pragma unroll
                    for (int n = 0; n < 2; ++n) *(f32x4*)(rp + bj * HALF + n * 16) = acc[ai][bj][m][n]; }
    }
};
struct PrefOrder : StaticOrder {
    const float* rowss; const float* sb; int sbN;
    __device__ __forceinline__ void a_ready(const Unit& u) const {
        const int wid = __builtin_amdgcn_readfirstlane((int)threadIdx.x >> 6); const unsigned voff = (threadIdx.x & 63u) * 16u;
        const int mi = (u.pm * BM < ROWS_X) ? ((u.pm * BM) >> 12) : 8;
        const float* src = (wid == 0) ? rowss + (size_t)u.pm * BM : sb + (size_t)mi * sbN + (size_t)u.pn * BM;
        const unsigned dst = PREF_LDS_ADDR + (unsigned)u.slot * 2048u + (wid == 0 ? 0u : 1024u);
        if (wid < 2) { unsigned keep; asm volatile("s_mov_b32 %0, m0\n\ts_mov_b32 m0, %2\n\ts_nop 0\n\tglobal_load_lds_dwordx4 %1, %3\n\ts_mov_b32 m0, %0" : "=&s"(keep) : "v"(voff), "s"(dst), "s"(src) : "memory"); }
    }
};
template <class Epi, class Sched, bool ALIGN_EPI = false, bool SP2 = false>
__device__ __forceinline__ void gemm_phase(PG8_LAS unsigned char* lds, const Gemm g, const Sched& S, const Epi& E) {
    int tid = threadIdx.x; asm volatile("" : "+v"(tid)); const int wid = __builtin_amdgcn_readfirstlane(tid >> 6), lane = tid & 63, wr = wid >> 2, wc = wid & 3, fr = lane & 15, fq = lane >> 4;
    const int K = g.K, nt = K / BK, LD = g.ld;
    unsigned voffA[2], voffB[2];
#pragma unroll
    for (int i = 0; i < 2; ++i) { int R, C; stage_rc(tid * 16 + i * 8192, R, C); const int Rb = Epi::PERM ? ((R & ~31) + perm32(R & 31)) : R;
        voffA[i] = (unsigned)(R * LD + C) * 2u; voffB[i] = (unsigned)(Rb * LD + C) * 2u; }
    const size_t kstep = (size_t)(BK * 2);
    const size_t hstep = (size_t)HALF * LD * 2;
    const size_t tstep = 2 * hstep;
    const unsigned ldsw = (unsigned)wid * 1024u;
    const int aoff = lds_byte(wr * 64 + fr, fq * 8), boff = lds_byte(wc * 32 + fr, fq * 8);
#define PG8_SA(b, h) (((b) * 2 + (h)) * HTB)
#define PG8_SB(b, h) ((4 + (b) * 2 + (h)) * HTB)
#define PG8_STAGE(bufoff, gbase, voff) do { _Pragma("unroll") for (int _i = 0; _i < 2; ++_i) \
        __builtin_amdgcn_global_load_lds((const unsigned*)((const char*)(gbase) + (voff)[_i]), (PG8_LAS unsigned*)(lds + (bufoff) + ldsw + _i * 8192), 16, 0, 0); } while (0)
#define PG8_LDA(dst, b, h) do { _Pragma("unroll") for (int m = 0; m < 4; ++m) _Pragma("unroll") for (int k = 0; k < 2; ++k) dst[m][k] = *(const PG8_LAS bf16x8*)(lds + PG8_SA(b, h) + aoff + m * 2048 + k * 1024); } while (0)
#define PG8_LDB(dst, b, h) do { _Pragma("unroll") for (int n = 0; n < 2; ++n) _Pragma("unroll") for (int k = 0; k < 2; ++k) dst[n][k] = *(const PG8_LAS bf16x8*)(lds + PG8_SB(b, h) + boff + n * 2048 + k * 1024); } while (0)
#define PG8_MMA(ai, bj, At, Bt) do { __builtin_amdgcn_s_setprio(1); _Pragma("unroll") for (int m = 0; m < 4; ++m) _Pragma("unroll") for (int n = 0; n < 2; ++n) _Pragma("unroll") for (int k = 0; k < 2; ++k) \
        acc[ai][bj][m][n] = __builtin_amdgcn_mfma_f32_16x16x32_bf16(Bt[n][k], At[m][k], acc[ai][bj][m][n], 0, 0, 0); __builtin_amdgcn_s_setprio(0); } while (0)
#define PG8_WAIT_V(n) asm volatile("s_waitcnt vmcnt(" #n ")" ::: "memory")
#define PG8_WAIT_L(n) asm volatile("s_waitcnt lgkmcnt(" #n ")" ::: "memory")
#define PG8_BAR __builtin_amdgcn_s_barrier()
#define PG8_SCHED __builtin_amdgcn_sched_barrier(0)
    Unit cur, nxt; int ui = 0;
    if (!S.next(0, cur)) return;
    f32x4 acc[2][2][4][2];
#pragma unroll
    for (int a = 0; a < 2; ++a)
#pragma unroll
        for (int b = 0; b < 2; ++b)
#pragma unroll
            for (int m = 0; m < 4; ++m)
#pragma unroll
                for (int n = 0; n < 2; ++n) acc[a][b][m][n] = (f32x4){0.f, 0.f, 0.f, 0.f};
    bf16x8 At[4][2], B0[2][2], B1[2][2];
    const char* cA = (const char*)g.A + (size_t)cur.pm * tstep; const char* cB = (const char*)g.Bt + (size_t)cur.pn * tstep;
    S.a_ready(cur);
    if constexpr (SP2) {
        PG8_STAGE(PG8_SB(0, 0), cB, voffB); PG8_STAGE(PG8_SB(0, 1), cB + hstep, voffB); PG8_STAGE(PG8_SA(0, 0), cA, voffA); PG8_STAGE(PG8_SA(0, 1), cA + hstep, voffA);
        if (wr == 1) PG8_BAR;
        PG8_WAIT_V(2); PG8_BAR;
        PG8_STAGE(PG8_SB(1, 0), cB + kstep, voffB); PG8_STAGE(PG8_SA(1, 0), cA + kstep, voffA); PG8_STAGE(PG8_SB(1, 1), cB + hstep + kstep, voffB);
        PG8_WAIT_V(6); PG8_BAR;
    } else {
        PG8_STAGE(PG8_SB(0, 0), cB, voffB); PG8_STAGE(PG8_SA(0, 0), cA, voffA); PG8_STAGE(PG8_SB(0, 1), cB + hstep, voffB); PG8_STAGE(PG8_SA(0, 1), cA + hstep, voffA);
        if (wr == 1) PG8_BAR;
        PG8_WAIT_V(4); PG8_BAR;
        PG8_STAGE(PG8_SB(1, 0), cB + kstep, voffB); PG8_STAGE(PG8_SA(1, 0), cA + kstep, voffA); PG8_STAGE(PG8_SB(1, 1), cB + hstep + kstep, voffB);
        PG8_WAIT_V(6); PG8_BAR;
    }
    for (;;) {
        const bool has_next = S.next(ui + 1, nxt);
        const char* nA = has_next ? (const char*)g.A + (size_t)nxt.pm * tstep : cA; const char* nB = has_next ? (const char*)g.Bt + (size_t)nxt.pn * tstep : cB;
        for (int t = 0; t < nt; t += 2) {
            const bool last = (t == nt - 2);
            const char* a1 = cA + (size_t)(t + 1) * kstep;
            const char* a2 = last ? nA : cA + (size_t)(t + 2) * kstep; const char* b2 = last ? nB : cB + (size_t)(t + 2) * kstep;
            const char* a3 = a2 + kstep; const char* b3 = b2 + kstep;
            if (last && has_next) S.a_ready(nxt);
            if constexpr (SP2) {
            PG8_LDB(B0, 0, 0); PG8_LDB(B1, 0, 1); PG8_SCHED; PG8_LDA(At, 0, 0); PG8_STAGE(PG8_SA(1, 1), a1 + hstep, voffA);
            PG8_WAIT_V(8); PG8_WAIT_L(0); PG8_BAR; PG8_MMA(0, 0, At, B0); PG8_MMA(0, 1, At, B1); PG8_BAR; PG8_SCHED;
            PG8_LDA(At, 0, 1); PG8_STAGE(PG8_SB(0, 0), b2, voffB); PG8_STAGE(PG8_SB(0, 1), b2 + hstep, voffB); PG8_STAGE(PG8_SA(0, 0), a2, voffA);
            PG8_WAIT_V(8); PG8_WAIT_L(0); PG8_BAR; PG8_MMA(1, 0, At, B0); PG8_MMA(1, 1, At, B1); PG8_BAR; PG8_SCHED;
            PG8_LDB(B0, 1, 0); PG8_LDB(B1, 1, 1); PG8_SCHED; PG8_LDA(At, 1, 0); PG8_STAGE(PG8_SA(0, 1), a2 + hstep, voffA);
            PG8_WAIT_V(8); PG8_WAIT_L(0); PG8_BAR; PG8_MMA(0, 0, At, B0); PG8_MMA(0, 1, At, B1); PG8_BAR; PG8_SCHED;
            PG8_LDA(At, 1, 1); PG8_STAGE(PG8_SB(1, 0), b3, voffB); PG8_STAGE(PG8_SB(1, 1), b3 + hstep, voffB); PG8_STAGE(PG8_SA(1, 0), a3, voffA);
            PG8_WAIT_V(8); PG8_WAIT_L(0); PG8_BAR; PG8_MMA(1, 0, At, B0); PG8_MMA(1, 1, At, B1); PG8_BAR; PG8_SCHED;
            } else {
            PG8_LDB(B0, 0, 0); PG8_SCHED; PG8_LDA(At, 0, 0); PG8_STAGE(PG8_SA(1, 1), a1 + hstep, voffA);
            PG8_WAIT_L(8); PG8_BAR; PG8_WAIT_L(0); PG8_MMA(0, 0, At, B0); PG8_BAR; PG8_SCHED;
            PG8_LDB(B1, 0, 1); PG8_STAGE(PG8_SB(0, 0), b2, voffB);
            PG8_BAR; PG8_WAIT_L(0); PG8_MMA(0, 1, At, B1); PG8_BAR;
            PG8_LDA(At, 0, 1); PG8_STAGE(PG8_SA(0, 0), a2, voffA);
            PG8_BAR; PG8_WAIT_L(0); PG8_MMA(1, 0, At, B0); PG8_BAR; PG8_SCHED;
            PG8_STAGE(PG8_SB(0, 1), b2 + hstep, voffB);
            PG8_WAIT_V(6); PG8_BAR; PG8_MMA(1, 1, At, B1); PG8_BAR;
            PG8_LDB(B0, 1, 0); PG8_SCHED; PG8_LDA(At, 1, 0); PG8_STAGE(PG8_SA(0, 1), a2 + hstep, voffA);
            PG8_WAIT_L(8); PG8_BAR; PG8_WAIT_L(0); PG8_MMA(0, 0, At, B0); PG8_BAR; PG8_SCHED;
            PG8_LDB(B1, 1, 1); PG8_STAGE(PG8_SB(1, 0), b3, voffB);
            PG8_BAR; PG8_WAIT_L(0); PG8_MMA(0, 1, At, B1); PG8_BAR;
            PG8_LDA(At, 1, 1); PG8_STAGE(PG8_SA(1, 0), a3, voffA);
            PG8_BAR; PG8_WAIT_L(0); PG8_MMA(1, 0, At, B0); PG8_BAR; PG8_SCHED;
            PG8_STAGE(PG8_SB(1, 1), b3 + hstep, voffB);
            PG8_WAIT_V(6); PG8_BAR; PG8_MMA(1, 1, At, B1); PG8_BAR;
            }
        }
        if constexpr (ALIGN_EPI) { if (wr == 0) PG8_BAR; }
        if constexpr (!Epi::AFTER_DRAIN) { E(acc, cur, wr, wc, fr, fq); S.done(cur); }
        if (!has_next) break;
#pragma unroll
        for (int a = 0; a < 2; ++a)
#pragma unroll
            for (int b = 0; b < 2; ++b)
#pragma unroll
                for (int m = 0; m < 4; ++m)
#pragma unroll
                    for (int n = 0; n < 2; ++n) acc[a][b][m][n] = (f32x4){0.f, 0.f, 0.f, 0.f};
        cur = nxt; cA = nA; cB = nB; ++ui;
        if constexpr (ALIGN_EPI) { if (wr == 1) PG8_BAR; }
    }
    PG8_WAIT_V(0);
    if constexpr (!ALIGN_EPI) { if (wr == 0) PG8_BAR; }
    PG8_BAR;
    if constexpr (Epi::AFTER_DRAIN) { E.fused(acc, cur, wr, wc, fr, fq, lds, wid, lane); S.done(cur); }
#undef PG8_SA
#undef PG8_SB
#undef PG8_STAGE
#undef PG8_LDA
#undef PG8_LDB
#undef PG8_MMA
#undef PG8_WAIT_V
#undef PG8_WAIT_L
#undef PG8_BAR
#undef PG8_SCHED
}
}
#include <hip/hip_bf16.h>
#include <cmath>
namespace attn_body {
using bf16=__hip_bfloat16;
using bf16x8=__attribute__((ext_vector_type(8)))short;
using s16x4=__attribute__((ext_vector_type(4)))short;
using f32x16=__attribute__((ext_vector_type(16)))float;
using u32x4=__attribute__((ext_vector_type(4)))unsigned;
constexpr int D=64,QP=2560,KP=2560,OP=1024;
constexpr int NW=8,QBLK=32,QB=QBLK*NW,KVBLK=64;
__device__ __forceinline__ int crow(int r,int hi){return (r&3)+8*(r>>2)+4*hi;}
#define SBAR() __builtin_amdgcn_sched_barrier(0)
__device__ __forceinline__ void cmask(f32x16&p0,f32x16&p1,int jb,int qrel,int hi){
  const float NEG=-INFINITY; int kb=64*jb+4*hi;
  #pragma unroll
  for(int r=0;r<16;++r){int kv=kb+(r&3)+8*(r>>2); if(kv>qrel)p0[r]=NEG; if(kv+32>qrel)p1[r]=NEG;}
}

constexpr int NSLOT=3, SLOTB=8192;
constexpr int LDS_K=0, LDS_V=NSLOT*SLOTB, LDS_WS=2*NSLOT*SLOTB, LDS_OST=LDS_WS+NW*64*4, LDS_BYTES=LDS_OST+NW*4096;
constexpr float C2=0.125f*1.4426950408889634f;
__device__ __forceinline__ void glds16(const void*gbase,unsigned voff,unsigned lds_dst){unsigned keep;
  asm volatile("s_mov_b32 %0, m0\n\ts_mov_b32 m0, %2\n\ts_nop 0\n\tglobal_load_lds_dwordx4 %1, %3\n\ts_mov_b32 m0, %0":"=&s"(keep):"v"(voff),"s"(lds_dst),"s"(gbase):"memory");}
__device__ __forceinline__ float max3f(float a,float b,float c){float r;asm("v_max3_f32 %0, %1, %2, %3":"=v"(r):"v"(a),"v"(b),"v"(c));return r;}
__device__ __forceinline__ float max2f(float a,float b){float r;asm("v_max_f32_e32 %0, %1, %2":"=v"(r):"v"(a),"v"(b));return r;}
__device__ __forceinline__ float fadd_s(float a,float b){float r;asm("v_add_f32_e32 %0, %1, %2":"=v"(r):"v"(a),"v"(b));return r;}
__device__ __forceinline__ float fsub_s(float a,float b){float r;asm("v_sub_f32_e32 %0, %1, %2":"=v"(r):"v"(a),"v"(b));return r;}
typedef float f32x2_t __attribute__((ext_vector_type(2))); typedef __bf16 bf16x2_t __attribute__((ext_vector_type(2)));
__device__ __forceinline__ unsigned cvtpk_s(float lo,float hi){f32x2_t v={lo,hi};bf16x2_t b=__builtin_convertvector(v,bf16x2_t);return __builtin_bit_cast(unsigned,b);}
#define WAIT_BAR(N) asm volatile("s_waitcnt vmcnt(" #N ") lgkmcnt(0)\n\ts_barrier":::"memory")

__device__ __forceinline__ void qkt(f32x16&p0,f32x16&p1,const char*Kslot,const bf16x8*qr,const f32x16&negm,int r32,int hi){
  const char*kb=Kslot+hi*1024+r32*16;
  #pragma unroll
  for(int d0=0;d0<4;++d0){
    const bf16x8 b0=*reinterpret_cast<const bf16x8*>(kb+d0*2048);
    const bf16x8 b1=*reinterpret_cast<const bf16x8*>(kb+d0*2048+512);
    if(d0==0){p0=__builtin_amdgcn_mfma_f32_32x32x16_bf16(b0,qr[0],negm,0,0,0);p1=__builtin_amdgcn_mfma_f32_32x32x16_bf16(b1,qr[0],negm,0,0,0);}
    else{p0=__builtin_amdgcn_mfma_f32_32x32x16_bf16(b0,qr[d0],p0,0,0,0);p1=__builtin_amdgcn_mfma_f32_32x32x16_bf16(b1,qr[d0],p1,0,0,0);}}
}
typedef __attribute__((address_space(3))) const char* lds_cptr;
typedef short v4i16_t __attribute__((ext_vector_type(4)));
__device__ __forceinline__ void kload8(bf16x8*kf,lds_cptr kp){
  kf[0]=*(const __attribute__((address_space(3))) bf16x8*)(kp);      kf[1]=*(const __attribute__((address_space(3))) bf16x8*)(kp+512);
  kf[2]=*(const __attribute__((address_space(3))) bf16x8*)(kp+2048); kf[3]=*(const __attribute__((address_space(3))) bf16x8*)(kp+2560);
  kf[4]=*(const __attribute__((address_space(3))) bf16x8*)(kp+4096); kf[5]=*(const __attribute__((address_space(3))) bf16x8*)(kp+4608);
  kf[6]=*(const __attribute__((address_space(3))) bf16x8*)(kp+6144); kf[7]=*(const __attribute__((address_space(3))) bf16x8*)(kp+6656);
}
__device__ __forceinline__ void kload2(bf16x8*kf,lds_cptr kp,int j){ kf[2*j]=*(const __attribute__((address_space(3))) bf16x8*)(kp+j*2048); kf[2*j+1]=*(const __attribute__((address_space(3))) bf16x8*)(kp+j*2048+512); }
__device__ __forceinline__ s16x4 vtr(lds_cptr p){ return __builtin_bit_cast(s16x4,__builtin_amdgcn_ds_read_tr16_b64_v4i16((__attribute__((address_space(3))) v4i16_t*)p)); }
__device__ __forceinline__ float rowmax(const f32x16&p0,const f32x16&p1){
  float a=max3f(p0[0],p0[1],p1[0]),b=max3f(p0[2],p0[3],p1[1]);a=max3f(a,p1[2],p1[3]);
  #pragma unroll
  for(int r=4;r<16;r+=4){a=max3f(a,p0[r],p0[r+1]);b=max3f(b,p0[r+2],p0[r+3]);a=max3f(a,p1[r],p1[r+1]);b=max3f(b,p1[r+2],p1[r+3]);}
  const float m=max2f(a,b);
  auto rr=__builtin_amdgcn_permlane32_swap(__float_as_uint(m),__float_as_uint(m),false,false);
  return max2f(__uint_as_float(rr[0]),__uint_as_float(rr[1]));
}
__device__ __forceinline__ void pv(f32x16*o,int vb,bf16x8 pa0,bf16x8 pa1,bf16x8 pa2,bf16x8 pa3){
  #pragma unroll
  for(int d0=0;d0<2;++d0){s16x4 lo[4],hi[4];
    #pragma unroll
    for(int ks=0;ks<4;++ks){
      asm volatile("ds_read_b64_tr_b16 %0,%1 offset:%c2":"=&v"(lo[ks]):"v"(vb),"i"(d0*4096+ks*1024):"memory");
      asm volatile("ds_read_b64_tr_b16 %0,%1 offset:%c2":"=&v"(hi[ks]):"v"(vb),"i"(d0*4096+ks*1024+512):"memory");}
    asm volatile("s_waitcnt lgkmcnt(0)":::"memory");SBAR();
    #define PK(k) (bf16x8){lo[k][0],lo[k][1],lo[k][2],lo[k][3],hi[k][0],hi[k][1],hi[k][2],hi[k][3]}
    o[d0]=__builtin_amdgcn_mfma_f32_32x32x16_bf16(pa0,PK(0),o[d0],0,0,0);
    o[d0]=__builtin_amdgcn_mfma_f32_32x32x16_bf16(pa1,PK(1),o[d0],0,0,0);
    o[d0]=__builtin_amdgcn_mfma_f32_32x32x16_bf16(pa2,PK(2),o[d0],0,0,0);
    o[d0]=__builtin_amdgcn_mfma_f32_32x32x16_bf16(pa3,PK(3),o[d0],0,0,0);
    #undef PK
  }
}

#ifndef ATTN_STORE16
#define ATTN_STORE16(p,v) (*(u32x4*)(p)=(v))
#endif
template<int THRL> __device__ __forceinline__ void attn_unit(const bf16*Qu,const bf16*__restrict__ K0,const bf16*__restrict__ V0,const bf16*__restrict__ K1,const bf16*__restrict__ V1,int NT0,int NT,bf16*Ou,char*shm){
  int tid=threadIdx.x; asm volatile("":"+v"(tid)); const int lane=tid&63,r32=lane&31,hi=lane>>5; const int wid=__builtin_amdgcn_readfirstlane(tid>>6);
  const bf16*Qw=Qu+(long)(wid*QBLK)*QP;
  const unsigned lds0=(unsigned)(uintptr_t)shm;
  float*wsf=(float*)(shm+LDS_WS)+wid*64;
  const unsigned koff=(unsigned)(lane*KP+wid*8)*2u;
  const unsigned voff=(unsigned)((16*(wid&3)+(lane>>2))*KP+(wid>>2)*32+(lane&3)*8)*2u;
  const unsigned kdst=lds0+LDS_K+wid*1024, vdst=lds0+LDS_V+wid*1024;
  #define DMA_K(t,slot) glds16(((t)<NT0?K0+(long)(t)*KVBLK*KP:K1+(long)((t)-NT0)*KVBLK*KP),koff,(unsigned)__builtin_amdgcn_readfirstlane(kdst+(slot)))
  #define DMA_V(t,slot) glds16(((t)<NT0?V0+(long)(t)*KVBLK*KP:V1+(long)((t)-NT0)*KVBLK*KP),voff,(unsigned)__builtin_amdgcn_readfirstlane(vdst+(slot)))
  const int vb0=(int)(lds0+LDS_V)+((lane>>4)&1)*32+(lane&3)*8+(4*hi+((lane&15)>>2))*64;
  const char*Kbase=shm+LDS_K; bf16x8 kf[8];
  const lds_cptr shm3=(lds_cptr)shm; const lds_cptr kp0=shm3+LDS_K+hi*1024+r32*16; const lds_cptr vp0=shm3+LDS_V+((lane>>4)&1)*32+(lane&3)*8+(4*hi+((lane&15)>>2))*64;
  DMA_K(0,0);DMA_V(0,0);DMA_K(1,SLOTB);
  bf16x8 qr[4];
  #pragma unroll
  for(int d0=0;d0<4;++d0)qr[d0]=*reinterpret_cast<const bf16x8*>(&Qw[(long)r32*QP+d0*16+hi*8]);
  float mhat=0.f,l_reg=0.f;f32x16 o[2];o[0]=f32x16{};o[1]=f32x16{};
  #define CMASK(P0,P1,t) do{}while(0)
  bool resc=false;
  #define START(P0,P1) do{ const float rm=rowmax(P0,P1); resc=false; \
    { const float dl=rm; mhat=fadd_s(mhat,dl); \
      _Pragma("unroll") for(int r=0;r<16;++r){P0[r]=fsub_s(P0[r],dl);P1[r]=fsub_s(P1[r],dl);} \
 } \
    _Pragma("unroll") for(int r=0;r<16;++r)P0[r]=__builtin_amdgcn_exp2f(P0[r]); }while(0)
  #define RESC() do{ if(resc){ asm volatile("s_waitcnt lgkmcnt(0)":::"memory"); \
      _Pragma("unroll") for(int d_=0;d_<2;++d_) _Pragma("unroll") for(int r=0;r<16;++r)o[d_][r]*=wsf[crow(r,hi)]; } }while(0)
  f32x16 pA0,pA1,pB0,pB1;
  int sl_prev=0,sl_cur=0,sl_next=SLOTB;
  #define ROT() do{sl_prev=sl_cur;sl_cur=sl_next;sl_next=(sl_next==(NSLOT-1)*SLOTB)?0:sl_next+SLOTB;}while(0)
  DMA_K(2,2*SLOTB);
  WAIT_BAR(3);
  qkt(pA0,pA1,Kbase,qr,f32x16{},r32,hi);asm volatile("s_nop 15\n\ts_nop 7":"+v"(pA0),"+v"(pA1));CMASK(pA0,pA1,0);
  START(pA0,pA1);
  _Pragma("unroll") for(int r=0;r<16;++r)pA1[r]=__builtin_amdgcn_exp2f(pA1[r]);
  WAIT_BAR(0);
  DMA_K(3,0);DMA_V(1,SLOTB);
  ROT();
  kload8(kf,kp0+sl_cur);
  WAIT_BAR(2);
  s16x4 vlo[8],vhi[8]; u32x4 pw0,pw1,pw2,pw3;
  #define PKW(P,B) cvtpk_s(P[B],P[B+1])
  #define PAF(k) __builtin_bit_cast(bf16x8,pw##k)
  #define VFR(i) (bf16x8){vlo[i][0],vlo[i][1],vlo[i][2],vlo[i][3],vhi[i][0],vhi[i][1],vhi[i][2],vhi[i][3]}
  #define PIN(x) asm volatile("":"+v"(x))
  #define MX3(a,b,c) __builtin_fmaxf(__builtin_fmaxf((a),(b)),(c))
  #define GAPA(MF,A0,A1,A2,A3,W0,W1,PW) do{ MF; sacc+=A0; sacc+=A1; sacc+=A2; sacc+=A3; PIN(sacc); W0; W1; PIN(PW); SBAR(); }while(0)
  #define EX(v) __builtin_amdgcn_exp2f(v)
  #define GAPB(MF,X,B) do{ MF; X[B]=EX(X[B]); X[B+1]=EX(X[B+1]); X[B+2]=EX(X[B+2]); X[B+3]=EX(X[B+3]); PIN(X); SBAR(); }while(0)
  #define VRD(i) do{ vlo[i]=vtr(vp_+(((i)>>2)*4096+((i)&3)*1024)); vhi[i]=vtr(vp_+(((i)>>2)*4096+((i)&3)*1024+512)); }while(0)
  #define KRD(G,j) do{ if(G){ kload2(kf,kp0+sl_next,j); SBAR(); } }while(0)
  #define STEP(C0,C1,P0,P1,t,GK,GV,GL) do{ SBAR(); \
    const lds_cptr vp_=vp0+sl_prev; \
    VRD(0); SBAR(); float sacc=(P0[0]+P0[1]); \
    GAPA(C0=__builtin_amdgcn_mfma_f32_32x32x16_bf16(kf[0],qr[0],f32x16{},0,0,0), P0[2],P0[3],P0[4],P0[5],     pw0[0]=PKW(P0,0), pw0[1]=PKW(P0,2), pw0); \
    VRD(4); SBAR(); GAPA(C1=__builtin_amdgcn_mfma_f32_32x32x16_bf16(kf[1],qr[0],f32x16{},0,0,0), P0[6],P0[7],P0[8],P0[9],     pw0[2]=PKW(P0,4), pw0[3]=PKW(P0,6), pw0); \
    VRD(1); SBAR(); GAPA(C0=__builtin_amdgcn_mfma_f32_32x32x16_bf16(kf[2],qr[1],C0,0,0,0),   P0[10],P0[11],P0[12],P0[13], pw1[0]=PKW(P0,8), pw1[1]=PKW(P0,10), pw1); \
    VRD(5); SBAR(); GAPA(C1=__builtin_amdgcn_mfma_f32_32x32x16_bf16(kf[3],qr[1],C1,0,0,0),   P0[14],P0[15],P1[0],P1[1],   pw1[2]=PKW(P0,12),pw1[3]=PKW(P0,14), pw1); \
    VRD(2); SBAR(); GAPA(C0=__builtin_amdgcn_mfma_f32_32x32x16_bf16(kf[4],qr[2],C0,0,0,0),   P1[2],P1[3],P1[4],P1[5],     pw2[0]=PKW(P1,0), pw2[1]=PKW(P1,2), pw2); \
    VRD(6); SBAR(); GAPA(C1=__builtin_amdgcn_mfma_f32_32x32x16_bf16(kf[5],qr[2],C1,0,0,0),   P1[6],P1[7],P1[8],P1[9],     pw2[2]=PKW(P1,4), pw2[3]=PKW(P1,6), pw2); \
    VRD(3); SBAR(); GAPA(C0=__builtin_amdgcn_mfma_f32_32x32x16_bf16(kf[6],qr[3],C0,0,0,0),   P1[10],P1[11],P1[12],P1[13], pw3[0]=PKW(P1,8), pw3[1]=PKW(P1,10), pw3); \
    VRD(7); SBAR(); GAPA(C1=__builtin_amdgcn_mfma_f32_32x32x16_bf16(kf[7],qr[3],C1,0,0,0),   P1[14],P1[15],0.f,0.f,       pw3[2]=PKW(P1,12),pw3[3]=PKW(P1,14), pw3); \
    l_reg+=sacc; \
    if(GK){DMA_K((t)+3,sl_cur);} if(GV){DMA_V((t)+1,sl_next);} \
    _Pragma("unroll") for(int r=0;r<16;++r){C0[r]-=mhat;C1[r]-=mhat;} \
    { float a=MX3(C0[0],C0[1],C1[0]),b=MX3(C0[2],C0[3],C1[1]); a=MX3(a,C1[2],C1[3]); \
      _Pragma("unroll") for(int r=4;r<16;r+=4){a=MX3(a,C0[r],C0[r+1]);b=MX3(b,C0[r+2],C0[r+3]);a=MX3(a,C1[r],C1[r+1]);b=MX3(b,C1[r+2],C1[r+3]);} \
      float rm=__builtin_fmaxf(a,b); { auto rr=__builtin_amdgcn_permlane32_swap(__float_as_uint(rm),__float_as_uint(rm),false,false); rm=__builtin_fmaxf(__uint_as_float(rr[0]),__uint_as_float(rr[1])); } \
      resc=false; \
      if(__builtin_expect(__any(rm>(float)THRL),0)){ const float dl=__builtin_fmaxf(rm,0.f); mhat+=dl; \
        _Pragma("unroll") for(int r=0;r<16;++r){C0[r]-=dl;C1[r]-=dl;} \
        const float f=__builtin_amdgcn_exp2f(-dl); l_reg*=f; if(hi==0)wsf[r32]=f; resc=true; } } \
    SBAR(); \
    GAPB(o[0]=__builtin_amdgcn_mfma_f32_32x32x16_bf16(PAF(0),VFR(0),o[0],0,0,0), C0,0); \
    GAPB(o[1]=__builtin_amdgcn_mfma_f32_32x32x16_bf16(PAF(0),VFR(4),o[1],0,0,0), C0,4); \
    KRD(GL,0); GAPB(o[0]=__builtin_amdgcn_mfma_f32_32x32x16_bf16(PAF(1),VFR(1),o[0],0,0,0), C0,8); \
    KRD(GL,1); GAPB(o[1]=__builtin_amdgcn_mfma_f32_32x32x16_bf16(PAF(1),VFR(5),o[1],0,0,0), C0,12); \
    KRD(GL,2); GAPB(o[0]=__builtin_amdgcn_mfma_f32_32x32x16_bf16(PAF(2),VFR(2),o[0],0,0,0), C1,0); \
    KRD(GL,3); GAPB(o[1]=__builtin_amdgcn_mfma_f32_32x32x16_bf16(PAF(2),VFR(6),o[1],0,0,0), C1,4); \
    GAPB(o[0]=__builtin_amdgcn_mfma_f32_32x32x16_bf16(PAF(3),VFR(3),o[0],0,0,0), C1,8); \
    GAPB(o[1]=__builtin_amdgcn_mfma_f32_32x32x16_bf16(PAF(3),VFR(7),o[1],0,0,0), C1,12); \
    }while(0)
  int t=1;
  #undef CMASK
  #define CMASK(P0,P1,t) do{}while(0)
  for(;t+5<NT;t+=2){
    STEP(pB0,pB1,pA0,pA1,t,true,true,true);     WAIT_BAR(2); RESC(); ROT();
    STEP(pA0,pA1,pB0,pB1,t+1,true,true,true);   WAIT_BAR(2); RESC(); ROT();
  }
  #undef CMASK
  #define CMASK(P0,P1,t) do{}while(0)
  #define ENDW(tt) do{ if((tt)+3<NT){WAIT_BAR(2);} else if((tt)+2<NT){WAIT_BAR(1);} else {WAIT_BAR(0);} }while(0)
  for(;t+1<NT;t+=2){
    STEP(pB0,pB1,pA0,pA1,t,(t+3<NT),(t+1<NT),(t+1<NT));       ENDW(t);   RESC(); ROT();
    STEP(pA0,pA1,pB0,pB1,t+1,(t+4<NT),(t+2<NT),(t+2<NT));     ENDW(t+1); RESC(); ROT();
  }
  STEP(pB0,pB1,pA0,pA1,NT-1,false,false,false); RESC();
  { float sacc=pB0[0]+pB0[1]; _Pragma("unroll") for(int r=2;r<16;++r)sacc+=pB0[r]; _Pragma("unroll") for(int r=0;r<16;++r)sacc+=pB1[r]; l_reg+=sacc;
    pw0=(u32x4){PKW(pB0,0),PKW(pB0,2),PKW(pB0,4),PKW(pB0,6)};pw1=(u32x4){PKW(pB0,8),PKW(pB0,10),PKW(pB0,12),PKW(pB0,14)};pw2=(u32x4){PKW(pB1,0),PKW(pB1,2),PKW(pB1,4),PKW(pB1,6)};pw3=(u32x4){PKW(pB1,8),PKW(pB1,10),PKW(pB1,12),PKW(pB1,14)};
    SBAR(); pv(o,vb0+sl_cur,PAF(0),PAF(1),PAF(2),PAF(3)); }
  #undef PKW
  #undef PAF
  #undef VFR
  #undef PIN
  #undef MX3
  #undef GAPA
  #undef GAPB
  #undef EX
  #undef VRD
  #undef KRD
  #undef STEP
  #undef ENDW
  {auto rr=__builtin_amdgcn_permlane32_swap(__float_as_uint(l_reg),__float_as_uint(l_reg),false,false);l_reg=__uint_as_float(rr[0])+__uint_as_float(rr[1]);}
  if(hi==0)wsf[32+r32]=l_reg;asm volatile("s_waitcnt lgkmcnt(0)":::"memory");
  float rli[16];
  #pragma unroll
  for(int r=0;r<16;++r)rli[r]=__builtin_amdgcn_rcpf(wsf[32+crow(r,hi)]);
  bf16*Ow=Ou+(long)(wid*QBLK)*OP;
  { bf16*stg=(bf16*)(shm+LDS_OST)+wid*2048;
    #pragma unroll
    for(int r=0;r<16;++r){const int orow=crow(r,hi);
      #pragma unroll
      for(int d0=0;d0<2;++d0)stg[orow*64+d0*32+r32]=__float2bfloat16(o[d0][r]*rli[r]);}
    asm volatile("s_waitcnt lgkmcnt(0)":::"memory");
    #pragma unroll
    for(int i=0;i<4;++i){const int row=i*8+(lane>>3),ch=lane&7; const u32x4 v=*(const u32x4*)(stg+row*64+ch*8); ATTN_STORE16(Ow+(long)row*OP+ch*8,v);} }
  asm volatile("s_waitcnt lgkmcnt(0)\n\ts_barrier":::"memory");
  #undef DMA_K
  #undef DMA_V
  #undef CMASK
  #undef START
  #undef RESC
  #undef ROT
}
constexpr int ATTN_LDS_BYTES=LDS_BYTES;
#undef SBAR
#undef WAIT_BAR
}
#define DI __device__ __forceinline__
#define LAS __attribute__((address_space(3)))
typedef unsigned short bf16_t;
typedef short bf16x8 __attribute__((ext_vector_type(8)));
typedef float f32x4 __attribute__((ext_vector_type(4)));
typedef unsigned u32x4 __attribute__((ext_vector_type(4)));
typedef unsigned u32x2 __attribute__((ext_vector_type(2)));
typedef unsigned long long u64;
typedef unsigned long long u64x2 __attribute__((ext_vector_type(2)));

constexpr int NB = 8, SEQ = 4096, DM = 1024, CTX = 256, DFF = 2816, DIN = 2336, DINP = 2560, KSEQ = 4352, NCHUNK = 68;
constexpr int TX = NB * SEQ, TZ = NB * CTX, TT = TX + TZ;
constexpr float EPS = 1e-6f;
constexpr float QSCALE = 0.125f * 1.4426950408889634f;
constexpr float LOG2E = 1.4426950408889634f;
constexpr int C_FOUR = 0, C_NAQ = 256, C_NAK = 512, C_NAV = 768, C_GLQ = 1024, C_GLK = 1152, C_GLV = 1280, C_GLR = 1536, C_GF = 1792, C_GB = 1808, C_GQQ = 1824, C_GQK = 2080, C_GQV = 2208;
constexpr int C_GLQB = 768, C_GLKB = 896;

constexpr size_t MiB = 1u << 20;
constexpr size_t WS_W = 0;
constexpr size_t W_UP1 = 0, W_DN1 = 11 * MiB, W_IN = W_DN1 + 5 * MiB + MiB / 2, W_OUT = W_IN + 5 * MiB, W_UP2 = W_OUT + 2 * MiB, W_DN2 = W_UP2 + 11 * MiB, W_LAYER = 40 * MiB;
constexpr size_t WS_MOD = 80 * MiB;
constexpr size_t WS_TAB = 81 * MiB;
constexpr size_t T_FC64 = 0, T_FS64 = 8192, T_FSN64 = 16384, T_TW = 32768, T_ROPE = 65536, T_FC256 = 131072, T_FS256 = 262144, T_FSN256 = 393216;
constexpr size_t WS_Z = 82 * MiB;
constexpr size_t WS_HN = 90 * MiB;
constexpr size_t WS_HB = 158 * MiB;
constexpr size_t WS_NAVT = 345 * MiB;
constexpr size_t WS_GVT = WS_NAVT + 17 * MiB;
constexpr size_t WS_GLVT = WS_GVT + 9 * MiB;
constexpr size_t WS_KKT = WS_GLVT + 17 * MiB;
constexpr size_t WS_SLOC = WS_KKT + 17 * MiB;
constexpr size_t WS_SST = WS_SLOC + 34 * MiB;
constexpr size_t WS_TTR = WS_SST + 17 * MiB;
constexpr size_t WS_TTI = WS_TTR + 16 * MiB;
constexpr size_t WS_BLAST = WS_TTI + 16 * MiB;
constexpr size_t WS_ROWSS = WS_BLAST + 1 * MiB;
constexpr size_t WS_SB = WS_ROWSS + 1 * MiB;
constexpr int SB_UP1 = 0, SB_IN = 9 * 5632, SB_UP2 = 9 * (5632 + 2560), SB_LAYER = 9 * (5632 + 2560 + 5632);
constexpr size_t WS_BAR = WS_SB + 2 * MiB;
constexpr size_t WS_END = WS_BAR + 1 * MiB;
constexpr int LDS_PREF = 131072 + 1024; static_assert(LDS_PREF == (int)pg8::PREF_LDS_ADDR, "prefetch slots");
constexpr int LDS_BARST = 131072 + 256;
static_assert(WS_END <= 512 * MiB, "workspace map");
static_assert(WS_HB + (size_t)TT * DFF * 2 <= WS_NAVT && WS_HN + (size_t)TT * DM * 2 <= WS_HB, "workspace map 2");
constexpr int LDS_BYTES = 147456;
#ifndef REP_NA
#define REP_NA 1
#endif
#ifndef REP_F2
#define REP_F2 1
#endif
#ifndef REP_SYNC
#define REP_SYNC 0
#endif
#ifndef REP_PRO
#define REP_PRO 1
#endif
#ifndef REP_S2
#define REP_S2 1
#endif
#ifndef REP_S3
#define REP_S3 1
#endif
#ifndef REP_S4
#define REP_S4 1
#endif
#ifndef REP_UP
#define REP_UP 1
#endif
#ifndef REP_NORM
#define REP_NORM 1
#endif
#ifndef DIAG_MODE
#define DIAG_MODE 0
#endif
#ifndef DIAG_A
#define DIAG_A 2
#define DIAG_B 7
#endif

struct Params { const float* in[24]; float* out; unsigned char* ws; };
#define XB_TMO      128
#define XB_XCNT(j)  (256  + 64 * (j))
#define XB_XSUB(j)  (1280 + 64 * (j))
#define XB_XGEN(j)  (2304 + 64 * (j))
#define XB_TOP      3328
#define XB_TOPGEN   3392
#define XCD_BAR_WORDS 3456
#define XB_SPIN_CAP (1u << 18)

__device__ __forceinline__ unsigned xb_ld(unsigned* p)              { return __hip_atomic_load(p, __ATOMIC_RELAXED, __HIP_MEMORY_SCOPE_AGENT); }
__device__ __forceinline__ unsigned xb_add(unsigned* p, unsigned v) { return __hip_atomic_fetch_add(p, v, __ATOMIC_RELAXED, __HIP_MEMORY_SCOPE_AGENT); }
__device__ __forceinline__ unsigned xb_xcc_id() { return (unsigned)__builtin_amdgcn_s_getreg((3 << 11) | 20) & 0xFu; }
#define XB_SPIN(cond, bar) do { unsigned _sp = 0; while (cond) { __builtin_amdgcn_s_sleep(1); \
    if ((++_sp & 255u) == 0u) { if (xb_ld(&(bar)[XB_TMO])) break; if (_sp > XB_SPIN_CAP) { atomicAdd(&(bar)[XB_TMO], 1u); break; } } } } while (0)

struct XcdBarrier {
    unsigned* bar; unsigned x;
    volatile LAS unsigned* st;
};

__device__ __forceinline__ XcdBarrier xcd_barrier_post(unsigned* bar, volatile LAS unsigned* st) {
    XcdBarrier b; b.bar = bar; b.x = xb_xcc_id(); b.st = st;
    if (threadIdx.x == 0) (void)xb_add(&bar[XB_XCNT(b.x)], 1u);
    return b;
}
__device__ __forceinline__ void xcd_barrier_complete(unsigned* bar, unsigned x, unsigned& nloc, unsigned& nx) {
    const unsigned G = gridDim.x * gridDim.y * gridDim.z;
    unsigned sum, cnt, mine, sp = 0u;
    for (;;) {
        sum = 0u; cnt = 0u; mine = 0u;
#pragma unroll
        for (unsigned j = 0; j < 16; ++j) { const unsigned c = xb_ld(&bar[XB_XCNT(j)]); sum += c; cnt += (c > 0u) ? 1u : 0u; mine = (j == x) ? c : mine; }
        if (sum == G) break;
        __builtin_amdgcn_s_sleep(1);
        if ((++sp & 255u) == 0u) { if (xb_ld(&bar[XB_TMO])) break; if (sp > XB_SPIN_CAP) { atomicAdd(&bar[XB_TMO], 1u); break; } }
    }
    nloc = mine > 0u ? mine : 1u; nx = cnt > 0u ? cnt : 1u;
}

__device__ __forceinline__ void xcd_barrier(const XcdBarrier& b) {
    asm volatile("s_waitcnt vmcnt(0)" ::: "memory");
    __syncthreads();
    if (threadIdx.x == 0) {
        unsigned* bar = b.bar;
        __builtin_amdgcn_s_waitcnt(0);
        unsigned nloc = b.st[0], nx = b.st[1];
        if (nloc == 0u) { xcd_barrier_complete(bar, b.x, nloc, nx); b.st[0] = nloc; b.st[1] = nx; }
        const unsigned old = xb_add(&bar[XB_XSUB(b.x)], 1u);
        const unsigned gen = old / nloc;
        if (old + 1u == (gen + 1u) * nloc) {
            __builtin_amdgcn_fence(__ATOMIC_RELEASE, "agent");
            asm volatile("s_waitcnt vmcnt(0)" ::: "memory");
            const unsigned og = xb_add(&bar[XB_TOP], 1u);
            const unsigned tg = og / nx;
            if (og + 1u == (tg + 1u) * nx) xb_add(&bar[XB_TOPGEN], 1u);
            else XB_SPIN(xb_ld(&bar[XB_TOPGEN]) == tg, bar);
            __builtin_amdgcn_fence(__ATOMIC_ACQUIRE, "agent");
            xb_add(&bar[XB_XGEN(b.x)], 1u);
            asm volatile("s_waitcnt vmcnt(0)" ::: "memory");
        } else {
            XB_SPIN(xb_ld(&bar[XB_XGEN(b.x)]) == gen, bar);
            __builtin_amdgcn_fence(__ATOMIC_ACQUIRE, "agent");
            asm volatile("s_waitcnt vmcnt(0)" ::: "memory");
        }
    }
    __syncthreads();
}
__device__ __attribute__((noinline)) void grid_bar_fn(unsigned* bar, unsigned st_addr) { XcdBarrier xb_; xb_.bar = bar; xb_.x = xb_xcc_id(); xb_.st = (volatile LAS unsigned*)(size_t)st_addr; xcd_barrier(xb_); }

DI float bf2f(bf16_t h) { return __uint_as_float(((unsigned)h) << 16); }
DI unsigned pk2(float lo, float hi) { return pg8::cvt_pk_bf16(lo, hi); }
DI bf16_t f2bf(float f) { return (bf16_t)(pk2(f, 0.f) & 0xffffu); }
DI bf16x8 ld16(const bf16_t* p) { return *(const bf16x8*)p; }
DI u64 ld8(const bf16_t* p) { return *(const u64*)p; }
DI bf16x8 cat8(u64 a, u64 b) { u64x2 v = {a, b}; return __builtin_bit_cast(bf16x8, v); }
DI bf16x8 pack8(const f32x4& a, const f32x4& b) { u32x4 w; w.x = pk2(a[0], a[1]); w.y = pk2(a[2], a[3]); w.z = pk2(b[0], b[1]); w.w = pk2(b[2], b[3]); return __builtin_bit_cast(bf16x8, w); }
DI bf16x8 neg8(bf16x8 v) { u32x4 w = __builtin_bit_cast(u32x4, v); w ^= 0x80008000u; return __builtin_bit_cast(bf16x8, w); }
#define MFMA16(a, b, c) __builtin_amdgcn_mfma_f32_16x16x32_bf16((a), (b), (c), 0, 0, 0)
template <int M> DI float swz_xor(float v) { return __int_as_float(__builtin_amdgcn_ds_swizzle(__float_as_int(v), (M << 10) | 0x1F)); }
DI float half_sum(float v) { auto rr = __builtin_amdgcn_permlane32_swap(__float_as_uint(v), __float_as_uint(v), false, false); return __uint_as_float(rr[0]) + __uint_as_float(rr[1]); }
DI float half_max(float v) { auto rr = __builtin_amdgcn_permlane32_swap(__float_as_uint(v), __float_as_uint(v), false, false); return fmaxf(__uint_as_float(rr[0]), __uint_as_float(rr[1])); }
DI float quad_sum(float v) { v += swz_xor<16>(v); return half_sum(v); }
DI float quad_max(float v) { v = fmaxf(v, swz_xor<16>(v)); return half_max(v); }

DI void transpose_item(const float* W, int K, int N, bf16_t* WT, int mode, LAS float* scr, int item, int lane) {
    const int nblk = N / 32, kb = item / nblk, nb = item % nblk, k0 = 64 * kb, n0 = 32 * nb;
    { const int kr = lane >> 3, nq = lane & 7;
      f32x4 wv[8];
#pragma unroll
      for (int i = 0; i < 8; ++i) wv[i] = *(const f32x4*)(W + (size_t)(k0 + 8 * i + kr) * N + n0 + 4 * nq);
#pragma unroll
      for (int i = 0; i < 8; ++i) { LAS float* d = scr + (8 * i + kr) * 33 + 4 * nq; d[0] = wv[i][0]; d[1] = wv[i][1]; d[2] = wv[i][2]; d[3] = wv[i][3]; } }
    asm volatile("s_waitcnt lgkmcnt(0)" ::: "memory");
    const int c = lane & 7;
    const int d0 = (mode == 0) ? n0 : ((n0 >> 7) * 256 + (n0 & 127) + (mode == 2 ? 128 : 0));
#pragma unroll
    for (int j = 0; j < 4; ++j) { const int n = (lane >> 3) + 8 * j; const LAS float* s = scr + (8 * c) * 33 + n;
        u32x4 o; o.x = pk2(s[0 * 33], s[1 * 33]); o.y = pk2(s[2 * 33], s[3 * 33]); o.z = pk2(s[4 * 33], s[5 * 33]); o.w = pk2(s[6 * 33], s[7 * 33]);
        *(u32x4*)(WT + (size_t)(d0 + n) * K + k0 + 8 * c) = o; }
    asm volatile("s_waitcnt lgkmcnt(0)" ::: "memory");
}

template <bool FIRST> DI void phase_prologue(const Params& p, LAS unsigned char* lds, int tid, int lane, int wave, int bid, int G, int l_lo, int l_hi) {
    constexpr bool first = FIRST;
    const int gw = bid * 8 + wave, NGW = G * 8;
    unsigned char* ws = p.ws;
    {
        LAS float* scr = (LAS float*)(lds + wave * 8704);
        constexpr int I_UP = 16 * 88, I_DN = 44 * 32, I_IN = 16 * 73, I_OUT = 16 * 32;
        constexpr int PER_L = 4 * I_UP + 2 * I_DN + I_IN + I_OUT;
        for (int it = gw; it < (l_hi - l_lo) * PER_L; it += NGW) {
            const int l = l_lo + it / PER_L; int r = it % PER_L;
            bf16_t* wl = (bf16_t*)(ws + WS_W + (size_t)l * W_LAYER);
            if (r < I_UP) { transpose_item(p.in[6] + (size_t)l * DM * DFF, DM, DFF, (bf16_t*)((unsigned char*)wl + W_UP1), 1, scr, r, lane); continue; } r -= I_UP;
            if (r < I_UP) { transpose_item(p.in[7] + (size_t)l * DM * DFF, DM, DFF, (bf16_t*)((unsigned char*)wl + W_UP1), 2, scr, r, lane); continue; } r -= I_UP;
            if (r < I_DN) { transpose_item(p.in[8] + (size_t)l * DM * DFF, DFF, DM, (bf16_t*)((unsigned char*)wl + W_DN1), 0, scr, r, lane); continue; } r -= I_DN;
            if (r < I_IN) { transpose_item(p.in[9] + (size_t)l * DM * DIN, DM, DIN, (bf16_t*)((unsigned char*)wl + W_IN), 0, scr, r, lane); continue; } r -= I_IN;
            if (r < I_OUT) { transpose_item(p.in[20] + (size_t)l * DM * DM, DM, DM, (bf16_t*)((unsigned char*)wl + W_OUT), 0, scr, r, lane); continue; } r -= I_OUT;
            if (r < I_UP) { transpose_item(p.in[21] + (size_t)l * DM * DFF, DM, DFF, (bf16_t*)((unsigned char*)wl + W_UP2), 1, scr, r, lane); continue; } r -= I_UP;
            if (r < I_UP) { transpose_item(p.in[22] + (size_t)l * DM * DFF, DM, DFF, (bf16_t*)((unsigned char*)wl + W_UP2), 2, scr, r, lane); continue; } r -= I_UP;
            transpose_item(p.in[23] + (size_t)l * DM * DFF, DFF, DM, (bf16_t*)((unsigned char*)wl + W_DN2), 0, scr, r, lane);
        }
        const int gt = bid * 512 + tid, NT = G * 512;
        for (int i = gt; i < (l_hi - l_lo) * (DINP - DIN) * DM / 8; i += NT) { const int l = l_lo + i / ((DINP - DIN) * DM / 8), r = i % ((DINP - DIN) * DM / 8);
            *(u32x4*)((bf16_t*)(ws + WS_W + (size_t)l * W_LAYER + W_IN) + (size_t)DIN * DM + (size_t)r * 8) = (u32x4){0u, 0u, 0u, 0u}; }
        if (first) {
        for (int i = gt; i < 5 * TT; i += NT) ((float*)(ws + WS_ROWSS))[TT + i] = 0.f;
        unsigned char* tab = ws + WS_TAB;
        for (int i = gt; i < 4096; i += NT) { const int a = i >> 6, b = i & 63; const float x = (float)((a * b) & 63) * (1.0f / 32.0f);
            const float c = cospif(x), s = sinpif(x);
            ((bf16_t*)(tab + T_FC64))[i] = f2bf(c); ((bf16_t*)(tab + T_FS64))[i] = f2bf(s); ((bf16_t*)(tab + T_FSN64))[i] = f2bf(-s);
            const float y = (float)(a * b) * (1.0f / 2048.0f);
            ((float*)(tab + T_TW))[2 * i] = cospif(y); ((float*)(tab + T_TW))[2 * i + 1] = sinpif(y); }
        for (int i = gt; i < 65536; i += NT) { const int a = i >> 8, b = i & 255; const float x = (float)((a * b) & 255) * (1.0f / 128.0f);
            const float c = cospif(x), s = sinpif(x);
            ((bf16_t*)(tab + T_FC256))[i] = f2bf(c); ((bf16_t*)(tab + T_FS256))[i] = f2bf(s); ((bf16_t*)(tab + T_FSN256))[i] = f2bf(-s); }
        for (int i = gt; i < 1024; i += NT) { const int pp = i >> 4, f = i & 15; const float inv = powf(10000.0f, -(float)f / 16.0f); const float ang = (float)pp * inv;
            ((float*)(tab + T_ROPE))[2 * i] = cosf(ang); ((float*)(tab + T_ROPE))[2 * i + 1] = sinf(ang); }
        }
    }
    if (!FIRST) return;
    __syncthreads();
    {
        LAS float* S = (LAS float*)lds;
        LAS float* red = (LAS float*)(lds + 9 * 1024 * 4);
        for (int i = tid; i < 9 * 1024; i += 512) { const int r = i >> 10, k = i & 1023; const float v = (r < 8) ? p.in[1][r * 1024 + k] : p.in[3][k]; S[i] = v / (1.0f + __expf(-v)); }
        __syncthreads();
        for (int it = bid; it < 2 * 144; it += G) {
            const int l = it / 144, nb = it % 144, n = nb * 64 + lane;
            const float* W = p.in[4] + (size_t)l * DM * 9216 + n;
            float acc[9];
#pragma unroll
            for (int r = 0; r < 9; ++r) acc[r] = 0.f;
            const int kbeg = wave * 128;
#pragma unroll 8
            for (int k = 0; k < 128; ++k) { const float w = W[(size_t)(kbeg + k) * 9216];
#pragma unroll
                for (int r = 0; r < 9; ++r) acc[r] += S[r * 1024 + kbeg + k] * w; }
#pragma unroll
            for (int r = 0; r < 9; ++r) red[(wave * 9 + r) * 64 + lane] = acc[r];
            __syncthreads();
            for (int i = tid; i < 9 * 64; i += 512) { const int r = i >> 6, c = i & 63; float s = 0.f;
#pragma unroll
                for (int w = 0; w < 8; ++w) s += red[(w * 9 + r) * 64 + c];
                const int nn = nb * 64 + c;
                ((float*)(ws + WS_MOD))[((size_t)l * 9 + r) * 9216 + nn] = s + p.in[5][(size_t)l * 9216 + nn]; }
            __syncthreads();
        }
    }
}

DI void scale_pass(const float* xx, const float* xz, const float* mod  , int iscale, bf16_t* HN, float* rowss, int nrows, int gw, int NGW, int lane) {
    for (int row = gw; row < nrows; row += NGW) {
        const bool isx = row < TX; const int mi = isx ? (row >> 12) : 8;
        const float* src = isx ? xx + (size_t)row * DM : xz + (size_t)(row - TX) * DM;
        const float* sc = mod + (size_t)mi * 9216 + iscale * 1024;
        f32x4 v[4]; float ss = 0.f;
#pragma unroll
        for (int j = 0; j < 4; ++j) { v[j] = *(const f32x4*)(src + 4 * lane + 256 * j); ss += (v[j][0] * v[j][0] + v[j][1] * v[j][1]) + (v[j][2] * v[j][2] + v[j][3] * v[j][3]); }
        ss += swz_xor<1>(ss); ss += swz_xor<2>(ss); ss += swz_xor<4>(ss); ss += swz_xor<8>(ss); ss += swz_xor<16>(ss); ss = half_sum(ss);
        if (lane == 0) rowss[row] = ss;
#pragma unroll
        for (int j = 0; j < 4; ++j) { const f32x4 a = *(const f32x4*)(sc + 4 * lane + 256 * j);
            const f32x4 y = v[j] * (a + 1.0f); u32x2 w; w.x = pk2(y[0], y[1]); w.y = pk2(y[2], y[3]);
            *(u32x2*)(HN + (size_t)row * DM + 4 * lane + 256 * j) = w; }
    }
}
DI void shift_bias_pass(unsigned char* ws, int gw, int NGW, int lane, int l, int n_lo, int n_hi) {
    for (int it = n_lo + gw; it < n_hi; it += NGW) {
        int n = it; int g, N; size_t woff, sboff;
        if (n < 5632) { g = 0; N = 5632; woff = W_UP1; sboff = SB_UP1; } else if (n < 5632 + 2560) { g = 1; N = 2560; n -= 5632; woff = W_IN; sboff = SB_IN; } else { g = 2; N = 5632; n -= 5632 + 2560; woff = W_UP2; sboff = SB_UP2; }
        const bf16_t* wrow = (const bf16_t*)(ws + WS_W + (size_t)l * W_LAYER + woff) + (size_t)n * DM + 16 * lane;
        const bf16x8 w0 = ld16(wrow), w1 = ld16(wrow + 8);
        float wf[16];
#pragma unroll
        for (int j = 0; j < 8; ++j) { wf[j] = bf2f((bf16_t)w0[j]); wf[8 + j] = bf2f((bf16_t)w1[j]); }
        const float* modl = (const float*)(ws + WS_MOD) + (size_t)l * 9 * 9216 + (3 * g) * 1024 + 16 * lane;
        float* sb = (float*)(ws + WS_SB) + (size_t)l * SB_LAYER + sboff;
#pragma unroll
        for (int mi = 0; mi < 9; ++mi) { float s = 0.f;
#pragma unroll
            for (int j4 = 0; j4 < 4; ++j4) { const f32x4 sh = *(const f32x4*)(modl + (size_t)mi * 9216 + 4 * j4); s += (sh[0] * wf[4 * j4] + sh[1] * wf[4 * j4 + 1]) + (sh[2] * wf[4 * j4 + 2] + sh[3] * wf[4 * j4 + 3]); }
            s += swz_xor<1>(s); s += swz_xor<2>(s); s += swz_xor<4>(s); s += swz_xor<8>(s); s += swz_xor<16>(s); s = half_sum(s);
            if (lane == 0) sb[(size_t)mi * N + n] = s; }
    }
}

DI void norm_pass(const float* xx, const float* xz, const float* mod  , int ishift, int iscale, bf16_t* HN, int nrows, int gw, int NGW, int lane) {
    for (int row = gw; row < nrows; row += NGW) {
        const bool isx = row < TX; const int mi = isx ? (row >> 12) : 8;
        const float* src = isx ? xx + (size_t)row * DM : xz + (size_t)(row - TX) * DM;
        const float* sh = mod + (size_t)mi * 9216 + ishift * 1024; const float* sc = mod + (size_t)mi * 9216 + iscale * 1024;
        f32x4 v[4]; float ss = 0.f;
#pragma unroll
        for (int j = 0; j < 4; ++j) { v[j] = *(const f32x4*)(src + 4 * lane + 256 * j); ss += (v[j][0] * v[j][0] + v[j][1] * v[j][1]) + (v[j][2] * v[j][2] + v[j][3] * v[j][3]); }
        ss += swz_xor<1>(ss); ss += swz_xor<2>(ss); ss += swz_xor<4>(ss); ss += swz_xor<8>(ss); ss += swz_xor<16>(ss); ss = half_sum(ss);
        const float rstd = rsqrtf(ss * (1.0f / DM) + EPS);
#pragma unroll
        for (int j = 0; j < 4; ++j) { const f32x4 a = *(const f32x4*)(sc + 4 * lane + 256 * j), b = *(const f32x4*)(sh + 4 * lane + 256 * j);
            const f32x4 y = v[j] * rstd * (a + 1.0f) + b; u32x2 w; w.x = pk2(y[0], y[1]); w.y = pk2(y[2], y[3]);
            *(u32x2*)(HN + (size_t)row * DM + 4 * lane + 256 * j) = w; }
    }
}

DI void shift_bias_mfma(unsigned char* ws, int gw, int NGW, int lane) {
    const int c16 = lane & 15, quad = lane >> 4;
    constexpr int NBLK = (5632 + 2560 + 5632) / 16;
    for (int it = gw; it < 2 * NBLK; it += NGW) {
        const int l = it / NBLK; int n0 = (it % NBLK) * 16; int g, N; size_t woff, sboff;
        if (n0 < 5632) { g = 0; N = 5632; woff = W_UP1; sboff = SB_UP1; } else if (n0 < 5632 + 2560) { g = 1; N = 2560; n0 -= 5632; woff = W_IN; sboff = SB_IN; } else { g = 2; N = 5632; n0 -= 5632 + 2560; woff = W_UP2; sboff = SB_UP2; }
        const bf16_t* wrow = (const bf16_t*)(ws + WS_W + (size_t)l * W_LAYER + woff) + (size_t)(n0 + c16) * DM + quad * 8;
        const float* shp = (const float*)(ws + WS_MOD) + (size_t)l * 9 * 9216 + (3 * g) * 1024 + (size_t)min(c16, 8) * 9216 + quad * 8;
        f32x4 acc = {0.f, 0.f, 0.f, 0.f};
#pragma unroll 8
        for (int ks = 0; ks < 32; ++ks) { const bf16x8 a = ld16(wrow + 32 * ks); const f32x4 s0 = *(const f32x4*)(shp + 32 * ks), s1 = *(const f32x4*)(shp + 32 * ks + 4);
            bf16x8 b = pack8(s0, s1); if (c16 >= 9) b = (bf16x8){0, 0, 0, 0, 0, 0, 0, 0};
            acc = MFMA16(a, b, acc); }
        if (c16 < 9) *(f32x4*)((float*)(ws + WS_SB) + (size_t)l * SB_LAYER + sboff + (size_t)c16 * N + n0 + quad * 4) = acc;
    }
}
DI void z_finalize(unsigned char* ws, const float* zin, const float* gate8  , bf16_t* hnz  , const float* nscale8, float* rowssz, int gw, int NGW, int lane) {
    const float* part = (const float*)(ws + WS_TTR);
    float* ZB = (float*)(ws + WS_Z);
    for (int r = gw; r < TZ; r += NGW) {
        float ss = 0.f;
#pragma unroll
        for (int j = 0; j < 4; ++j) { const size_t o = (size_t)r * DM + 4 * lane + 256 * j;
            f32x4 a = *(const f32x4*)(part + o);
#pragma unroll
            for (int s = 1; s < 4; ++s) a += *(const f32x4*)(part + (size_t)s * TZ * DM + o);
            const f32x4 g = *(const f32x4*)(gate8 + 4 * lane + 256 * j), zi = *(const f32x4*)(zin + o);
            const f32x4 zn = zi + g * 0.5f * a;
            *(f32x4*)(ZB + o) = zn;
            if (hnz) { const f32x4 sc = *(const f32x4*)(nscale8 + 4 * lane + 256 * j) + 1.0f; const f32x4 y = zn * sc; u32x2 w; w.x = pk2(y[0], y[1]); w.y = pk2(y[2], y[3]); *(u32x2*)(hnz + o) = w;
                ss += (zn[0] * zn[0] + zn[1] * zn[1]) + (zn[2] * zn[2] + zn[3] * zn[3]); } }
        if (hnz) { ss += swz_xor<1>(ss); ss += swz_xor<2>(ss); ss += swz_xor<4>(ss); ss += swz_xor<8>(ss); ss += swz_xor<16>(ss); ss = half_sum(ss); if (lane == 0) rowssz[r] = ss; }
    }
}

DI float log_sigmoid(float x) { return fminf(x, 0.f) - __logf(1.0f + __expf(-fabsf(x))); }

template <bool ROPE> DI void prep_vec(u32x2 raw, bf16_t* ptr, const float* gain, float scale, bool rp, int li, int gr, int t, const LAS float* ropeL) {
    float x[4] = {__uint_as_float(raw.x << 16), __uint_as_float(raw.x & 0xffff0000u), __uint_as_float(raw.y << 16), __uint_as_float(raw.y & 0xffff0000u)};
    float ss = (x[0] * x[0] + x[1] * x[1]) + (x[2] * x[2] + x[3] * x[3]);
    ss += swz_xor<1>(ss); ss += swz_xor<2>(ss); ss += swz_xor<4>(ss); ss += swz_xor<8>(ss);
    const float rstd = rsqrtf(ss * (1.0f / 64.0f) + EPS);
    const f32x4 g = *(const f32x4*)(gain + 4 * li);
    float o[4];
#pragma unroll
    for (int j = 0; j < 4; ++j) { const float y = x[j] * rstd * g[j];
        if (ROPE) { const float partner = swz_xor<8>(y);
            const int d = 4 * li + j, i = d & 31; const int pp = (i < 16) ? gr : t, f = i & 15;
            const float cs = ropeL[2 * (pp * 16 + f)], sn = ropeL[2 * (pp * 16 + f) + 1];
            const float rot = (li < 8) ? (y * cs - partner * sn) : (partner * sn + y * cs);
            o[j] = (rp ? rot : y) * scale; }
        else o[j] = y * scale; }
    u32x2 w; w.x = pk2(o[0], o[1]); w.y = pk2(o[2], o[3]);
    *(u32x2*)ptr = w;
}

DI void gla_local_unit(unsigned char* ws, int u, int lane);
DI void prep_tile(const Params& p, int l, int tile, LAS unsigned char* lds, int tid) {
    unsigned char* ws = p.ws;
    bf16_t* HX = (bf16_t*)(ws + WS_HB);
    int b, row0, pos0, gr; bool isx;
    if (tile < 512) { b = tile >> 6; gr = tile & 63; row0 = b * SEQ + 64 * gr; pos0 = 64 * gr; isx = true; }
    else { const int tz = tile - 512; b = tz >> 2; gr = tz & 3; row0 = TX + b * CTX + 64 * gr; pos0 = SEQ + 64 * gr; isx = false; }
    const LAS float* ropeL = (const LAS float*)(lds + 65536);
    {
        const int li = tid & 15, jg = tid >> 4;
#pragma unroll
        for (int hb = 0; hb < 2; ++hb) {
            const int t = hb * 32 + jg;
            bf16_t* rowp = HX + (size_t)(row0 + t) * DINP + 4 * li;
            u32x2 raw[14];
#pragma unroll
            for (int v = 0; v < 14; ++v) { const int col = (v < 4) ? C_NAQ + 64 * v : (v < 8) ? C_NAK + 64 * (v - 4) : (v < 12) ? C_GQQ + 64 * (v - 8) : C_GQK + 64 * (v - 12);
                raw[v] = *(const u32x2*)(rowp + col); }
#pragma unroll
            for (int v = 0; v < 14; ++v) { const int col = (v < 4) ? C_NAQ + 64 * v : (v < 8) ? C_NAK + 64 * (v - 4) : (v < 12) ? C_GQQ + 64 * (v - 8) : C_GQK + 64 * (v - 12);
                if (v < 4) prep_vec<false>(raw[v], rowp + col, p.in[10] + l * 64, QSCALE, false, li, gr, t, ropeL);
                else if (v < 8) prep_vec<false>(raw[v], rowp + col, p.in[11] + l * 64, 1.0f, false, li, gr, t, ropeL);
                else if (v < 12) prep_vec<true>(raw[v], rowp + col, p.in[18] + l * 64, QSCALE, isx, li, gr, t, ropeL);
                else prep_vec<true>(raw[v], rowp + col, p.in[19] + l * 64, 1.0f, isx, li, gr, t, ropeL); }
        }
    }
    {
#pragma unroll
        for (int k0 = 0; k0 < 2; ++k0) {
            unsigned h[4][8]; bf16_t* dstp[4];
#pragma unroll
            for (int k = 0; k < 4; ++k) { const int job = tid + 512 * (k0 * 4 + k); const int cc = job & 511, tg = job >> 9;
                int col; bf16_t* dst;
                if (cc < 256) { col = C_NAV + cc; dst = (bf16_t*)(ws + WS_NAVT) + ((size_t)(b * 256 + cc)) * KSEQ; }
                else { col = C_GLV + (cc - 256); dst = (bf16_t*)(ws + WS_GLVT) + ((size_t)(b * 256 + (cc - 256))) * KSEQ; }
                const bf16_t* src = HX + (size_t)(row0 + 8 * tg) * DINP + col;
#pragma unroll
                for (int i = 0; i < 8; ++i) h[k][i] = src[(size_t)i * DINP];
                dstp[k] = dst + pos0 + 8 * tg; }
#pragma unroll
            for (int k = 0; k < 4; ++k) { u32x4 w; w.x = h[k][0] | (h[k][1] << 16); w.y = h[k][2] | (h[k][3] << 16); w.z = h[k][4] | (h[k][5] << 16); w.w = h[k][6] | (h[k][7] << 16);
                *(u32x4*)dstp[k] = w; }
        }
    }
    LAS float* A = (LAS float*)lds;
    {
        const int colid = tid & 255, half = tid >> 8, dir = colid >> 7, hd = colid & 127;
        const float* wg = (dir == 0 ? p.in[13] : p.in[15]) + l * 16 * 128 + hd;
        const float bg = (dir == 0 ? p.in[14] : p.in[16])[l * 128 + hd];
        float w[16];
#pragma unroll
        for (int r = 0; r < 16; ++r) w[r] = wg[r * 128];
#pragma unroll 4
        for (int t = half * 32; t < half * 32 + 32; ++t) {
            const bf16_t* gp = HX + (size_t)(row0 + t) * DINP + (dir == 0 ? C_GF : C_GB);
            const bf16x8 g0 = ld16(gp), g1 = ld16(gp + 8);
            float acc = bg;
#pragma unroll
            for (int r = 0; r < 8; ++r) { acc += bf2f((bf16_t)g0[r]) * w[r]; acc += bf2f((bf16_t)g1[r]) * w[8 + r]; }
            A[(dir * 64 + t) * 128 + hd] = log_sigmoid(acc) * (1.0f / 16.0f);
        }
    }
    __syncthreads();
    if (tid < 256) {
        const int dir = tid >> 7, hd = tid & 127; float s = 0.f;
        if (dir == 0) {
#pragma unroll 8
            for (int t = 0; t < 64; ++t) { s += A[t * 128 + hd]; A[t * 128 + hd] = s; } }
        else {
#pragma unroll 8
            for (int t = 63; t >= 0; --t) { s += A[(64 + t) * 128 + hd]; A[(64 + t) * 128 + hd] = s; } }
        ((float*)(ws + WS_BLAST))[(((size_t)b * NCHUNK + (pos0 >> 6)) * 2 + dir) * 128 + hd] = s;
    }
    __syncthreads();
    {
        unsigned short kraw[4][8];
#pragma unroll
        for (int k = 0; k < 4; ++k) { const int job = tid + 512 * k; const int hd = job & 127, tg = (job >> 7) & 7;
            const bf16_t* src = HX + (size_t)(row0 + 8 * tg) * DINP + C_GLK + hd;
#pragma unroll
            for (int i = 0; i < 8; ++i) kraw[k][i] = src[(size_t)i * DINP]; }
#pragma unroll
        for (int k = 0; k < 4; ++k) { const int job = tid + 512 * k; const int hd = job & 127, tg = (job >> 7) & 7, dir = job >> 10;
            const float bl = A[(dir * 64 + (dir == 0 ? 63 : 0)) * 128 + hd];
            unsigned h[8];
#pragma unroll
            for (int i = 0; i < 8; ++i) h[i] = f2bf(bf2f(kraw[k][i]) * __expf(bl - A[(dir * 64 + 8 * tg + i) * 128 + hd]));
            u32x4 w; w.x = h[0] | (h[1] << 16); w.y = h[2] | (h[3] << 16); w.z = h[4] | (h[5] << 16); w.w = h[6] | (h[7] << 16);
            *(u32x4*)((bf16_t*)(ws + WS_KKT) + ((size_t)(dir * NB + b) * 128 + hd) * KSEQ + pos0 + 8 * tg) = w; }
    }
    __syncthreads();
    {
        const float qs = 0.17677669529663687f;
        unsigned qraw[8], kraw[8];
#pragma unroll
        for (int k = 0; k < 8; ++k) { const int e = tid + 512 * k; const int t = e >> 6, hp = (e & 63) * 2; const bf16_t* rowp = HX + (size_t)(row0 + t) * DINP;
            qraw[k] = *(const unsigned*)(rowp + C_GLQ + hp); kraw[k] = *(const unsigned*)(rowp + C_GLK + hp); }
#pragma unroll
        for (int k = 0; k < 8; ++k) { const int e = tid + 512 * k; const int t = e >> 6, hp = (e & 63) * 2; bf16_t* rowp = HX + (size_t)(row0 + t) * DINP;
            const float q0 = __uint_as_float(qraw[k] << 16), q1 = __uint_as_float(qraw[k] & 0xffff0000u), k0 = __uint_as_float(kraw[k] << 16), k1 = __uint_as_float(kraw[k] & 0xffff0000u);
            const float bf0 = A[t * 128 + hp], bf1 = A[t * 128 + hp + 1], bb0 = A[(64 + t) * 128 + hp], bb1 = A[(64 + t) * 128 + hp + 1];
            *(unsigned*)(rowp + C_GLQ + hp) = pk2(q0 * qs * __expf(bf0), q1 * qs * __expf(bf1));
            *(unsigned*)(rowp + C_GLK + hp) = pk2(k0 * __expf(-bf0), k1 * __expf(-bf1));
            *(unsigned*)(rowp + C_GLQB + hp) = pk2(q0 * qs * __expf(bb0), q1 * qs * __expf(bb1));
            *(unsigned*)(rowp + C_GLKB + hp) = pk2(k0 * __expf(-bb0), k1 * __expf(-bb1)); }
    }
    asm volatile("s_waitcnt vmcnt(0)" ::: "memory");
    __syncthreads();
    { const int wv = __builtin_amdgcn_readfirstlane(tid >> 6), h = wv >> 1, dir = wv & 1;
      gla_local_unit(ws, ((b * 4 + h) * 2 + dir) * NCHUNK + (pos0 >> 6), tid & 63); }
}

template <int NG> struct AttnState { float m[NG], l[NG]; f32x4 o[NG][4]; bf16x8 q[NG][2]; };

template <int NG> DI void attn_init(AttnState<NG>& st) {
#pragma unroll
    for (int g = 0; g < NG; ++g) { st.m[g] = -1e30f; st.l[g] = 0.f;
#pragma unroll
        for (int d = 0; d < 4; ++d) st.o[g][d] = (f32x4){0.f, 0.f, 0.f, 0.f}; }
}
template <int NG, bool BIAS> DI void attn_block(AttnState<NG>& st, const bf16_t* kp0, const bf16_t* kp1, const bf16_t* vp0, const bf16_t* vp1, const f32x4& bias0, const f32x4& bias1) {
    const bf16x8 k00 = ld16(kp0), k01 = ld16(kp0 + 32), k10 = ld16(kp1), k11 = ld16(kp1 + 32);
    u64 v0[4], v1[4];
#pragma unroll
    for (int d = 0; d < 4; ++d) { v0[d] = ld8(vp0 + (size_t)d * 16 * KSEQ); v1[d] = ld8(vp1 + (size_t)d * 16 * KSEQ); }
#pragma unroll
    for (int g = 0; g < NG; ++g) {
        f32x4 s0 = MFMA16(k00, st.q[g][0], ((f32x4){0.f, 0.f, 0.f, 0.f})); s0 = MFMA16(k01, st.q[g][1], s0);
        f32x4 s1 = MFMA16(k10, st.q[g][0], ((f32x4){0.f, 0.f, 0.f, 0.f})); s1 = MFMA16(k11, st.q[g][1], s1);
        if (BIAS) { s0 += bias0; s1 += bias1; }
        float mx = fmaxf(fmaxf(fmaxf(s0[0], s0[1]), fmaxf(s0[2], s0[3])), fmaxf(fmaxf(s1[0], s1[1]), fmaxf(s1[2], s1[3])));
        mx = quad_max(mx);
        const float mn = fmaxf(st.m[g], mx), corr = __builtin_amdgcn_exp2f(st.m[g] - mn); st.m[g] = mn;
        f32x4 p0, p1;
#pragma unroll
        for (int j = 0; j < 4; ++j) { p0[j] = __builtin_amdgcn_exp2f(s0[j] - mn); p1[j] = __builtin_amdgcn_exp2f(s1[j] - mn); }
        st.l[g] = st.l[g] * corr + ((p0[0] + p0[1]) + (p0[2] + p0[3])) + ((p1[0] + p1[1]) + (p1[2] + p1[3]));
        const bf16x8 pf = pack8(p0, p1);
#pragma unroll
        for (int d = 0; d < 4; ++d) { st.o[g][d] = st.o[g][d] * corr; st.o[g][d] = MFMA16(cat8(v0[d], v1[d]), pf, st.o[g][d]); }
    }
}
template <int NG> DI void attn_run(AttnState<NG>& st, const bf16_t* kl, size_t kpitch, const bf16_t* vl, int nblk) {
    const f32x4 z = {0.f, 0.f, 0.f, 0.f};
#pragma unroll 2
    for (int i = 0; i < nblk; ++i) { const bf16_t* kp0 = kl + (size_t)(32 * i) * kpitch; attn_block<NG, false>(st, kp0, kp0 + 16 * kpitch, vl + 32 * i, vl + 32 * i + 16, z, z); }
}
template <int NG> DI void attn_finish(AttnState<NG>& st, bf16_t* orow  , int hstride, int quad) {
#pragma unroll
    for (int g = 0; g < NG; ++g) { const float inv = 1.0f / quad_sum(st.l[g]);
#pragma unroll
        for (int d = 0; d < 4; ++d) { const f32x4 o = st.o[g][d] * inv; u32x2 w; w.x = pk2(o[0], o[1]); w.y = pk2(o[2], o[3]);
            *(u32x2*)(orow + g * hstride + 16 * d + 4 * quad) = w; } }
}

DI void gqa_unit_x(unsigned char* ws, int u, int lane) {
    const int c16 = lane & 15, quad = lane >> 4;
    const int qb = u & 255, kvh = (u >> 8) & 1, b = u >> 9;
    const bf16_t* HX = (const bf16_t*)(ws + WS_HB); bf16_t* MIX = (bf16_t*)(ws + WS_HN);
    const size_t qrow = (size_t)b * SEQ + 16 * qb + c16;
    AttnState<2> st; attn_init(st);
#pragma unroll
    for (int g = 0; g < 2; ++g) { const bf16_t* qp = HX + qrow * DINP + C_GQQ + (2 * kvh + g) * 64 + quad * 8; st.q[g][0] = ld16(qp); st.q[g][1] = ld16(qp + 32); }
    const bf16_t* vt = (const bf16_t*)(ws + WS_GVT) + ((size_t)(b * 2 + kvh) * 64 + c16) * KSEQ + quad * 4;
    attn_run<2>(st, HX + ((size_t)b * SEQ + c16) * DINP + C_GQK + kvh * 64 + quad * 8, DINP, vt, SEQ / 32);
    attn_run<2>(st, HX + ((size_t)TX + b * CTX + c16) * DINP + C_GQK + kvh * 64 + quad * 8, DINP, vt + SEQ, CTX / 32);
    attn_finish<2>(st, MIX + qrow * DM + 768 + (2 * kvh) * 64, 64, quad);
}
DI void gqa_unit_z(unsigned char* ws, int u, int lane) {
    const int c16 = lane & 15, quad = lane >> 4;
    const int qb = u & 15, kvh = (u >> 4) & 1, b = u >> 5;
    const bf16_t* HX = (const bf16_t*)(ws + WS_HB); bf16_t* MIX = (bf16_t*)(ws + WS_HN);
    const size_t qrow = (size_t)TX + b * CTX + 16 * qb + c16;
    AttnState<2> st; attn_init(st);
#pragma unroll
    for (int g = 0; g < 2; ++g) { const bf16_t* qp = HX + qrow * DINP + C_GQQ + (2 * kvh + g) * 64 + quad * 8; st.q[g][0] = ld16(qp); st.q[g][1] = ld16(qp + 32); }
    const bf16_t* vt = (const bf16_t*)(ws + WS_GVT) + ((size_t)(b * 2 + kvh) * 64 + c16) * KSEQ + quad * 4;
    attn_run<2>(st, HX + ((size_t)TX + b * CTX + c16) * DINP + C_GQK + kvh * 64 + quad * 8, DINP, vt + SEQ, CTX / 32);
    attn_finish<2>(st, MIX + qrow * DM + 768 + (2 * kvh) * 64, 64, quad);
}
DI void na_unit_z(unsigned char* ws, int u, int lane) {
    const int c16 = lane & 15, quad = lane >> 4;
    const int qb = u & 15, h = (u >> 4) & 3, b = u >> 6;
    const bf16_t* HX = (const bf16_t*)(ws + WS_HB); bf16_t* MIX = (bf16_t*)(ws + WS_HN);
    const size_t qrow = (size_t)TX + b * CTX + 16 * qb + c16;
    AttnState<1> st; attn_init(st);
    { const bf16_t* qp = HX + qrow * DINP + C_NAQ + h * 64 + quad * 8; st.q[0][0] = ld16(qp); st.q[0][1] = ld16(qp + 32); }
    const bf16_t* vt = (const bf16_t*)(ws + WS_NAVT) + ((size_t)(b * 4 + h) * 64 + c16) * KSEQ + quad * 4;
    attn_run<1>(st, HX + ((size_t)TX + b * CTX + c16) * DINP + C_NAK + h * 64 + quad * 8, DINP, vt + SEQ, CTX / 32);
    attn_finish<1>(st, MIX + qrow * DM + 256 + h * 64, 64, quad);
}
DI void na_unit_x(unsigned char* ws, const LAS float* rpbL, int u, int lane) {
    const int c16 = lane & 15, quad = lane >> 4;
    const int cb = u & 3, r = (u >> 2) & 63, h = (u >> 8) & 3, b = u >> 10;
    const bf16_t* HX = (const bf16_t*)(ws + WS_HB); bf16_t* MIX = (bf16_t*)(ws + WS_HN);
    const int c = 16 * cb + c16;
    const size_t qrow = (size_t)b * SEQ + 64 * r + c;
    AttnState<1> st; attn_init(st);
    { const bf16_t* qp = HX + qrow * DINP + C_NAQ + h * 64 + quad * 8; st.q[0][0] = ld16(qp); st.q[0][1] = ld16(qp + 32); }
    const bf16_t* vt = (const bf16_t*)(ws + WS_NAVT) + ((size_t)(b * 4 + h) * 64 + c16) * KSEQ + quad * 4;
    const int rs = min(max(r - 4, 0), 56), cbase = min(max(16 * cb - 8, 0), 32), cs = min(max(c - 8, 0), 48);
    const LAS float* rpb = rpbL + h * 15 * 31;
#pragma unroll 2
    for (int wr = 0; wr < 8; ++wr) {
        const int krow = rs + wr, t0 = krow * 64 + cbase;
        const LAS float* bp = rpb + (krow - r + 7) * 31;
        f32x4 b0, b1;
#pragma unroll
        for (int j = 0; j < 4; ++j) { const int kc0 = cbase + 4 * quad + j, kc1 = kc0 + 16;
            const bool ok0 = (kc0 >= cs) && (kc0 < cs + 16), ok1 = (kc1 >= cs) && (kc1 < cs + 16);
            const float w0 = bp[min(max(kc0 - c + 15, 0), 30)], w1 = bp[min(max(kc1 - c + 15, 0), 30)];
            b0[j] = ok0 ? w0 * LOG2E : -1e30f; b1[j] = ok1 ? w1 * LOG2E : -1e30f; }
        const bf16_t* kp0 = HX + ((size_t)b * SEQ + t0 + c16) * DINP + C_NAK + h * 64 + quad * 8;
        attn_block<1, true>(st, kp0, kp0 + (size_t)16 * DINP, vt + t0, vt + t0 + 16, b0, b1);
    }
    attn_run<1>(st, HX + ((size_t)TX + b * CTX + c16) * DINP + C_NAK + h * 64 + quad * 8, DINP, vt + SEQ, CTX / 32);
    attn_finish<1>(st, MIX + qrow * DM + 256 + h * 64, 64, quad);
}

DI void na_row_unit(unsigned char* ws, const LAS float* rpbL, int u, int lane) {
    const int c16 = lane & 15, quad = lane >> 4;
    const int r = u & 63, h = (u >> 6) & 3, b = u >> 8;
    const bf16_t* HX = (const bf16_t*)(ws + WS_HB); bf16_t* MIX = (bf16_t*)(ws + WS_HN);
    const size_t qrow0 = (size_t)b * SEQ + 64 * r;
    float m[4], l[4]; f32x4 o[4][4]; bf16x8 q[4][2];
#pragma unroll
    for (int g = 0; g < 4; ++g) { m[g] = -1e30f; l[g] = 0.f;
#pragma unroll
        for (int d = 0; d < 4; ++d) o[g][d] = (f32x4){0.f, 0.f, 0.f, 0.f};
        const bf16_t* qp = HX + (qrow0 + 16 * g + c16) * DINP + C_NAQ + h * 64 + quad * 8; q[g][0] = ld16(qp); q[g][1] = ld16(qp + 32); }
    const bf16_t* vt = (const bf16_t*)(ws + WS_NAVT) + ((size_t)(b * 4 + h) * 64 + c16) * KSEQ + quad * 8;
    const int tokoff = 8 * (c16 >> 2) + (c16 & 3);
    const int rs = min(max(r - 4, 0), 56);
    const LAS float* rpb = rpbL + h * 15 * 31;
#pragma unroll 1
    for (int blk = 0; blk < 24; ++blk) {
        const bool win = blk < 16; const int wr = blk >> 1, cblk = blk & 1;
        const int t0 = win ? (rs + wr) * 64 + 32 * cblk : SEQ + 32 * (blk - 16);
        const bf16_t* kbase = (win ? HX + ((size_t)b * SEQ + t0 + tokoff) * DINP : HX + ((size_t)TX + b * CTX + (t0 - SEQ) + tokoff) * DINP) + C_NAK + h * 64 + quad * 8;
        const bf16x8 kA0 = ld16(kbase), kA1 = ld16(kbase + 32), kB0 = ld16(kbase + (size_t)4 * DINP), kB1 = ld16(kbase + (size_t)4 * DINP + 32);
        bf16x8 vf[4];
#pragma unroll
        for (int d = 0; d < 4; ++d) vf[d] = ld16(vt + t0 + (size_t)d * 16 * KSEQ);
        const LAS float* bp = rpb + (win ? (rs + wr - r + 7) : 0) * 31;
#pragma unroll
        for (int g = 0; g < 4; ++g) {
            if (win && ((g == 0 && cblk == 1) || (g == 3 && cblk == 0))) continue;
            f32x4 s0 = MFMA16(kA0, q[g][0], ((f32x4){0.f, 0.f, 0.f, 0.f})); s0 = MFMA16(kA1, q[g][1], s0);
            f32x4 s1 = MFMA16(kB0, q[g][0], ((f32x4){0.f, 0.f, 0.f, 0.f})); s1 = MFMA16(kB1, q[g][1], s1);
            if (win) { const int c = 16 * g + c16, cs = min(max(c - 8, 0), 48);
                const int kc0 = 32 * cblk + 8 * quad, lo = cs - kc0; const LAS float* bq = bp + (kc0 - c + 15);
#pragma unroll
                for (int j = 0; j < 4; ++j) { const float w0 = bq[j], w1 = bq[j + 4];
                    const bool ok0 = (unsigned)(j - lo) < 16u, ok1 = (unsigned)(j + 4 - lo) < 16u;
                    s0[j] = ok0 ? s0[j] + w0 * LOG2E : -INFINITY; s1[j] = ok1 ? s1[j] + w1 * LOG2E : -INFINITY; } }
            float mx = fmaxf(fmaxf(fmaxf(s0[0], s0[1]), fmaxf(s0[2], s0[3])), fmaxf(fmaxf(s1[0], s1[1]), fmaxf(s1[2], s1[3])));
            mx = quad_max(mx);
            if (__any(mx > m[g] + 8.0f)) { const float mn = fmaxf(m[g], mx), corr = __builtin_amdgcn_exp2f(m[g] - mn); m[g] = mn; l[g] *= corr;
#pragma unroll
                for (int d = 0; d < 4; ++d) o[g][d] = o[g][d] * corr; }
            const float mr = m[g];
            f32x4 p0, p1;
#pragma unroll
            for (int j = 0; j < 4; ++j) { p0[j] = __builtin_amdgcn_exp2f(s0[j] - mr); p1[j] = __builtin_amdgcn_exp2f(s1[j] - mr); }
            l[g] += ((p0[0] + p0[1]) + (p0[2] + p0[3])) + ((p1[0] + p1[1]) + (p1[2] + p1[3]));
            const bf16x8 pf = pack8(p0, p1);
#pragma unroll
            for (int d = 0; d < 4; ++d) o[g][d] = MFMA16(vf[d], pf, o[g][d]);
        }
    }
#pragma unroll
    for (int g = 0; g < 4; ++g) { const float inv = 1.0f / quad_sum(l[g]); bf16_t* orow = MIX + (qrow0 + 16 * g + c16) * DM + 256 + h * 64;
#pragma unroll
        for (int d = 0; d < 4; ++d) { const f32x4 ov = o[g][d] * inv; u32x2 w; w.x = pk2(ov[0], ov[1]); w.y = pk2(ov[2], ov[3]);
            *(u32x2*)(orow + 16 * d + 4 * quad) = w; } }
}

DI int chunk_row0(int b, int pc) { return pc < 64 ? b * SEQ + 64 * pc : TX + b * CTX + 64 * (pc - 64); }
DI void gla_local_unit(unsigned char* ws, int u, int lane) {
    const int c16 = lane & 15, quad = lane >> 4;
    const int pc = u % NCHUNK; const int seq = u / NCHUNK; const int dir = seq & 1, h = (seq >> 1) & 3, b = seq >> 3;
    const bf16_t* vt = (const bf16_t*)(ws + WS_GLVT) + ((size_t)(b * 4 + h) * 64 + c16) * KSEQ + 64 * pc + quad * 8;
    const bf16_t* kt = (const bf16_t*)(ws + WS_KKT) + ((size_t)((dir * NB + b) * 4 + h) * 32 + c16) * KSEQ + 64 * pc + quad * 8;
    bf16x8 kf[2][2];
#pragma unroll
    for (int db = 0; db < 2; ++db)
#pragma unroll
        for (int ks = 0; ks < 2; ++ks) kf[db][ks] = ld16(kt + (size_t)db * 16 * KSEQ + 32 * ks);
    float* dst = (float*)(ws + WS_SLOC) + ((size_t)seq * NCHUNK + pc) * 2048;
#pragma unroll
    for (int eb = 0; eb < 4; ++eb) { const bf16x8 a0 = ld16(vt + (size_t)eb * 16 * KSEQ), a1 = ld16(vt + (size_t)eb * 16 * KSEQ + 32);
#pragma unroll
        for (int db = 0; db < 2; ++db) { f32x4 acc = MFMA16(a0, kf[db][0], ((f32x4){0.f, 0.f, 0.f, 0.f})); acc = MFMA16(a1, kf[db][1], acc);
#pragma unroll
            for (int j = 0; j < 4; ++j) dst[(16 * eb + 4 * quad + j) * 32 + 16 * db + c16] = acc[j]; } }
}
DI void gla_scan(unsigned char* ws, int gt, int NT) {
    const float* sloc = (const float*)(ws + WS_SLOC); bf16_t* sst = (bf16_t*)(ws + WS_SST); const float* blast = (const float*)(ws + WS_BLAST);
    for (int idx = gt; idx < 64 * 2048; idx += NT) {
        const int el = idx & 2047, seq = idx >> 11, d = el & 31, dir = seq & 1, h = (seq >> 1) & 3, b = seq >> 3;
        float S = 0.f;
        for (int s0 = 0; s0 < NCHUNK; s0 += 17) {
            float lv[17], dv[17];
#pragma unroll
            for (int i = 0; i < 17; ++i) { const int s = s0 + i; const int pc = (dir == 0) ? (s < 4 ? 64 + s : s - 4) : (s < 4 ? 67 - s : 67 - s);
                lv[i] = sloc[((size_t)seq * NCHUNK + pc) * 2048 + el]; dv[i] = blast[(((size_t)b * NCHUNK + pc) * 2 + dir) * 128 + h * 32 + d]; }
#pragma unroll
            for (int i = 0; i < 17; ++i) { const int s = s0 + i; const int pc = (dir == 0) ? (s < 4 ? 64 + s : s - 4) : (s < 4 ? 67 - s : 67 - s);
                sst[((size_t)seq * NCHUNK + pc) * 2048 + el] = f2bf(S); S = __expf(dv[i]) * S + lv[i]; }
        }
    }
}
DI void gla_out_unit(const Params& p, int l, int u, int lane) {
    unsigned char* ws = p.ws;
    const int c16 = lane & 15, quad = lane >> 4;
    const int ib = u & 3, pc = (u >> 2) % NCHUNK, bh = (u >> 2) / NCHUNK, h = bh & 3, b = bh >> 2;
    const bf16_t* HX = (const bf16_t*)(ws + WS_HB); bf16_t* MIX = (bf16_t*)(ws + WS_HN);
    const int row0 = chunk_row0(b, pc);
    const bf16_t* vt = (const bf16_t*)(ws + WS_GLVT) + ((size_t)(b * 4 + h) * 64 + c16) * KSEQ + 64 * pc + quad * 4;
    f32x4 o[4];
#pragma unroll
    for (int e = 0; e < 4; ++e) o[e] = (f32x4){0.f, 0.f, 0.f, 0.f};
    const int i_tok = 16 * ib + c16;
#pragma unroll
    for (int dir = 0; dir < 2; ++dir) {
        const int qc = (dir == 0 ? C_GLQ : C_GLQB) + h * 32, kc = (dir == 0 ? C_GLK : C_GLKB) + h * 32;
        const bf16x8 qf = ld16(HX + (size_t)(row0 + i_tok) * DINP + qc + quad * 8);
        const bf16_t* sp = (const bf16_t*)(ws + WS_SST) + ((size_t)((b * 4 + h) * 2 + dir) * NCHUNK + pc) * 2048 + c16 * 32 + quad * 8;
#pragma unroll
        for (int e = 0; e < 4; ++e) o[e] = MFMA16(ld16(sp + e * 16 * 32), qf, o[e]);
#pragma unroll
        for (int pr = 0; pr < 2; ++pr) {
            f32x4 s[2];
#pragma unroll
            for (int sb = 0; sb < 2; ++sb) { const int jb = 2 * pr + sb;
                const bf16x8 kf = ld16(HX + (size_t)(row0 + 16 * jb + c16) * DINP + kc + quad * 8);
                s[sb] = MFMA16(kf, qf, ((f32x4){0.f, 0.f, 0.f, 0.f}));
#pragma unroll
                for (int j = 0; j < 4; ++j) { const int jt = 16 * jb + 4 * quad + j; const bool keep = (dir == 0) ? (jt <= i_tok) : (jt >= i_tok); s[sb][j] = keep ? s[sb][j] : 0.f; } }
            const bf16x8 pf = pack8(s[0], s[1]);
#pragma unroll
            for (int e = 0; e < 4; ++e) o[e] = MFMA16(cat8(ld8(vt + (size_t)e * 16 * KSEQ + 32 * pr), ld8(vt + (size_t)e * 16 * KSEQ + 32 * pr + 16)), pf, o[e]);
        }
    }
    float ss = 0.f;
#pragma unroll
    for (int e = 0; e < 4; ++e) ss += (o[e][0] * o[e][0] + o[e][1] * o[e][1]) + (o[e][2] * o[e][2] + o[e][3] * o[e][3]);
    ss = quad_sum(ss);
    const float rstd = rsqrtf(ss * (1.0f / 64.0f) + EPS);
    const float* gain = p.in[17] + l * 64;
    const size_t row = (size_t)row0 + i_tok;
#pragma unroll
    for (int e = 0; e < 4; ++e) { const int ec = 16 * e + 4 * quad;
        const u32x2 rr = *(const u32x2*)(HX + row * DINP + C_GLR + h * 64 + ec); const f32x4 g = *(const f32x4*)(gain + ec);
        const float r0 = __uint_as_float(rr.x << 16), r1 = __uint_as_float(rr.x & 0xffff0000u), r2 = __uint_as_float(rr.y << 16), r3 = __uint_as_float(rr.y & 0xffff0000u);
        u32x2 w; w.x = pk2(o[e][0] * rstd * g[0] * pg8::silu_f(r0), o[e][1] * rstd * g[1] * pg8::silu_f(r1)); w.y = pk2(o[e][2] * rstd * g[2] * pg8::silu_f(r2), o[e][3] * rstd * g[3] * pg8::silu_f(r3));
        *(u32x2*)(MIX + row * DM + 512 + h * 64 + ec) = w; }
}

DI void gla_chunk_unit(const Params& p, int l, int u, int lane) {
    unsigned char* ws = p.ws;
    const int c16 = lane & 15, quad = lane >> 4;
    const int pc = u % NCHUNK, bh = u / NCHUNK, h = bh & 3, b = bh >> 2;
    const bf16_t* HX = (const bf16_t*)(ws + WS_HB); bf16_t* MIX = (bf16_t*)(ws + WS_HN);
    const int row0 = chunk_row0(b, pc);
    const bf16_t* vt = (const bf16_t*)(ws + WS_GLVT) + ((size_t)(b * 4 + h) * 64 + c16) * KSEQ + 64 * pc + quad * 8;
    bf16x8 vf[2][4];
#pragma unroll
    for (int pr = 0; pr < 2; ++pr)
#pragma unroll
        for (int e = 0; e < 4; ++e) vf[pr][e] = ld16(vt + (size_t)e * 16 * KSEQ + 32 * pr);
    f32x4 o[4][4];
#pragma unroll
    for (int ib = 0; ib < 4; ++ib)
#pragma unroll
        for (int e = 0; e < 4; ++e) o[ib][e] = (f32x4){0.f, 0.f, 0.f, 0.f};
    const int ktok = 8 * (c16 >> 2) + (c16 & 3);
#pragma unroll
    for (int dir = 0; dir < 2; ++dir) {
        const int qc = (dir == 0 ? C_GLQ : C_GLQB) + h * 32, kc = (dir == 0 ? C_GLK : C_GLKB) + h * 32;
        bf16x8 qf[4], sf[4], kA[2], kB[2];
#pragma unroll
        for (int ib = 0; ib < 4; ++ib) qf[ib] = ld16(HX + (size_t)(row0 + 16 * ib + c16) * DINP + qc + quad * 8);
        const bf16_t* sp = (const bf16_t*)(ws + WS_SST) + ((size_t)((b * 4 + h) * 2 + dir) * NCHUNK + pc) * 2048 + c16 * 32 + quad * 8;
#pragma unroll
        for (int e = 0; e < 4; ++e) sf[e] = ld16(sp + e * 16 * 32);
#pragma unroll
        for (int pr = 0; pr < 2; ++pr) { const bf16_t* kp = HX + (size_t)(row0 + 32 * pr + ktok) * DINP + kc + quad * 8; kA[pr] = ld16(kp); kB[pr] = ld16(kp + (size_t)4 * DINP); }
#pragma unroll
        for (int ib = 0; ib < 4; ++ib) {
#pragma unroll
            for (int e = 0; e < 4; ++e) o[ib][e] = MFMA16(sf[e], qf[ib], o[ib][e]);
            const int it = 16 * ib + c16;
#pragma unroll
            for (int pr = 0; pr < 2; ++pr) {
                const bool need = (dir == 0) ? (32 * pr <= 16 * ib + 15) : (32 * pr + 31 >= 16 * ib);
                if (!need) continue;
                f32x4 s0 = MFMA16(kA[pr], qf[ib], ((f32x4){0.f, 0.f, 0.f, 0.f})), s1 = MFMA16(kB[pr], qf[ib], ((f32x4){0.f, 0.f, 0.f, 0.f}));
#pragma unroll
                for (int j = 0; j < 4; ++j) { const int j0 = 32 * pr + 8 * quad + j, j1 = j0 + 4;
                    const bool k0 = (dir == 0) ? (j0 <= it) : (j0 >= it), k1 = (dir == 0) ? (j1 <= it) : (j1 >= it);
                    s0[j] = k0 ? s0[j] : 0.f; s1[j] = k1 ? s1[j] : 0.f; }
                const bf16x8 pf = pack8(s0, s1);
#pragma unroll
                for (int e = 0; e < 4; ++e) o[ib][e] = MFMA16(vf[pr][e], pf, o[ib][e]);
            }
        }
    }
    const float* gain = p.in[17] + l * 64;
#pragma unroll
    for (int ib = 0; ib < 4; ++ib) {
        float ss = 0.f;
#pragma unroll
        for (int e = 0; e < 4; ++e) ss += (o[ib][e][0] * o[ib][e][0] + o[ib][e][1] * o[ib][e][1]) + (o[ib][e][2] * o[ib][e][2] + o[ib][e][3] * o[ib][e][3]);
        ss = quad_sum(ss);
        const float rstd = rsqrtf(ss * (1.0f / 64.0f) + EPS);
        const size_t row = (size_t)row0 + 16 * ib + c16;
#pragma unroll
        for (int e = 0; e < 4; ++e) { const int ec = 16 * e + 4 * quad;
            const u32x2 rr = *(const u32x2*)(HX + row * DINP + C_GLR + h * 64 + ec); const f32x4 g = *(const f32x4*)(gain + ec);
            const float r0 = __uint_as_float(rr.x << 16), r1 = __uint_as_float(rr.x & 0xffff0000u), r2 = __uint_as_float(rr.y << 16), r3 = __uint_as_float(rr.y & 0xffff0000u);
            u32x2 w; w.x = pk2(o[ib][e][0] * rstd * g[0] * pg8::silu_f(r0), o[ib][e][1] * rstd * g[1] * pg8::silu_f(r1)); w.y = pk2(o[ib][e][2] * rstd * g[2] * pg8::silu_f(r2), o[ib][e][3] * rstd * g[3] * pg8::silu_f(r3));
            *(u32x2*)(MIX + row * DM + 512 + h * 64 + ec) = w; }
    }
}

DI void four1_unit(unsigned char* ws, int u, int lane) {
    const int c16 = lane & 15, quad = lane >> 4;
    const int cq = u & 3, l2 = (u >> 2) & 63, bg = u >> 8, g = bg & 3, b = bg >> 2;
    const bf16_t* HX = (const bf16_t*)(ws + WS_HB);
    const bf16_t* FC = (const bf16_t*)(ws + WS_TAB + T_FC64); const bf16_t* FSN = (const bf16_t*)(ws + WS_TAB + T_FSN64); const float* TW = (const float*)(ws + WS_TAB + T_TW);
    bf16x8 uf[2];
    const bf16_t* up = HX + ((size_t)b * SEQ + l2) * DINP + C_FOUR + g * 64 + 16 * cq + c16;
#pragma unroll
    for (int ks = 0; ks < 2; ++ks) { unsigned hh[8];
#pragma unroll
        for (int j = 0; j < 8; ++j) hh[j] = up[(size_t)(64 * (quad * 8 + j + 32 * ks)) * DINP];
        u32x4 w; w.x = hh[0] | (hh[1] << 16); w.y = hh[2] | (hh[3] << 16); w.z = hh[4] | (hh[5] << 16); w.w = hh[6] | (hh[7] << 16); uf[ks] = __builtin_bit_cast(bf16x8, w); }
    bf16_t* tr = (bf16_t*)(ws + WS_TTR); bf16_t* ti = (bf16_t*)(ws + WS_TTI);
#pragma unroll
    for (int kq = 0; kq < 4; ++kq) {
        const bf16_t* fr = FC + (16 * kq + c16) * 64 + quad * 8; const bf16_t* fi = FSN + (16 * kq + c16) * 64 + quad * 8;
        f32x4 re = MFMA16(ld16(fr), uf[0], ((f32x4){0.f, 0.f, 0.f, 0.f})); re = MFMA16(ld16(fr + 32), uf[1], re);
        f32x4 im = MFMA16(ld16(fi), uf[0], ((f32x4){0.f, 0.f, 0.f, 0.f})); im = MFMA16(ld16(fi + 32), uf[1], im);
#pragma unroll
        for (int j = 0; j < 4; ++j) { const int kb = 16 * kq + 4 * quad + j; const float cw = TW[2 * (kb * 64 + l2)], sw = TW[2 * (kb * 64 + l2) + 1];
            const float xr = re[j] * cw + im[j] * sw, xi = im[j] * cw - re[j] * sw;
            const size_t off = (((size_t)bg * 64 + kb) * 64 + l2) * 64 + 16 * cq + c16;
            tr[off] = f2bf(xr); ti[off] = f2bf(xi); }
    }
}
template <int NLB, bool CPLX> DI void four2_unit(const bf16_t* xr, const bf16_t* xi, size_t xpitch, const bf16_t* FC64, const bf16_t* FS64, const bf16_t* FSN64,
                                                  const bf16_t* FLC, const bf16_t* FLS, bf16_t* out, size_t out_rstride, float scale, int mb, int lane, int kq_lo = 0, int kq_hi = NLB) {
    const int c16 = lane & 15, quad = lane >> 4;
    bf16x8 bc[2], bs[2], bsn[2];
#pragma unroll
    for (int ks = 0; ks < 2; ++ks) { const size_t o = (size_t)(16 * mb + c16) * 64 + quad * 8 + 32 * ks; bc[ks] = ld16(FC64 + o); bs[ks] = ld16(FS64 + o); bsn[ks] = ld16(FSN64 + o); }
    bf16x8 qr[NLB / 2], qi[NLB / 2];
#pragma unroll
    for (int pr = 0; pr < NLB / 2; ++pr) {
        f32x4 tr[2], ti[2];
#pragma unroll
        for (int sb = 0; sb < 2; ++sb) { const int lb = 2 * pr + sb;
            const bf16_t* xp = xr + (size_t)(16 * lb + c16) * xpitch + quad * 8;
            const bf16x8 a0 = ld16(xp), a1 = ld16(xp + 32);
            tr[sb] = MFMA16(a0, bc[0], ((f32x4){0.f, 0.f, 0.f, 0.f})); tr[sb] = MFMA16(a1, bc[1], tr[sb]);
            ti[sb] = MFMA16(a0, bsn[0], ((f32x4){0.f, 0.f, 0.f, 0.f})); ti[sb] = MFMA16(a1, bsn[1], ti[sb]);
            if (CPLX) { const bf16_t* yp = xi + (size_t)(16 * lb + c16) * xpitch + quad * 8; const bf16x8 i0 = ld16(yp), i1 = ld16(yp + 32);
                tr[sb] = MFMA16(i0, bs[0], tr[sb]); tr[sb] = MFMA16(i1, bs[1], tr[sb]);
                ti[sb] = MFMA16(i0, bc[0], ti[sb]); ti[sb] = MFMA16(i1, bc[1], ti[sb]); } }
        qr[pr] = pack8(tr[0], tr[1]); qi[pr] = pack8(ti[0], ti[1]);
    }
    constexpr int NL = NLB * 16;
#pragma unroll 2
    for (int kq = kq_lo; kq < kq_hi; ++kq) {
        f32x4 y = {0.f, 0.f, 0.f, 0.f};
        const bf16_t* fc = FLC + (size_t)(16 * kq + c16) * NL + quad * 4; const bf16_t* fs = FLS + (size_t)(16 * kq + c16) * NL + quad * 4;
#pragma unroll
        for (int pr = 0; pr < NLB / 2; ++pr) { y = MFMA16(cat8(ld8(fc + 32 * pr), ld8(fc + 32 * pr + 16)), qr[pr], y); y = MFMA16(cat8(ld8(fs + 32 * pr), ld8(fs + 32 * pr + 16)), qi[pr], y); }
#pragma unroll
        for (int j = 0; j < 4; ++j) out[(size_t)(16 * kq + 4 * quad + j) * out_rstride + c16] = f2bf(y[j] * scale);
    }
}

DI void four2_row_unit(unsigned char* ws, int u, int lane) {
    asm volatile("" : "+v"(lane));
    const int c16 = lane & 15, quad = lane >> 4;
    const int kb = u & 63, bg = u >> 6;
    const unsigned char* tab = ws + WS_TAB;
    const bf16_t* FC = (const bf16_t*)(tab + T_FC64); const bf16_t* FS = (const bf16_t*)(tab + T_FS64); const bf16_t* FSN = (const bf16_t*)(tab + T_FSN64);
    const size_t xo = ((size_t)bg * 64 + kb) * 4096;
    const bf16_t* xr = (const bf16_t*)(ws + WS_TTR) + xo; const bf16_t* xi = (const bf16_t*)(ws + WS_TTI) + xo;
    bf16x8 tc[4][2], ts[4][2];
#pragma unroll
    for (int kq = 0; kq < 4; ++kq)
#pragma unroll
        for (int pr = 0; pr < 2; ++pr) { const size_t o = (size_t)(16 * kq + c16) * 64 + quad * 4 + 32 * pr; tc[kq][pr] = cat8(ld8(FC + o), ld8(FC + o + 16)); ts[kq][pr] = cat8(ld8(FS + o), ld8(FS + o + 16)); }
    bf16_t* out = (bf16_t*)(ws + WS_HN) + ((size_t)(bg >> 2) * SEQ + kb) * DM + (bg & 3) * 64;
#pragma unroll 1
    for (int mb = 0; mb < 4; ++mb) {
        bf16x8 bc[2], bs[2], bsn[2];
#pragma unroll
        for (int ks = 0; ks < 2; ++ks) { const size_t o = (size_t)(16 * mb + c16) * 64 + quad * 8 + 32 * ks; bc[ks] = ld16(FC + o); bs[ks] = ld16(FS + o); bsn[ks] = ld16(FSN + o); }
        bf16x8 qr[2], qi[2];
#pragma unroll
        for (int pr = 0; pr < 2; ++pr) { f32x4 tr[2], ti[2];
#pragma unroll
            for (int sb = 0; sb < 2; ++sb) { const int lb = 2 * pr + sb; const size_t o = (size_t)(16 * lb + c16) * 64 + quad * 8;
                const bf16x8 ar0 = ld16(xr + o), ar1 = ld16(xr + o + 32), ai0 = ld16(xi + o), ai1 = ld16(xi + o + 32);
                tr[sb] = MFMA16(ar0, bc[0], ((f32x4){0.f, 0.f, 0.f, 0.f})); tr[sb] = MFMA16(ar1, bc[1], tr[sb]); tr[sb] = MFMA16(ai0, bs[0], tr[sb]); tr[sb] = MFMA16(ai1, bs[1], tr[sb]);
                ti[sb] = MFMA16(ar0, bsn[0], ((f32x4){0.f, 0.f, 0.f, 0.f})); ti[sb] = MFMA16(ar1, bsn[1], ti[sb]); ti[sb] = MFMA16(ai0, bc[0], ti[sb]); ti[sb] = MFMA16(ai1, bc[1], ti[sb]); }
            qr[pr] = pack8(tr[0], tr[1]); qi[pr] = pack8(ti[0], ti[1]); }
#pragma unroll
        for (int kq = 0; kq < 4; ++kq) { f32x4 y = {0.f, 0.f, 0.f, 0.f};
#pragma unroll
            for (int pr = 0; pr < 2; ++pr) { y = MFMA16(tc[kq][pr], qr[pr], y); y = MFMA16(ts[kq][pr], qi[pr], y); }
#pragma unroll
            for (int j = 0; j < 4; ++j) out[(size_t)(16 * kq + 4 * quad + j) * 64 * DM + 16 * mb + c16] = f2bf(y[j] * (1.0f / 512.0f)); }
    }
}

#define PHASE_VARS \
    int tid = threadIdx.x; asm volatile("" : "+v"(tid)); \
    const int lane = tid & 63, wave = __builtin_amdgcn_readfirstlane(tid >> 6); \
    const int G = gridDim.x, bid = blockIdx.x, vbid = ((G & 7) == 0) ? (bid & 7) * (G >> 3) + (bid >> 3) : bid, gw = vbid * 8 + wave, NGW = G * 8, gt = bid * 512 + tid, NT = G * 512; \
    size_t ws_off0 = 0; asm volatile("" : "+s"(ws_off0)); unsigned char* ws = p.ws + ws_off0; \
    int hs = hs_loop; asm volatile("" : "+s"(hs)); \
    const int l = hs >> 1; const bool second = hs & 1; const bool lastl = (l == 1); \
    const float* mod = (const float*)(ws + WS_MOD) + (size_t)l * 9 * 9216; \
    const unsigned char* wl = ws + WS_W + (size_t)l * W_LAYER; \
    float* ZB = (float*)(ws + WS_Z); bf16_t* HN = (bf16_t*)(ws + WS_HN); bf16_t* HB = (bf16_t*)(ws + WS_HB); \
    (void)vbid; (void)lane; (void)wave; (void)gw; (void)NGW; (void)gt; (void)NT; (void)second; (void)lastl; (void)mod; (void)wl; (void)ZB; (void)HN; (void)HB; (void)bid; (void)G;

__global__ void __launch_bounds__(512, 2) mega_fwd(Params p) {
    extern __shared__ __attribute__((aligned(16))) unsigned char lds_raw[];
    LAS unsigned char* lds = (LAS unsigned char*)lds_raw;
    cg::grid_group grid = cg::this_grid();
    if (threadIdx.x < 2) ((volatile LAS unsigned*)(lds + LDS_BARST))[threadIdx.x] = 0u;
    __syncthreads();
    (void)xcd_barrier_post((unsigned*)(p.ws + WS_BAR), (volatile LAS unsigned*)(lds + LDS_BARST));
#define GRID_BAR() grid_bar_fn((unsigned*)(p.ws + WS_BAR), (unsigned)LDS_BARST)
#if DIAG_MODE
    unsigned long long t_prev = __builtin_amdgcn_s_memrealtime(); unsigned t_cat[8] = {0u, 0u, 0u, 0u, 0u, 0u, 0u, 0u};
#define STAMP(c) do { const unsigned long long t_now = __builtin_amdgcn_s_memrealtime(); t_cat[c] += (unsigned)(t_now - t_prev); t_prev = t_now; } while (0)
#else
#define STAMP(c) do {} while (0)
#endif
    { const int hs_loop = 0; PHASE_VARS
      phase_prologue<true>(p, lds, tid, lane, wave, bid, G, 0, 2); }
    grid.sync(); STAMP(0);
    { const int hs_loop = 0; PHASE_VARS
      shift_bias_mfma(ws, gw, NGW, lane);
      scale_pass(p.in[0], p.in[2], mod, 1, HN, (float*)(ws + WS_ROWSS), TT, gw, NGW, lane); }
    GRID_BAR(); STAMP(1);
    for (int rs_ = 0; rs_ < REP_SYNC; ++rs_) GRID_BAR();

#pragma unroll 1
    for (int hs_loop = 0; hs_loop < 4; ++hs_loop) {
        for (int rep = 0; rep < REP_UP; ++rep) {
        { PHASE_VARS
          const int Mrows = (hs == 3) ? TX : TT;
          const bf16_t* Ain = second ? (const bf16_t*)(ws + WS_NAVT) : HN;
          const int slot = second ? (l == 0 ? 2 : 5) : (l == 0 ? 0 : 3);
          pg8::Gemm g{Ain, (const bf16_t*)(wl + (second ? W_UP2 : W_UP1)), Mrows, 2 * DFF, DM, DM}; pg8::PrefOrder S; S.init(Mrows, 2 * DFF, G, bid);
          S.rowss = (const float*)(ws + WS_ROWSS) + (size_t)slot * TT; S.sb = (const float*)(ws + WS_SB) + (size_t)l * SB_LAYER + (second ? SB_UP2 : SB_UP1); S.sbN = 2 * DFF;
          pg8::EpiSwiglu E{HB, DFF};
          pg8::gemm_phase<pg8::EpiSwiglu, pg8::PrefOrder, true, true>(lds, g, S, E); }
        GRID_BAR(); STAMP(2); }
        { PHASE_VARS
          const float* xin = (hs == 0) ? p.in[0] : p.out;
          bf16_t* hn = (hs == 3) ? (bf16_t*)nullptr : HN;
          const float* nscale = second ? (const float*)(ws + WS_MOD) + (size_t)9 * 9216 + 1 * 1024 : mod + 4 * 1024;
          const int nslot = second ? 3 : (l == 0 ? 1 : 4);
          pg8::Gemm g{HB, (const bf16_t*)(wl + (second ? W_DN2 : W_DN1)), TX, DM, DFF, DFF}; pg8::StaticOrder S; S.init(TX, DM, G, bid);
          pg8::EpiResid E{xin, ZB, p.out, ZB, mod + (second ? 8 : 2) * 1024, 0.5f, hn, nscale, (float*)(ws + WS_ROWSS) + (size_t)nslot * TT};
          pg8::gemm_phase<pg8::EpiResid, pg8::StaticOrder, true, true>(lds, g, S, E); }
        if (hs_loop < 3) {
        { PHASE_VARS
          const int sl = bid & 3, koff = (sl == 0) ? 0 : (sl == 1) ? 768 : (sl == 2) ? 1408 : 2176, klen = (sl & 1) ? 640 : 768;
          pg8::Gemm g{HB + koff, (const bf16_t*)(wl + (second ? W_DN2 : W_DN1)) + koff, TT, DM, klen, DFF};
          pg8::OneUnit S{128 + (bid >> 4), (bid >> 2) & 3, bid < 128};
          pg8::EpiPart E{(float*)(ws + WS_TTR) + (size_t)sl * TZ * DM - (size_t)TX * DM};
          pg8::gemm_phase<pg8::EpiPart, pg8::OneUnit, false, true>(lds, g, S, E); }
        GRID_BAR();
        { PHASE_VARS
          const float* zin = (hs == 0) ? p.in[2] : ZB;
          const float* nscale = second ? (const float*)(ws + WS_MOD) + (size_t)9 * 9216 + 1 * 1024 : mod + 4 * 1024;
          const int nslot = second ? 3 : (l == 0 ? 1 : 4);
          z_finalize(ws, zin, mod + (size_t)8 * 9216 + (second ? 8 : 2) * 1024, HN + (size_t)TX * DM, nscale + (size_t)8 * 9216, (float*)(ws + WS_ROWSS) + (size_t)nslot * TT + TX, gw, NGW, lane); }
        }
        GRID_BAR(); STAMP(2);
        if (hs_loop & 1) continue;
        { PHASE_VARS
          pg8::Gemm g{HN, (const bf16_t*)(wl + W_IN), TT, DINP, DM, DM}; pg8::PrefOrder S; S.init(TT, DINP, G, bid);
          S.rowss = (const float*)(ws + WS_ROWSS) + (size_t)(l == 0 ? 1 : 4) * TT; S.sb = (const float*)(ws + WS_SB) + (size_t)l * SB_LAYER + SB_IN; S.sbN = DINP;
          pg8::EpiBf16 E{HB, DINP}; pg8::gemm_phase<pg8::EpiBf16, pg8::PrefOrder, true, true>(lds, g, S, E); }
        GRID_BAR(); STAMP(3);
        { PHASE_VARS
          for (int i = tid; i < 2048; i += 512) ((LAS float*)(lds + 65536))[i] = ((const float*)(ws + WS_TAB + T_ROPE))[i];
          __syncthreads();
          for (int t = bid; t < 544; t += G) prep_tile(p, l, t, lds, tid); }
        { PHASE_VARS
          const int n_busy = 544 - 2 * G;
          if (n_busy > 0 && n_busy < G) { if (bid >= n_busy) for (int u = (bid - n_busy) * 8 + wave; u < 8192; u += (G - n_busy) * 8) four1_unit(ws, u, lane); }
          else for (int u = gw; u < 8192; u += NGW) four1_unit(ws, u, lane); }
        GRID_BAR(); STAMP(4);
        for (int rep = 0; rep < REP_S3; ++rep) {
        { PHASE_VARS
          gla_scan(ws, gt, NT); }
        { PHASE_VARS
          const unsigned char* tab = ws + WS_TAB;
          for (int i = tid; i < 4 * 15 * 31; i += 512) ((LAS float*)lds)[i] = p.in[12][(size_t)l * 4 * 15 * 31 + i];
          __syncthreads();
          const int n_f2 = 2048, n_na = 2048, n_fz = lastl ? 0 : 512, n_naz = lastl ? 0 : 512;
          const int tot = n_f2 + n_na + n_fz + n_naz;
          for (int u = gw; u < tot; u += NGW) {
              if (u < n_na) { for (int rn = 0; rn < REP_NA; ++rn) na_row_unit(ws, (const LAS float*)lds, u, lane); }
              else if (u < n_na + n_f2) { for (int rf = 0; rf < REP_F2; ++rf) four2_row_unit(ws, u - n_na, lane); }
              else if (u < n_na + n_f2 + n_fz) { const int v = u - n_na - n_f2; const int qt = v & 3, mb = (v >> 2) & 3, bg = v >> 4;
                  const bf16_t* xr = HB + ((size_t)TX + (bg >> 2) * CTX) * DINP + C_FOUR + (bg & 3) * 64;
                  four2_unit<16, false>(xr, xr, DINP, (const bf16_t*)(tab + T_FC64), (const bf16_t*)(tab + T_FS64), (const bf16_t*)(tab + T_FSN64),
                                        (const bf16_t*)(tab + T_FC256), (const bf16_t*)(tab + T_FS256), HN + ((size_t)TX + (bg >> 2) * CTX) * DM + (bg & 3) * 64 + 16 * mb, (size_t)DM, 1.0f / 128.0f, mb, lane, 4 * qt, 4 * qt + 4); }
              else na_unit_z(ws, u - n_na - n_f2 - n_fz, lane);
          } }
        GRID_BAR(); STAMP(6); }
        for (int rep = 0; rep < REP_S4; ++rep) {
        { PHASE_VARS
          typedef attn_body::bf16 abf;
          const abf* HXb = (const abf*)HB; abf* MIXb = (abf*)HN;
          const int n_units = 512 + (lastl ? 0 : 32);
          for (int u = vbid; u < n_units; u += G) {
              const abf *Qu, *K0, *V0, *K1, *V1; abf* Ou; int NT0, NTt;
              if (u < 512) { const int b = u >> 6, h = (u >> 4) & 3, qb = u & 15, kvh = h >> 1;
                  Qu = HXb + ((size_t)b * SEQ + 256 * qb) * DINP + C_GQQ + h * 64;
                  K0 = HXb + (size_t)b * SEQ * DINP + C_GQK + kvh * 64; V0 = HXb + (size_t)b * SEQ * DINP + C_GQV + kvh * 64;
                  K1 = HXb + ((size_t)TX + b * CTX) * DINP + C_GQK + kvh * 64; V1 = HXb + ((size_t)TX + b * CTX) * DINP + C_GQV + kvh * 64;
                  NT0 = 64; NTt = 68; Ou = MIXb + ((size_t)b * SEQ + 256 * qb) * DM + 768 + h * 64; }
              else { const int v = u - 512, b = v >> 2, h = v & 3, kvh = h >> 1;
                  Qu = HXb + ((size_t)TX + b * CTX) * DINP + C_GQQ + h * 64;
                  K1 = HXb + ((size_t)TX + b * CTX) * DINP + C_GQK + kvh * 64; V1 = HXb + ((size_t)TX + b * CTX) * DINP + C_GQV + kvh * 64; K0 = K1; V0 = V1;
                  NT0 = 0; NTt = 4; Ou = MIXb + ((size_t)TX + b * CTX) * DM + 768 + h * 64; }
              attn_body::attn_unit<8>(Qu, K0, V0, K1, V1, NT0, NTt, Ou, (char*)lds_raw);
          } }
        { PHASE_VARS
          const int n_lat = 8 * 4 * 64, n_ctx = lastl ? 0 : 8 * 4 * 4 * 4;
          const int voff = (NGW > n_ctx) ? NGW - n_ctx : 0;
          for (int u = gw; u < n_lat; u += NGW) gla_chunk_unit(p, l, (u >> 6) * NCHUNK + (u & 63), lane);
          for (int v = gw - voff; v < n_ctx; v += NGW) if (v >= 0) { const int ib = v & 3, pcz = (v >> 2) & 3, bh = v >> 4; gla_out_unit(p, l, ((bh * NCHUNK + 64 + pcz) << 2) | ib, lane); } }
        GRID_BAR(); STAMP(7); }
        { PHASE_VARS
          const int Mo = lastl ? TX : TT; pg8::Gemm g{HN, (const bf16_t*)(wl + W_OUT), Mo, DM, DM, DM}; pg8::StaticOrder S; S.init(Mo, DM, G, bid);
          pg8::EpiResid E{p.out, ZB, p.out, ZB, mod + 5 * 1024, 1.0f, (bf16_t*)(ws + WS_NAVT), mod + 7 * 1024, (float*)(ws + WS_ROWSS) + (size_t)(l == 0 ? 2 : 5) * TT}; pg8::gemm_phase<pg8::EpiResid, pg8::StaticOrder, true, true>(lds, g, S, E); }
        GRID_BAR(); STAMP(3);
    }
#if DIAG_MODE
    if (blockIdx.x == 0) {
        const float ta = (float)t_cat[DIAG_A] * 0.01f, tb = (float)t_cat[DIAG_B] * 0.01f;
        if (threadIdx.x == 0) p.out[0] = 100.0f * ta;
        for (int i = threadIdx.x; i < (1 << 20); i += 512) p.out[1024 + i] = tb;
    }
#endif
}

extern "C" void kernel_launch(void* const* d_in, const int* in_sizes, int n_in, void* d_out, int out_size, void* d_ws, size_t ws_size, hipStream_t stream) {
    static int grid = 0;
    if (grid == 0) {
        int dev = 0, cus = 0, per_cu = 0;
        hipGetDevice(&dev);
        hipDeviceGetAttribute(&cus, hipDeviceAttributeMultiprocessorCount, dev);
        hipFuncSetAttribute((const void*)mega_fwd, hipFuncAttributeMaxDynamicSharedMemorySize, LDS_BYTES);
        hipOccupancyMaxActiveBlocksPerMultiprocessor(&per_cu, (const void*)mega_fwd, 512, LDS_BYTES);
        (void)hipGetLastError();
        if (per_cu < 1) per_cu = 1;
        if (per_cu > 1) per_cu = 1;
        grid = cus * per_cu;
        if (n_in != 24 || ws_size < WS_END) { fprintf(stderr, "kernel_launch: unexpected n_in %d / ws_size %zu (need %zu)\n", n_in, ws_size, (size_t)WS_END); }
    }
    (void)hipMemsetAsync((unsigned char*)d_ws + WS_BAR, 0, 16384, stream);
    Params p{};
    for (int i = 0; i < 24; ++i) p.in[i] = (const float*)d_in[i];
    p.out = (float*)d_out; p.ws = (unsigned char*)d_ws;
    void* args[] = {&p};
    hipError_t e = hipLaunchCooperativeKernel((const void*)mega_fwd, dim3(grid), dim3(512), args, LDS_BYTES, stream);
    if (e != hipSuccess) fprintf(stderr, "cooperative launch failed: %s (grid %d)\n", hipGetErrorString(e), grid);
}
```

```cpp
#include <hip/hip_runtime.h>
#include <hip/hip_cooperative_groups.h>
#include <cstdio>
#include <cstdint>
namespace cg = cooperative_groups;

namespace pg8 {
#define PG8_LAS __attribute__((address_space(3)))
typedef unsigned short bf16_t;
typedef short bf16x8 __attribute__((ext_vector_type(8)));
typedef float f32x4 __attribute__((ext_vector_type(4)));
typedef unsigned u32x4 __attribute__((ext_vector_type(4)));
constexpr int BM = 256, BK = 64, HALF = 128, HTB = HALF * BK * 2  , STAGE_BYTES = 8 * HTB, NXCD = 8, WGM = 8;

__host__ __device__ __forceinline__ int lds_byte(int r, int c) { const int st = (r >> 4) * 2 + (c >> 5), rr = r & 15, cc = c & 31, ob = rr * 64 + cc * 2; return st * 1024 + (ob ^ (((ob >> 9) & 1) << 5)); }
__host__ __device__ __forceinline__ void stage_rc(int b, int& R, int& C) { const int st = b / 1024, sb = b % 1024, swz = sb ^ (((sb >> 9) & 1) << 5); R = (st >> 1) * 16 + swz / 64; C = (st & 1) * 32 + (swz % 64) / 2; }
__host__ __device__ __forceinline__ int perm32(int rho) { const int n = rho >> 4, i = rho & 15; return 8 * (i >> 2) + 4 * n + (i & 3); }

struct Unit { int pm, pn, slot; };
struct Gemm { const bf16_t* A; const bf16_t* Bt; int M, N, K, ld; };

struct StaticOrder {
    int nM, nN, nwg, G, c;
    __host__ __device__ void init(int M, int N, int G_, int c_) { nM = M / BM; nN = N / BM; nwg = nM * nN; G = G_; c = c_; }
    __host__ __device__ bool next(int i, Unit& u) const {
        const long L = (long)i * G + c; if (L >= nwg) return false; u.slot = i & 1;
        int wgid = (int)L; { const int q = nwg / NXCD, r = nwg % NXCD, xcd = wgid % NXCD, off = wgid / NXCD; wgid = (xcd < r ? xcd * (q + 1) : r * (q + 1) + (xcd - r) * q) + off; }
        const int nig = WGM * nN, gid = wgid / nig, fm = gid * WGM, gsz = (nM - fm) < WGM ? (nM - fm) : WGM;
        u.pm = fm + ((wgid % nig) % gsz); u.pn = (wgid % nig) / gsz; return true;
    }
    __device__ __forceinline__ void a_ready(const Unit&) const {}
    __device__ __forceinline__ void done(const Unit&) const {}
};

__device__ __forceinline__ unsigned cvt_pk_bf16(float lo, float hi) {
    typedef float f32x2_t __attribute__((ext_vector_type(2))); typedef __bf16 bf16x2_t __attribute__((ext_vector_type(2)));
    f32x2_t v = {lo, hi}; bf16x2_t b = __builtin_convertvector(v, bf16x2_t); return __builtin_bit_cast(unsigned, b);
}
__device__ __forceinline__ float silu_f(float v) { return v * __builtin_amdgcn_rcpf(1.0f + __expf(-v)); }
constexpr int ROWS_X = 32768;
constexpr unsigned PREF_LDS_ADDR = 131072 + 1024;
#define PG8_PREF ((PG8_LAS float*)(size_t)PREF_LDS_ADDR)
__device__ __forceinline__ float fq_sum(float v) {
    v += __int_as_float(__builtin_amdgcn_ds_swizzle(__float_as_int(v), (16 << 10) | 0x1F));
    auto rr = __builtin_amdgcn_permlane32_swap(__float_as_uint(v), __float_as_uint(v), false, false); return __uint_as_float(rr[0]) + __uint_as_float(rr[1]); }
constexpr float NORM_EPS = 1e-6f;

struct EpiBf16 {
    static constexpr bool PERM = true, AFTER_DRAIN = false;
    bf16_t* O; int ldo;
    __device__ __forceinline__ void operator()(const f32x4 (&acc)[2][2][4][2], const Unit& u, int wr, int wc, int fr, int fq) const {
        const int row0 = u.pm * BM + wr * 64 + fr, col0 = u.pn * BM + wc * 32 + 8 * fq;
        const PG8_LAS float* ps = PG8_PREF + u.slot * 512;
        f32x4 sbv[2][2];
#pragma unroll
        for (int bj = 0; bj < 2; ++bj)
#pragma unroll
            for (int n = 0; n < 2; ++n) sbv[bj][n] = *(const PG8_LAS f32x4*)(ps + 256 + wc * 32 + 8 * fq + bj * HALF + 4 * n);
#pragma unroll
        for (int ai = 0; ai < 2; ++ai)
#pragma unroll
            for (int m = 0; m < 4; ++m) { bf16_t* rowp = O + (size_t)(row0 + ai * HALF + m * 16) * ldo + col0;
                const float rstd = rsqrtf(ps[wr * 64 + fr + ai * HALF + m * 16] * (1.0f / 1024.0f) + NORM_EPS);
#pragma unroll
                for (int bj = 0; bj < 2; ++bj) { const f32x4 v0 = acc[ai][bj][m][0] * rstd + sbv[bj][0], v1 = acc[ai][bj][m][1] * rstd + sbv[bj][1]; u32x4 w;
                    w.x = cvt_pk_bf16(v0[0], v0[1]); w.y = cvt_pk_bf16(v0[2], v0[3]); w.z = cvt_pk_bf16(v1[0], v1[1]); w.w = cvt_pk_bf16(v1[2], v1[3]);
                    *(u32x4*)(rowp + bj * HALF) = w; } }
    }
};
struct EpiSwiglu {
    static constexpr bool PERM = true, AFTER_DRAIN = false;
    bf16_t* O; int ldo;
    __device__ __forceinline__ void operator()(const f32x4 (&acc)[2][2][4][2], const Unit& u, int wr, int wc, int fr, int fq) const {
        const int row0 = u.pm * BM + wr * 64 + fr, col0 = u.pn * HALF + wc * 32 + 8 * fq;
        const PG8_LAS float* ps = PG8_PREF + u.slot * 512;
        f32x4 sbv[2][2];
#pragma unroll
        for (int bj = 0; bj < 2; ++bj)
#pragma unroll
            for (int n = 0; n < 2; ++n) sbv[bj][n] = *(const PG8_LAS f32x4*)(ps + 256 + bj * HALF + wc * 32 + 8 * fq + 4 * n);
#pragma unroll
        for (int ai = 0; ai < 2; ++ai)
#pragma unroll
            for (int m = 0; m < 4; ++m) { bf16_t* rowp = O + (size_t)(row0 + ai * HALF + m * 16) * ldo + col0;
                const float rstd = rsqrtf(ps[wr * 64 + fr + ai * HALF + m * 16] * (1.0f / 1024.0f) + NORM_EPS);
                const f32x4 g0 = acc[ai][0][m][0] * rstd + sbv[0][0], g1 = acc[ai][0][m][1] * rstd + sbv[0][1], u0 = acc[ai][1][m][0] * rstd + sbv[1][0], u1 = acc[ai][1][m][1] * rstd + sbv[1][1]; u32x4 w;
                w.x = cvt_pk_bf16(silu_f(g0[0]) * u0[0], silu_f(g0[1]) * u0[1]); w.y = cvt_pk_bf16(silu_f(g0[2]) * u0[2], silu_f(g0[3]) * u0[3]);
                w.z = cvt_pk_bf16(silu_f(g1[0]) * u1[0], silu_f(g1[1]) * u1[1]); w.w = cvt_pk_bf16(silu_f(g1[2]) * u1[2], silu_f(g1[3]) * u1[3]);
                *(u32x4*)rowp = w; }
    }
};
struct EpiResid {
    static constexpr bool PERM = false, AFTER_DRAIN = false;
    const float* inx; const float* inz; float* outx; float* outz; const float* gate;   float s;
    bf16_t* hn; const float* nscale; float* rowss;
    __device__ __forceinline__ void operator()(const f32x4 (&acc)[2][2][4][2], const Unit& u, int wr, int wc, int fr, int fq) const {
        const int trow = u.pm * BM; const bool isx = trow < ROWS_X; const int mi = isx ? (trow >> 12) : 8;
        const float* ib = isx ? inx + (size_t)trow * 1024 : inz + (size_t)(trow - ROWS_X) * 1024;
        float* ob = isx ? outx + (size_t)trow * 1024 : outz + (size_t)(trow - ROWS_X) * 1024;
        const int col0 = u.pn * BM + wc * 32 + 4 * fq; const float* gp = gate + (size_t)mi * 9216 + col0;
        f32x4 gv[2][2]; unsigned svp[2][2][2];
        const bool fuse = hn != nullptr;
#pragma unroll
        for (int bj = 0; bj < 2; ++bj)
#pragma unroll
            for (int n = 0; n < 2; ++n) { gv[bj][n] = *(const f32x4*)(gp + bj * HALF + n * 16) * s;
                const f32x4 svf = fuse ? *(const f32x4*)(nscale + (size_t)mi * 9216 + col0 + bj * HALF + n * 16) + 1.0f : (f32x4){1.f, 1.f, 1.f, 1.f};
                svp[bj][n][0] = cvt_pk_bf16(svf[0], svf[1]); svp[bj][n][1] = cvt_pk_bf16(svf[2], svf[3]); }
#pragma unroll
        for (int ch = 0; ch < 3; ++ch) {
            constexpr int NRG = 3;
            f32x4 pre[NRG][2][2];
#pragma unroll
            for (int k = 0; k < NRG; ++k) { const int rg = 3 * ch + k; if (rg < 8) { const int ai = rg >> 2, m = rg & 3;
#pragma unroll
                for (int bj = 0; bj < 2; ++bj)
#pragma unroll
                    for (int n = 0; n < 2; ++n) pre[k][bj][n] = *(const f32x4*)(ib + (unsigned)((ai * HALF + wr * 64 + m * 16 + fr) * 1024 + col0 + bj * HALF + n * 16)); } }
#pragma unroll
            for (int k = 0; k < NRG; ++k) { const int rg = 3 * ch + k; if (rg < 8) { const int ai = rg >> 2, m = rg & 3; const int rt = ai * HALF + wr * 64 + m * 16 + fr; const unsigned off = (unsigned)(rt * 1024 + col0); float ssq = 0.f;
#pragma unroll
                for (int bj = 0; bj < 2; ++bj)
#pragma unroll
                    for (int n = 0; n < 2; ++n) { const f32x4 bs = pre[k][bj][n];
                        const f32x4 xn = bs + gv[bj][n] * acc[ai][bj][m][n];
                        *(f32x4*)(ob + off + bj * HALF + n * 16) = xn;
                        if (fuse) { const unsigned p0 = svp[bj][n][0], p1 = svp[bj][n][1];
                            const f32x4 a = xn * (f32x4){__uint_as_float(p0 << 16), __uint_as_float(p0 & 0xffff0000u), __uint_as_float(p1 << 16), __uint_as_float(p1 & 0xffff0000u)}; typedef unsigned u32x2e __attribute__((ext_vector_type(2))); u32x2e w; w.x = cvt_pk_bf16(a[0], a[1]); w.y = cvt_pk_bf16(a[2], a[3]);
                            *(u32x2e*)(hn + (size_t)trow * 1024 + (off + bj * HALF + n * 16)) = w;
                            ssq += (xn[0] * xn[0] + xn[1] * xn[1]) + (xn[2] * xn[2] + xn[3] * xn[3]); } }
                if (fuse) { ssq = fq_sum(ssq); if (fq == 0) __hip_atomic_fetch_add(rowss + trow + rt, ssq, __ATOMIC_RELAXED, __HIP_MEMORY_SCOPE_AGENT); } } } }
    }
};

struct OneUnit {
    int pm, pn; bool have;
    __device__ __forceinline__ bool next(int i, Unit& u) const { if (i != 0 || !have) return false; u.pm = pm; u.pn = pn; u.slot = 0; return true; }
    __device__ __forceinline__ void a_ready(const Unit&) const {}
    __device__ __forceinline__ void done(const Unit&) const {}
};
struct EpiPart {
    static constexpr bool PERM = false, AFTER_DRAIN = false;
    float* P;
    __device__ __forceinline__ void operator()(const f32x4 (&acc)[2][2][4][2], const Unit& u, int wr, int wc, int fr, int fq) const {
        const int col0 = u.pn * BM + wc * 32 + 4 * fq;
#pragma unroll
        for (int ai = 0; ai < 2; ++ai)
#pragma unroll
            for (int m = 0; m < 4; ++m) { float* rp = P + (size_t)(u.pm * BM + ai * HALF + wr * 64 + m * 16 + fr) * 1024 + col0;
#pragma unroll
                for (int bj = 0; bj < 2; ++bj)
#pragma unroll
                    for (int n = 0; n < 2; ++n) *(f32x4*)(rp + bj * HALF + n * 16) = acc[ai][bj][m][n]; }
    }
};
struct PrefOrder : StaticOrder {
    const float* rowss; const float* sb; int sbN;
    __device__ __forceinline__ void a_ready(const Unit& u) const {
        const int wid = __builtin_amdgcn_readfirstlane((int)threadIdx.x >> 6); const unsigned voff = (threadIdx.x & 63u) * 16u;
        const int mi = (u.pm * BM < ROWS_X) ? ((u.pm * BM) >> 12) : 8;
        const float* src = (wid == 0) ? rowss + (size_t)u.pm * BM : sb + (size_t)mi * sbN + (size_t)u.pn * BM;
        const unsigned dst = PREF_LDS_ADDR + (unsigned)u.slot * 2048u + (wid == 0 ? 0u : 1024u);
        if (wid < 2) { unsigned keep; asm volatile("s_mov_b32 %0, m0\n\ts_mov_b32 m0, %2\n\ts_nop 0\n\tglobal_load_lds_dwordx4 %1, %3\n\ts_mov_b32 m0, %0" : "=&s"(keep) : "v"(voff), "s"(dst), "s"(src) : "memory"); }
    }
};
template <class Epi, class Sched, bool ALIGN_EPI = false, bool SP2 = false>
__device__ __forceinline__ void gemm_phase(PG8_LAS unsigned char* lds, const Gemm g, const Sched& S, const Epi& E) {
    int tid = threadIdx.x; asm volatile("" : "+v"(tid)); const int wid = __builtin_amdgcn_readfirstlane(tid >> 6), lane = tid & 63, wr = wid >> 2, wc = wid & 3, fr = lane & 15, fq = lane >> 4;
    const int K = g.K, nt = K / BK, LD = g.ld;
    unsigned voffA[2], voffB[2];
#pragma unroll
    for (int i = 0; i < 2; ++i) { int R, C; stage_rc(tid * 16 + i * 8192, R, C); const int Rb = Epi::PERM ? ((R & ~31) + perm32(R & 31)) : R;
        voffA[i] = (unsigned)(R * LD + C) * 2u; voffB[i] = (unsigned)(Rb * LD + C) * 2u; }
    const size_t kstep = (size_t)(BK * 2);
    const size_t hstep = (size_t)HALF * LD * 2;
    const size_t tstep = 2 * hstep;
    const unsigned ldsw = (unsigned)wid * 1024u;
    const int aoff = lds_byte(wr * 64 + fr, fq * 8), boff = lds_byte(wc * 32 + fr, fq * 8);
#define PG8_SA(b, h) (((b) * 2 + (h)) * HTB)
#define PG8_SB(b, h) ((4 + (b) * 2 + (h)) * HTB)
#define PG8_STAGE(bufoff, gbase, voff) do { _Pragma("unroll") for (int _i = 0; _i < 2; ++_i) \
        __builtin_amdgcn_global_load_lds((const unsigned*)((const char*)(gbase) + (voff)[_i]), (PG8_LAS unsigned*)(lds + (bufoff) + ldsw + _i * 8192), 16, 0, 0); } while (0)
#define PG8_LDA(dst, b, h) do { _Pragma("unroll") for (int m = 0; m < 4; ++m) _Pragma("unroll") for (int k = 0; k < 2; ++k) dst[m][k] = *(const PG8_LAS bf16x8*)(lds + PG8_SA(b, h) + aoff + m * 2048 + k * 1024); } while (0)
#define PG8_LDB(dst, b, h) do { _Pragma("unroll") for (int n = 0; n < 2; ++n) _Pragma("unroll") for (int k = 0; k < 2; ++k) dst[n][k] = *(const PG8_LAS bf16x8*)(lds + PG8_SB(b, h) + boff + n * 2048 + k * 1024); } while (0)
#define PG8_MMA(ai, bj, At, Bt) do { __builtin_amdgcn_s_setprio(1); _Pragma("unroll") for (int m = 0; m < 4; ++m) _Pragma("unroll") for (int n = 0; n < 2; ++n) _Pragma("unroll") for (int k = 0; k < 2; ++k) \
        acc[ai][bj][m][n] = __builtin_amdgcn_mfma_f32_16x16x32_bf16(Bt[n][k], At[m][k], acc[ai][bj][m][n], 0, 0, 0); __builtin_amdgcn_s_setprio(0); } while (0)
#define PG8_WAIT_V(n) asm volatile("s_waitcnt vmcnt(" #n ")" ::: "memory")
#define PG8_WAIT_L(n) asm volatile("s_waitcnt lgkmcnt(" #n ")" ::: "memory")
#define PG8_BAR __builtin_amdgcn_s_barrier()
#define PG8_SCHED __builtin_amdgcn_sched_barrier(0)
    Unit cur, nxt; int ui = 0;
    if (!S.next(0, cur)) return;
    f32x4 acc[2][2][4][2];
#pragma unroll
    for (int a = 0; a < 2; ++a)
#pragma unroll
        for (int b = 0; b < 2; ++b)
#pragma unroll
            for (int m = 0; m < 4; ++m)
#pragma unroll
                for (int n = 0; n < 2; ++n) acc[a][b][m][n] = (f32x4){0.f, 0.f, 0.f, 0.f};
    bf16x8 At[4][2], B0[2][2], B1[2][2];
    const char* cA = (const char*)g.A + (size_t)cur.pm * tstep; const char* cB = (const char*)g.Bt + (size_t)cur.pn * tstep;
    S.a_ready(cur);
    if constexpr (SP2) {
        PG8_STAGE(PG8_SB(0, 0), cB, voffB); PG8_STAGE(PG8_SB(0, 1), cB + hstep, voffB); PG8_STAGE(PG8_SA(0, 0), cA, voffA); PG8_STAGE(PG8_SA(0, 1), cA + hstep, voffA);
        if (wr == 1) PG8_BAR;
        PG8_WAIT_V(2); PG8_BAR;
        PG8_STAGE(PG8_SB(1, 0), cB + kstep, voffB); PG8_STAGE(PG8_SA(1, 0), cA + kstep, voffA); PG8_STAGE(PG8_SB(1, 1), cB + hstep + kstep, voffB);
        PG8_WAIT_V(6); PG8_BAR;
    } else {
        PG8_STAGE(PG8_SB(0, 0), cB, voffB); PG8_STAGE(PG8_SA(0, 0), cA, voffA); PG8_STAGE(PG8_SB(0, 1), cB + hstep, voffB); PG8_STAGE(PG8_SA(0, 1), cA + hstep, voffA);
        if (wr == 1) PG8_BAR;
        PG8_WAIT_V(4); PG8_BAR;
        PG8_STAGE(PG8_SB(1, 0), cB + kstep, voffB); PG8_STAGE(PG8_SA(1, 0), cA + kstep, voffA); PG8_STAGE(PG8_SB(1, 1), cB + hstep + kstep, voffB);
        PG8_WAIT_V(6); PG8_BAR;
    }
    for (;;) {
        const bool has_next = S.next(ui + 1, nxt);
        const char* nA = has_next ? (const char*)g.A + (size_t)nxt.pm * tstep : cA; const char* nB = has_next ? (const char*)g.Bt + (size_t)nxt.pn * tstep : cB;
        for (int t = 0; t < nt; t += 2) {
            const bool last = (t == nt - 2);
            const char* a1 = cA + (size_t)(t + 1) * kstep;
            const char* a2 = last ? nA : cA + (size_t)(t + 2) * kstep; const char* b2 = last ? nB : cB + (size_t)(t + 2) * kstep;
            const char* a3 = a2 + kstep; const char* b3 = b2 + kstep;
            if (last && has_next) S.a_ready(nxt);
            if constexpr (SP2) {
            PG8_LDB(B0, 0, 0); PG8_LDB(B1, 0, 1); PG8_SCHED; PG8_LDA(At, 0, 0); PG8_STAGE(PG8_SA(1, 1), a1 + hstep, voffA);
            PG8_WAIT_V(8); PG8_WAIT_L(0); PG8_BAR; PG8_MMA(0, 0, At, B0); PG8_MMA(0, 1, At, B1); PG8_BAR; PG8_SCHED;
            PG8_LDA(At, 0, 1); PG8_STAGE(PG8_SB(0, 0), b2, voffB); PG8_STAGE(PG8_SB(0, 1), b2 + hstep, voffB); PG8_STAGE(PG8_SA(0, 0), a2, voffA);
            PG8_WAIT_V(8); PG8_WAIT_L(0); PG8_BAR; PG8_MMA(1, 0, At, B0); PG8_MMA(1, 1, At, B1); PG8_BAR; PG8_SCHED;
            PG8_LDB(B0, 1, 0); PG8_LDB(B1, 1, 1); PG8_SCHED; PG8_LDA(At, 1, 0); PG8_STAGE(PG8_SA(0, 1), a2 + hstep, voffA);
            PG8_WAIT_V(8); PG8_WAIT_L(0); PG8_BAR; PG8_MMA(0, 0, At, B0); PG8_MMA(0, 1, At, B1); PG8_BAR; PG8_SCHED;
            PG8_LDA(At, 1, 1); PG8_STAGE(PG8_SB(1, 0), b3, voffB); PG8_STAGE(PG8_SB(1, 1), b3 + hstep, voffB); PG8_STAGE(PG8_SA(1, 0), a3, voffA);
            PG8_WAIT_V(8); PG8_WAIT_L(0); PG8_BAR; PG8_MMA(1, 0, At, B0); PG8_MMA(1, 1, At, B1); PG8_BAR; PG8_SCHED;
            } else {
            PG8_LDB(B0, 0, 0); PG8_SCHED; PG8_LDA(At, 0, 0); PG8_STAGE(PG8_SA(1, 1), a1 + hstep, voffA);
            PG8_WAIT_L(8); PG8_BAR; PG8_WAIT_L(0); PG8_MMA(0, 0, At, B0); PG8_BAR; PG8_SCHED;
            PG8_LDB(B1, 0, 1); PG8_STAGE(PG8_SB(0, 0), b2, voffB);
            PG8_BAR; PG8_WAIT_L(0); PG8_MMA(0, 1, At, B1); PG8_BAR;
            PG8_LDA(At, 0, 1); PG8_STAGE(PG8_SA(0, 0), a2, voffA);
            PG8_BAR; PG8_WAIT_L(0); PG8_MMA(1, 0, At, B0); PG8_BAR; PG8_SCHED;
            PG8_STAGE(PG8_SB(0, 1), b2 + hstep, voffB);
            PG8_WAIT_V(6); PG8_BAR; PG8_MMA(1, 1, At, B1); PG8_BAR;
            PG8_LDB(B0, 1, 0); PG8_SCHED; PG8_LDA(At, 1, 0); PG8_STAGE(PG8_SA(0, 1), a2 + hstep, voffA);
            PG8_WAIT_L(8); PG8_BAR; PG8_WAIT_L(0); PG8_MMA(0, 0, At, B0); PG8_BAR; PG8_SCHED;
            PG8_LDB(B1, 1, 1); PG8_STAGE(PG8_SB(1, 0), b3, voffB);
            PG8_BAR; PG8_WAIT_L(0); PG8_MMA(0, 1, At, B1); PG8_BAR;
            PG8_LDA(At, 1, 1); PG8_STAGE(PG8_SA(1, 0), a3, voffA);
            PG8_BAR; PG8_WAIT_L(0); PG8_MMA(1, 0, At, B0); PG8_BAR; PG8_SCHED;
            PG8_STAGE(PG8_SB(1, 1), b3 + hstep, voffB);
            PG8_WAIT_V(6); PG8_BAR; PG8_MMA(1, 1, At, B1); PG8_BAR;
            }
        }
        if constexpr (ALIGN_EPI) { if (wr == 0) PG8_BAR; }
        if constexpr (!Epi::AFTER_DRAIN) { E(acc, cur, wr, wc, fr, fq); S.done(cur); }
        if (!has_next) break;
#pragma unroll
        for (int a = 0; a < 2; ++a)
#pragma unroll
            for (int b = 0; b < 2; ++b)
#pragma unroll
                for (int m = 0; m < 4; ++m)
#pragma unroll
                    for (int n = 0; n < 2; ++n) acc[a][b][m][n] = (f32x4){0.f, 0.f, 0.f, 0.f};
        cur = nxt; cA = nA; cB = nB; ++ui;
        if constexpr (ALIGN_EPI) { if (wr == 1) PG8_BAR; }
    }
    PG8_WAIT_V(0);
    if constexpr (!ALIGN_EPI) { if (wr == 0) PG8_BAR; }
    PG8_BAR;
    if constexpr (Epi::AFTER_DRAIN) { E.fused(acc, cur, wr, wc, fr, fq, lds, wid, lane); S.done(cur); }
#undef PG8_SA
#undef PG8_SB
#undef PG8_STAGE
#undef PG8_LDA
#undef PG8_LDB
#undef PG8_MMA
#undef PG8_WAIT_V
#undef PG8_WAIT_L
#undef PG8_BAR
#undef PG8_SCHED
}
}
#include <hip/hip_bf16.h>
#include <cmath>
namespace attn_body {
using bf16=__hip_bfloat16;
using bf16x8=__attribute__((ext_vector_type(8)))short;
using s16x4=__attribute__((ext_vector_type(4)))short;
using f32x16=__attribute__((ext_vector_type(16)))float;
using u32x4=__attribute__((ext_vector_type(4)))unsigned;
constexpr int D=64,QP=2560,KP=2560,OP=1024;
constexpr int NW=8,QBLK=32,QB=QBLK*NW,KVBLK=64;
__device__ __forceinline__ int crow(int r,int hi){return (r&3)+8*(r>>2)+4*hi;}
#define SBAR() __builtin_amdgcn_sched_barrier(0)
__device__ __forceinline__ void cmask(f32x16&p0,f32x16&p1,int jb,int qrel,int hi){
  const float NEG=-INFINITY; int kb=64*jb+4*hi;
  #pragma unroll
  for(int r=0;r<16;++r){int kv=kb+(r&3)+8*(r>>2); if(kv>qrel)p0[r]=NEG; if(kv+32>qrel)p1[r]=NEG;}
}

constexpr int NSLOT=3, SLOTB=8192;
constexpr int LDS_K=0, LDS_V=NSLOT*SLOTB, LDS_WS=2*NSLOT*SLOTB, LDS_OST=LDS_WS+NW*64*4, LDS_BYTES=LDS_OST+NW*4096;
constexpr float C2=0.125f*1.4426950408889634f;
__device__ __forceinline__ void glds16(const void*gbase,unsigned voff,unsigned lds_dst){unsigned keep;
  asm volatile("s_mov_b32 %0, m0\n\ts_mov_b32 m0, %2\n\ts_nop 0\n\tglobal_load_lds_dwordx4 %1, %3\n\ts_mov_b32 m0, %0":"=&s"(keep):"v"(voff),"s"(lds_dst),"s"(gbase):"memory");}
__device__ __forceinline__ float max3f(float a,float b,float c){float r;asm("v_max3_f32 %0, %1, %2, %3":"=v"(r):"v"(a),"v"(b),"v"(c));return r;}
__device__ __forceinline__ float max2f(float a,float b){float r;asm("v_max_f32_e32 %0, %1, %2":"=v"(r):"v"(a),"v"(b));return r;}
__device__ __forceinline__ float fadd_s(float a,float b){float r;asm("v_add_f32_e32 %0, %1, %2":"=v"(r):"v"(a),"v"(b));return r;}
__device__ __forceinline__ float fsub_s(float a,float b){float r;asm("v_sub_f32_e32 %0, %1, %2":"=v"(r):"v"(a),"v"(b));return r;}
typedef float f32x2_t __attribute__((ext_vector_type(2))); typedef __bf16 bf16x2_t __attribute__((ext_vector_type(2)));
__device__ __forceinline__ unsigned cvtpk_s(float lo,float hi){f32x2_t v={lo,hi};bf16x2_t b=__builtin_convertvector(v,bf16x2_t);return __builtin_bit_cast(unsigned,b);}
#define WAIT_BAR(N) asm volatile("s_waitcnt vmcnt(" #N ") lgkmcnt(0)\n\ts_barrier":::"memory")

__device__ __forceinline__ void qkt(f32x16&p0,f32x16&p1,const char*Kslot,const bf16x8*qr,const f32x16&negm,int r32,int hi){
  const char*kb=Kslot+hi*1024+r32*16;
  #pragma unroll
  for(int d0=0;d0<4;++d0){
    const bf16x8 b0=*reinterpret_cast<const bf16x8*>(kb+d0*2048);
    const bf16x8 b1=*reinterpret_cast<const bf16x8*>(kb+d0*2048+512);
    if(d0==0){p0=__builtin_amdgcn_mfma_f32_32x32x16_bf16(b0,qr[0],negm,0,0,0);p1=__builtin_amdgcn_mfma_f32_32x32x16_bf16(b1,qr[0],negm,0,0,0);}
    else{p0=__builtin_amdgcn_mfma_f32_32x32x16_bf16(b0,qr[d0],p0,0,0,0);p1=__builtin_amdgcn_mfma_f32_32x32x16_bf16(b1,qr[d0],p1,0,0,0);}}
}
typedef __attribute__((address_space(3))) const char* lds_cptr;
typedef short v4i16_t __attribute__((ext_vector_type(4)));
__device__ __forceinline__ void kload8(bf16x8*kf,lds_cptr kp){
  kf[0]=*(const __attribute__((address_space(3))) bf16x8*)(kp);      kf[1]=*(const __attribute__((address_space(3))) bf16x8*)(kp+512);
  kf[2]=*(const __attribute__((address_space(3))) bf16x8*)(kp+2048); kf[3]=*(const __attribute__((address_space(3))) bf16x8*)(kp+2560);
  kf[4]=*(const __attribute__((address_space(3))) bf16x8*)(kp+4096); kf[5]=*(const __attribute__((address_space(3))) bf16x8*)(kp+4608);
  kf[6]=*(const __attribute__((address_space(3))) bf16x8*)(kp+6144); kf[7]=*(const __attribute__((address_space(3))) bf16x8*)(kp+6656);
}
__device__ __forceinline__ void kload2(bf16x8*kf,lds_cptr kp,int j){ kf[2*j]=*(const __attribute__((address_space(3))) bf16x8*)(kp+j*2048); kf[2*j+1]=*(const __attribute__((address_space(3))) bf16x8*)(kp+j*2048+512); }
__device__ __forceinline__ s16x4 vtr(lds_cptr p){ return __builtin_bit_cast(s16x4,__builtin_amdgcn_ds_read_tr16_b64_v4i16((__attribute__((address_space(3))) v4i16_t*)p)); }
__device__ __forceinline__ float rowmax(const f32x16&p0,const f32x16&p1){
  float a=max3f(p0[0],p0[1],p1[0]),b=max3f(p0[2],p0[3],p1[1]);a=max3f(a,p1[2],p1[3]);
  #pragma unroll
  for(int r=4;r<16;r+=4){a=max3f(a,p0[r],p0[r+1]);b=max3f(b,p0[r+2],p0[r+3]);a=max3f(a,p1[r],p1[r+1]);b=max3f(b,p1[r+2],p1[r+3]);}
  const float m=max2f(a,b);
  auto rr=__builtin_amdgcn_permlane32_swap(__float_as_uint(m),__float_as_uint(m),false,false);
  return max2f(__uint_as_float(rr[0]),__uint_as_float(rr[1]));
}
__device__ __forceinline__ void pv(f32x16*o,int vb,bf16x8 pa0,bf16x8 pa1,bf16x8 pa2,bf16x8 pa3){
  #pragma unroll
  for(int d0=0;d0<2;++d0){s16x4 lo[4],hi[4];
    #pragma unroll
    for(int ks=0;ks<4;++ks){
      asm volatile("ds_read_b64_tr_b16 %0,%1 offset:%c2":"=&v"(lo[ks]):"v"(vb),"i"(d0*4096+ks*1024):"memory");
      asm volatile("ds_read_b64_tr_b16 %0,%1 offset:%c2":"=&v"(hi[ks]):"v"(vb),"i"(d0*4096+ks*1024+512):"memory");}
    asm volatile("s_waitcnt lgkmcnt(0)":::"memory");SBAR();
    #define PK(k) (bf16x8){lo[k][0],lo[k][1],lo[k][2],lo[k][3],hi[k][0],hi[k][1],hi[k][2],hi[k][3]}
    o[d0]=__builtin_amdgcn_mfma_f32_32x32x16_bf16(pa0,PK(0),o[d0],0,0,0);
    o[d0]=__builtin_amdgcn_mfma_f32_32x32x16_bf16(pa1,PK(1),o[d0],0,0,0);
    o[d0]=__builtin_amdgcn_mfma_f32_32x32x16_bf16(pa2,PK(2),o[d0],0,0,0);
    o[d0]=__builtin_amdgcn_mfma_f32_32x32x16_bf16(pa3,PK(3),o[d0],0,0,0);
    #undef PK
  }
}

#ifndef ATTN_STORE16
#define ATTN_STORE16(p,v) (*(u32x4*)(p)=(v))
#endif
template<int THRL> __device__ __forceinline__ void attn_unit(const bf16*Qu,const bf16*__restrict__ K0,const bf16*__restrict__ V0,const bf16*__restrict__ K1,const bf16*__restrict__ V1,int NT0,int NT,bf16*Ou,char*shm){
  int tid=threadIdx.x; asm volatile("":"+v"(tid)); const int lane=tid&63,r32=lane&31,hi=lane>>5; const int wid=__builtin_amdgcn_readfirstlane(tid>>6);
  const bf16*Qw=Qu+(long)(wid*QBLK)*QP;
  const unsigned lds0=(unsigned)(uintptr_t)shm;
  float*wsf=(float*)(shm+LDS_WS)+wid*64;
  const unsigned koff=(unsigned)(lane*KP+wid*8)*2u;
  const unsigned voff=(unsigned)((16*(wid&3)+(lane>>2))*KP+(wid>>2)*32+(lane&3)*8)*2u;
  const unsigned kdst=lds0+LDS_K+wid*1024, vdst=lds0+LDS_V+wid*1024;
  #define DMA_K(t,slot) glds16(((t)<NT0?K0+(long)(t)*KVBLK*KP:K1+(long)((t)-NT0)*KVBLK*KP),koff,(unsigned)__builtin_amdgcn_readfirstlane(kdst+(slot)))
  #define DMA_V(t,slot) glds16(((t)<NT0?V0+(long)(t)*KVBLK*KP:V1+(long)((t)-NT0)*KVBLK*KP),voff,(unsigned)__builtin_amdgcn_readfirstlane(vdst+(slot)))
  const int vb0=(int)(lds0+LDS_V)+((lane>>4)&1)*32+(lane&3)*8+(4*hi+((lane&15)>>2))*64;
  const char*Kbase=shm+LDS_K; bf16x8 kf[8];
  const lds_cptr shm3=(lds_cptr)shm; const lds_cptr kp0=shm3+LDS_K+hi*1024+r32*16; const lds_cptr vp0=shm3+LDS_V+((lane>>4)&1)*32+(lane&3)*8+(4*hi+((lane&15)>>2))*64;
  DMA_K(0,0);DMA_V(0,0);DMA_K(1,SLOTB);
  bf16x8 qr[4];
  #pragma unroll
  for(int d0=0;d0<4;++d0)qr[d0]=*reinterpret_cast<const bf16x8*>(&Qw[(long)r32*QP+d0*16+hi*8]);
  float mhat=0.f,l_reg=0.f;f32x16 o[2];o[0]=f32x16{};o[1]=f32x16{};
  #define CMASK(P0,P1,t) do{}while(0)
  bool resc=false;
  #define START(P0,P1) do{ const float rm=rowmax(P0,P1); resc=false; \
    { const float dl=rm; mhat=fadd_s(mhat,dl); \
      _Pragma("unroll") for(int r=0;r<16;++r){P0[r]=fsub_s(P0[r],dl);P1[r]=fsub_s(P1[r],dl);} \
 } \
    _Pragma("unroll") for(int r=0;r<16;++r)P0[r]=__builtin_amdgcn_exp2f(P0[r]); }while(0)
  #define RESC() do{ if(resc){ asm volatile("s_waitcnt lgkmcnt(0)":::"memory"); \
      _Pragma("unroll") for(int d_=0;d_<2;++d_) _Pragma("unroll") for(int r=0;r<16;++r)o[d_][r]*=wsf[crow(r,hi)]; } }while(0)
  f32x16 pA0,pA1,pB0,pB1;
  int sl_prev=0,sl_cur=0,sl_next=SLOTB;
  #define ROT() do{sl_prev=sl_cur;sl_cur=sl_next;sl_next=(sl_next==(NSLOT-1)*SLOTB)?0:sl_next+SLOTB;}while(0)
  DMA_K(2,2*SLOTB);
  WAIT_BAR(3);
  qkt(pA0,pA1,Kbase,qr,f32x16{},r32,hi);asm volatile("s_nop 15\n\ts_nop 7":"+v"(pA0),"+v"(pA1));CMASK(pA0,pA1,0);
  START(pA0,pA1);
  _Pragma("unroll") for(int r=0;r<16;++r)pA1[r]=__builtin_amdgcn_exp2f(pA1[r]);
  WAIT_BAR(0);
  DMA_K(3,0);DMA_V(1,SLOTB);
  ROT();
  kload8(kf,kp0+sl_cur);
  WAIT_BAR(2);
  s16x4 vlo[8],vhi[8]; u32x4 pw0,pw1,pw2,pw3;
  #define PKW(P,B) cvtpk_s(P[B],P[B+1])
  #define PAF(k) __builtin_bit_cast(bf16x8,pw##k)
  #define VFR(i) (bf16x8){vlo[i][0],vlo[i][1],vlo[i][2],vlo[i][3],vhi[i][0],vhi[i][1],vhi[i][2],vhi[i][3]}
  #define PIN(x) asm volatile("":"+v"(x))
  #define MX3(a,b,c) __builtin_fmaxf(__builtin_fmaxf((a),(b)),(c))
  #define GAPA(MF,A0,A1,A2,A3,W0,W1,PW) do{ MF; sacc+=A0; sacc+=A1; sacc+=A2; sacc+=A3; PIN(sacc); W0; W1; PIN(PW); SBAR(); }while(0)
  #define EX(v) __builtin_amdgcn_exp2f(v)
  #define GAPB(MF,X,B) do{ MF; X[B]=EX(X[B]); X[B+1]=EX(X[B+1]); X[B+2]=EX(X[B+2]); X[B+3]=EX(X[B+3]); PIN(X); SBAR(); }while(0)
  #define VRD(i) do{ vlo[i]=vtr(vp_+(((i)>>2)*4096+((i)&3)*1024)); vhi[i]=vtr(vp_+(((i)>>2)*4096+((i)&3)*1024+512)); }while(0)
  #define KRD(G,j) do{ if(G){ kload2(kf,kp0+sl_next,j); SBAR(); } }while(0)
  #define STEP(C0,C1,P0,P1,t,GK,GV,GL) do{ SBAR(); \
    const lds_cptr vp_=vp0+sl_prev; \
    VRD(0); SBAR(); float sacc=(P0[0]+P0[1]); \
    GAPA(C0=__builtin_amdgcn_mfma_f32_32x32x16_bf16(kf[0],qr[0],f32x16{},0,0,0), P0[2],P0[3],P0[4],P0[5],     pw0[0]=PKW(P0,0), pw0[1]=PKW(P0,2), pw0); \
    VRD(4); SBAR(); GAPA(C1=__builtin_amdgcn_mfma_f32_32x32x16_bf16(kf[1],qr[0],f32x16{},0,0,0), P0[6],P0[7],P0[8],P0[9],     pw0[2]=PKW(P0,4), pw0[3]=PKW(P0,6), pw0); \
    VRD(1); SBAR(); GAPA(C0=__builtin_amdgcn_mfma_f32_32x32x16_bf16(kf[2],qr[1],C0,0,0,0),   P0[10],P0[11],P0[12],P0[13], pw1[0]=PKW(P0,8), pw1[1]=PKW(P0,10), pw1); \
    VRD(5); SBAR(); GAPA(C1=__builtin_amdgcn_mfma_f32_32x32x16_bf16(kf[3],qr[1],C1,0,0,0),   P0[14],P0[15],P1[0],P1[1],   pw1[2]=PKW(P0,12),pw1[3]=PKW(P0,14), pw1); \
    VRD(2); SBAR(); GAPA(C0=__builtin_amdgcn_mfma_f32_32x32x16_bf16(kf[4],qr[2],C0,0,0,0),   P1[2],P1[3],P1[4],P1[5],     pw2[0]=PKW(P1,0), pw2[1]=PKW(P1,2), pw2); \
    VRD(6); SBAR(); GAPA(C1=__builtin_amdgcn_mfma_f32_32x32x16_bf16(kf[5],qr[2],C1,0,0,0),   P1[6],P1[7],P1[8],P1[9],     pw2[2]=PKW(P1,4), pw2[3]=PKW(P1,6), pw2); \
    VRD(3); SBAR(); GAPA(C0=__builtin_amdgcn_mfma_f32_32x32x16_bf16(kf[6],qr[3],C0,0,0,0),   P1[10],P1[11],P1[12],P1[13], pw3[0]=PKW(P1,8), pw3[1]=PKW(P1,10), pw3); \
    VRD(7); SBAR(); GAPA(C1=__builtin_amdgcn_mfma_f32_32x32x16_bf16(kf[7],qr[3],C1,0,0,0),   P1[14],P1[15],0.f,0.f,       pw3[2]=PKW(P1,12),pw3[3]=PKW(P1,14), pw3); \
    l_reg+=sacc; \
    if(GK){DMA_K((t)+3,sl_cur);} if(GV){DMA_V((t)+1,sl_next);} \
    _Pragma("unroll") for(int r=0;r<16;++r){C0[r]-=mhat;C1[r]-=mhat;} \
    { float a=MX3(C0[0],C0[1],C1[0]),b=MX3(C0[2],C0[3],C1[1]); a=MX3(a,C1[2],C1[3]); \
      _Pragma("unroll") for(int r=4;r<16;r+=4){a=MX3(a,C0[r],C0[r+1]);b=MX3(b,C0[r+2],C0[r+3]);a=MX3(a,C1[r],C1[r+1]);b=MX3(b,C1[r+2],C1[r+3]);} \
      float rm=__builtin_fmaxf(a,b); { auto rr=__builtin_amdgcn_permlane32_swap(__float_as_uint(rm),__float_as_uint(rm),false,false); rm=__builtin_fmaxf(__uint_as_float(rr[0]),__uint_as_float(rr[1])); } \
      resc=false; \
      if(__builtin_expect(__any(rm>(float)THRL),0)){ const float dl=__builtin_fmaxf(rm,0.f); mhat+=dl; \
        _Pragma("unroll") for(int r=0;r<16;++r){C0[r]-=dl;C1[r]-=dl;} \
        const float f=__builtin_amdgcn_exp2f(-dl); l_reg*=f; if(hi==0)wsf[r32]=f; resc=true; } } \
    SBAR(); \
    GAPB(o[0]=__builtin_amdgcn_mfma_f32_32x32x16_bf16(PAF(0),VFR(0),o[0],0,0,0), C0,0); \
    GAPB(o[1]=__builtin_amdgcn_mfma_f32_32x32x16_bf16(PAF(0),VFR(4),o[1],0,0,0), C0,4); \
    KRD(GL,0); GAPB(o[0]=__builtin_amdgcn_mfma_f32_32x32x16_bf16(PAF(1),VFR(1),o[0],0,0,0), C0,8); \
    KRD(GL,1); GAPB(o[1]=__builtin_amdgcn_mfma_f32_32x32x16_bf16(PAF(1),VFR(5),o[1],0,0,0), C0,12); \
    KRD(GL,2); GAPB(o[0]=__builtin_amdgcn_mfma_f32_32x32x16_bf16(PAF(2),VFR(2),o[0],0,0,0), C1,0); \
    KRD(GL,3); GAPB(o[1]=__builtin_amdgcn_mfma_f32_32x32x16_bf16(PAF(2),VFR(6),o[1],0,0,0), C1,4); \
    GAPB(o[0]=__builtin_amdgcn_mfma_f32_32x32x16_bf16(PAF(3),VFR(3),o[0],0,0,0), C1,8); \
    GAPB(o[1]=__builtin_amdgcn_mfma_f32_32x32x16_bf16(PAF(3),VFR(7),o[1],0,0,0), C1,12); \
    }while(0)
  int t=1;
  #undef CMASK
  #define CMASK(P0,P1,t) do{}while(0)
  for(;t+5<NT;t+=2){
    STEP(pB0,pB1,pA0,pA1,t,true,true,true);     WAIT_BAR(2); RESC(); ROT();
    STEP(pA0,pA1,pB0,pB1,t+1,true,true,true);   WAIT_BAR(2); RESC(); ROT();
  }
  #undef CMASK
  #define CMASK(P0,P1,t) do{}while(0)
  #define ENDW(tt) do{ if((tt)+3<NT){WAIT_BAR(2);} else if((tt)+2<NT){WAIT_BAR(1);} else {WAIT_BAR(0);} }while(0)
  for(;t+1<NT;t+=2){
    STEP(pB0,pB1,pA0,pA1,t,(t+3<NT),(t+1<NT),(t+1<NT));       ENDW(t);   RESC(); ROT();
    STEP(pA0,pA1,pB0,pB1,t+1,(t+4<NT),(t+2<NT),(t+2<NT));     ENDW(t+1); RESC(); ROT();
  }
  STEP(pB0,pB1,pA0,pA1,NT-1,false,false,false); RESC();
  { float sacc=pB0[0]+pB0[1]; _Pragma("unroll") for(int r=2;r<16;++r)sacc+=pB0[r]; _Pragma("unroll") for(int r=0;r<16;++r)sacc+=pB1[r]; l_reg+=sacc;
    pw0=(u32x4){PKW(pB0,0),PKW(pB0,2),PKW(pB0,4),PKW(pB0,6)};pw1=(u32x4){PKW(pB0,8),PKW(pB0,10),PKW(pB0,12),PKW(pB0,14)};pw2=(u32x4){PKW(pB1,0),PKW(pB1,2),PKW(pB1,4),PKW(pB1,6)};pw3=(u32x4){PKW(pB1,8),PKW(pB1,10),PKW(pB1,12),PKW(pB1,14)};
    SBAR(); pv(o,vb0+sl_cur,PAF(0),PAF(1),PAF(2),PAF(3)); }
  #undef PKW
  #undef PAF
  #undef VFR
  #undef PIN
  #undef MX3
  #undef GAPA
  #undef GAPB
  #undef EX
  #undef VRD
  #undef KRD
  #undef STEP
  #undef ENDW
  {auto rr=__builtin_amdgcn_permlane32_swap(__float_as_uint(l_reg),__float_as_uint(l_reg),false,false);l_reg=__uint_as_float(rr[0])+__uint_as_float(rr[1]);}
  if(hi==0)wsf[32+r32]=l_reg;asm volatile("s_waitcnt lgkmcnt(0)":::"memory");
  float rli[16];
  #pragma unroll
  for(int r=0;r<16;++r)rli[r]=__builtin_amdgcn_rcpf(wsf[32+crow(r,hi)]);
  bf16*Ow=Ou+(long)(wid*QBLK)*OP;
  { bf16*stg=(bf16*)(shm+LDS_OST)+wid*2048;
    #pragma unroll
    for(int r=0;r<16;++r){const int orow=crow(r,hi);
      #pragma unroll
      for(int d0=0;d0<2;++d0)stg[orow*64+d0*32+r32]=__float2bfloat16(o[d0][r]*rli[r]);}
    asm volatile("s_waitcnt lgkmcnt(0)":::"memory");
    #pragma unroll
    for(int i=0;i<4;++i){const int row=i*8+(lane>>3),ch=lane&7; const u32x4 v=*(const u32x4*)(stg+row*64+ch*8); ATTN_STORE16(Ow+(long)row*OP+ch*8,v);} }
  asm volatile("s_waitcnt lgkmcnt(0)\n\ts_barrier":::"memory");
  #undef DMA_K
  #undef DMA_V
  #undef CMASK
  #undef START
  #undef RESC
  #undef ROT
}
constexpr int ATTN_LDS_BYTES=LDS_BYTES;
#undef SBAR
#undef WAIT_BAR
}
#define DI __device__ __forceinline__
#define LAS __attribute__((address_space(3)))
typedef unsigned short bf16_t;
typedef short bf16x8 __attribute__((ext_vector_type(8)));
typedef float f32x4 __attribute__((ext_vector_type(4)));
typedef unsigned u32x4 __attribute__((ext_vector_type(4)));
typedef unsigned u32x2 __attribute__((ext_vector_type(2)));
typedef unsigned long long u64;
typedef unsigned long long u64x2 __attribute__((ext_vector_type(2)));

constexpr int NB = 8, SEQ = 4096, DM = 1024, CTX = 256, DFF = 2816, DIN = 2336, DINP = 2560, KSEQ = 4352, NCHUNK = 68;
constexpr int TX = NB * SEQ, TZ = NB * CTX, TT = TX + TZ;
constexpr float EPS = 1e-6f;
constexpr float QSCALE = 0.125f * 1.4426950408889634f;
constexpr float LOG2E = 1.4426950408889634f;
constexpr int C_FOUR = 0, C_NAQ = 256, C_NAK = 512, C_NAV = 768, C_GLQ = 1024, C_GLK = 1152, C_GLV = 1280, C_GLR = 1536, C_GF = 1792, C_GB = 1808, C_GQQ = 1824, C_GQK = 2080, C_GQV = 2208;
constexpr int C_GLQB = 768, C_GLKB = 896;

constexpr size_t MiB = 1u << 20;
constexpr size_t WS_W = 0;
constexpr size_t W_UP1 = 0, W_DN1 = 11 * MiB, W_IN = W_DN1 + 5 * MiB + MiB / 2, W_OUT = W_IN + 5 * MiB, W_UP2 = W_OUT + 2 * MiB, W_DN2 = W_UP2 + 11 * MiB, W_LAYER = 40 * MiB;
constexpr size_t WS_MOD = 80 * MiB;
constexpr size_t WS_TAB = 81 * MiB;
constexpr size_t T_FC64 = 0, T_FS64 = 8192, T_FSN64 = 16384, T_TW = 32768, T_ROPE = 65536, T_FC256 = 131072, T_FS256 = 262144, T_FSN256 = 393216;
constexpr size_t WS_Z = 82 * MiB;
constexpr size_t WS_HN = 90 * MiB;
constexpr size_t WS_HB = 158 * MiB;
constexpr size_t WS_NAVT = 345 * MiB;
constexpr size_t WS_GVT = WS_NAVT + 17 * MiB;
constexpr size_t WS_GLVT = WS_GVT + 9 * MiB;
constexpr size_t WS_KKT = WS_GLVT + 17 * MiB;
constexpr size_t WS_SLOC = WS_KKT + 17 * MiB;
constexpr size_t WS_SST = WS_SLOC + 34 * MiB;
constexpr size_t WS_TTR = WS_SST + 17 * MiB;
constexpr size_t WS_TTI = WS_TTR + 16 * MiB;
constexpr size_t WS_BLAST = WS_TTI + 16 * MiB;
constexpr size_t WS_ROWSS = WS_BLAST + 1 * MiB;
constexpr size_t WS_SB = WS_ROWSS + 1 * MiB;
constexpr int SB_UP1 = 0, SB_IN = 9 * 5632, SB_UP2 = 9 * (5632 + 2560), SB_LAYER = 9 * (5632 + 2560 + 5632);
constexpr size_t WS_BAR = WS_SB + 2 * MiB;
constexpr size_t WS_END = WS_BAR + 1 * MiB;
constexpr int LDS_PREF = 131072 + 1024; static_assert(LDS_PREF == (int)pg8::PREF_LDS_ADDR, "prefetch slots");
constexpr int LDS_BARST = 131072 + 256;
static_assert(WS_END <= 512 * MiB, "workspace map");
static_assert(WS_HB + (size_t)TT * DFF * 2 <= WS_NAVT && WS_HN + (size_t)TT * DM * 2 <= WS_HB, "workspace map 2");
constexpr int LDS_BYTES = 147456;
#ifndef REP_NA
#define REP_NA 1
#endif
#ifndef REP_F2
#define REP_F2 1
#endif
#ifndef REP_SYNC
#define REP_SYNC 0
#endif
#ifndef REP_PRO
#define REP_PRO 1
#endif
#ifndef REP_S2
#define REP_S2 1
#endif
#ifndef REP_S3
#define REP_S3 1
#endif
#ifndef REP_S4
#define REP_S4 1
#endif
#ifndef REP_UP
#define REP_UP 1
#endif
#ifndef REP_NORM
#define REP_NORM 1
#endif
#ifndef DIAG_MODE
#define DIAG_MODE 0
#endif
#ifndef DIAG_A
#define DIAG_A 2
#define DIAG_B 7
#endif

struct Params { const float* in[24]; float* out; unsigned char* ws; };
#define XB_TMO      128
#define XB_XCNT(j)  (256  + 64 * (j))
#define XB_XSUB(j)  (1280 + 64 * (j))
#define XB_XGEN(j)  (2304 + 64 * (j))
#define XB_TOP      3328
#define XB_TOPGEN   3392
#define XCD_BAR_WORDS 3456
#define XB_SPIN_CAP (1u << 18)

__device__ __forceinline__ unsigned xb_ld(unsigned* p)              { return __hip_atomic_load(p, __ATOMIC_RELAXED, __HIP_MEMORY_SCOPE_AGENT); }
__device__ __forceinline__ unsigned xb_add(unsigned* p, unsigned v) { return __hip_atomic_fetch_add(p, v, __ATOMIC_RELAXED, __HIP_MEMORY_SCOPE_AGENT); }
__device__ __forceinline__ unsigned xb_xcc_id() { return (unsigned)__builtin_amdgcn_s_getreg((3 << 11) | 20) & 0xFu; }
#define XB_SPIN(cond, bar) do { unsigned _sp = 0; while (cond) { __builtin_amdgcn_s_sleep(1); \
    if ((++_sp & 255u) == 0u) { if (xb_ld(&(bar)[XB_TMO])) break; if (_sp > XB_SPIN_CAP) { atomicAdd(&(bar)[XB_TMO], 1u); break; } } } } while (0)

struct XcdBarrier {
    unsigned* bar; unsigned x;
    volatile LAS unsigned* st;
};

__device__ __forceinline__ XcdBarrier xcd_barrier_post(unsigned* bar, volatile LAS unsigned* st) {
    XcdBarrier b; b.bar = bar; b.x = xb_xcc_id(); b.st = st;
    if (threadIdx.x == 0) (void)xb_add(&bar[XB_XCNT(b.x)], 1u);
    return b;
}
__device__ __forceinline__ void xcd_barrier_complete(unsigned* bar, unsigned x, unsigned& nloc, unsigned& nx) {
    const unsigned G = gridDim.x * gridDim.y * gridDim.z;
    unsigned sum, cnt, mine, sp = 0u;
    for (;;) {
        sum = 0u; cnt = 0u; mine = 0u;
#pragma unroll
        for (unsigned j = 0; j < 16; ++j) { const unsigned c = xb_ld(&bar[XB_XCNT(j)]); sum += c; cnt += (c > 0u) ? 1u : 0u; mine = (j == x) ? c : mine; }
        if (sum == G) break;
        __builtin_amdgcn_s_sleep(1);
        if ((++sp & 255u) == 0u) { if (xb_ld(&bar[XB_TMO])) break; if (sp > XB_SPIN_CAP) { atomicAdd(&bar[XB_TMO], 1u); break; } }
    }
    nloc = mine > 0u ? mine : 1u; nx = cnt > 0u ? cnt : 1u;
}

__device__ __forceinline__ void xcd_barrier(const XcdBarrier& b) {
    asm volatile("s_waitcnt vmcnt(0)" ::: "memory");
    __syncthreads();
    if (threadIdx.x == 0) {
        unsigned* bar = b.bar;
        __builtin_amdgcn_s_waitcnt(0);
        unsigned nloc = b.st[0], nx = b.st[1];
        if (nloc == 0u) { xcd_barrier_complete(bar, b.x, nloc, nx); b.st[0] = nloc; b.st[1] = nx; }
        const unsigned old = xb_add(&bar[XB_XSUB(b.x)], 1u);
        const unsigned gen = old / nloc;
        if (old + 1u == (gen + 1u) * nloc) {
            __builtin_amdgcn_fence(__ATOMIC_RELEASE, "agent");
            asm volatile("s_waitcnt vmcnt(0)" ::: "memory");
            const unsigned og = xb_add(&bar[XB_TOP], 1u);
            const unsigned tg = og / nx;
            if (og + 1u == (tg + 1u) * nx) xb_add(&bar[XB_TOPGEN], 1u);
            else XB_SPIN(xb_ld(&bar[XB_TOPGEN]) == tg, bar);
            __builtin_amdgcn_fence(__ATOMIC_ACQUIRE, "agent");
            xb_add(&bar[XB_XGEN(b.x)], 1u);
            asm volatile("s_waitcnt vmcnt(0)" ::: "memory");
        } else {
            XB_SPIN(xb_ld(&bar[XB_XGEN(b.x)]) == gen, bar);
            __builtin_amdgcn_fence(__ATOMIC_ACQUIRE, "agent");
            asm volatile("s_waitcnt vmcnt(0)" ::: "memory");
        }
    }
    __syncthreads();
}
__device__ __attribute__((noinline)) void grid_bar_fn(unsigned* bar, unsigned st_addr) { XcdBarrier xb_; xb_.bar = bar; xb_.x = xb_xcc_id(); xb_.st = (volatile LAS unsigned*)(size_t)st_addr; xcd_barrier(xb_); }

DI float bf2f(bf16_t h) { return __uint_as_float(((unsigned)h) << 16); }
DI unsigned pk2(float lo, float hi) { return pg8::cvt_pk_bf16(lo, hi); }
DI bf16_t f2bf(float f) { return (bf16_t)(pk2(f, 0.f) & 0xffffu); }
DI bf16x8 ld16(const bf16_t* p) { return *(const bf16x8*)p; }
DI u64 ld8(const bf16_t* p) { return *(const u64*)p; }
DI bf16x8 cat8(u64 a, u64 b) { u64x2 v = {a, b}; return __builtin_bit_cast(bf16x8, v); }
DI bf16x8 pack8(const f32x4& a, const f32x4& b) { u32x4 w; w.x = pk2(a[0], a[1]); w.y = pk2(a[2], a[3]); w.z = pk2(b[0], b[1]); w.w = pk2(b[2], b[3]); return __builtin_bit_cast(bf16x8, w); }
DI bf16x8 neg8(bf16x8 v) { u32x4 w = __builtin_bit_cast(u32x4, v); w ^= 0x80008000u; return __builtin_bit_cast(bf16x8, w); }
#define MFMA16(a, b, c) __builtin_amdgcn_mfma_f32_16x16x32_bf16((a), (b), (c), 0, 0, 0)
template <int M> DI float swz_xor(float v) { return __int_as_float(__builtin_amdgcn_ds_swizzle(__float_as_int(v), (M << 10) | 0x1F)); }
DI float half_sum(float v) { auto rr = __builtin_amdgcn_permlane32_swap(__float_as_uint(v), __float_as_uint(v), false, false); return __uint_as_float(rr[0]) + __uint_as_float(rr[1]); }
DI float half_max(float v) { auto rr = __builtin_amdgcn_permlane32_swap(__float_as_uint(v), __float_as_uint(v), false, false); return fmaxf(__uint_as_float(rr[0]), __uint_as_float(rr[1])); }
DI float quad_sum(float v) { v += swz_xor<16>(v); return half_sum(v); }
DI float quad_max(float v) { v = fmaxf(v, swz_xor<16>(v)); return half_max(v); }

DI void transpose_item(const float* W, int K, int N, bf16_t* WT, int mode, LAS float* scr, int item, int lane) {
    const int nblk = N / 32, kb = item / nblk, nb = item % nblk, k0 = 64 * kb, n0 = 32 * nb;
    { const int kr = lane >> 3, nq = lane & 7;
      f32x4 wv[8];
#pragma unroll
      for (int i = 0; i < 8; ++i) wv[i] = *(const f32x4*)(W + (size_t)(k0 + 8 * i + kr) * N + n0 + 4 * nq);
#pragma unroll
      for (int i = 0; i < 8; ++i) { LAS float* d = scr + (8 * i + kr) * 33 + 4 * nq; d[0] = wv[i][0]; d[1] = wv[i][1]; d[2] = wv[i][2]; d[3] = wv[i][3]; } }
    asm volatile("s_waitcnt lgkmcnt(0)" ::: "memory");
    const int c = lane & 7;
    const int d0 = (mode == 0) ? n0 : ((n0 >> 7) * 256 + (n0 & 127) + (mode == 2 ? 128 : 0));
#pragma unroll
    for (int j = 0; j < 4; ++j) { const int n = (lane >> 3) + 8 * j; const LAS float* s = scr + (8 * c) * 33 + n;
        u32x4 o; o.x = pk2(s[0 * 33], s[1 * 33]); o.y = pk2(s[2 * 33], s[3 * 33]); o.z = pk2(s[4 * 33], s[5 * 33]); o.w = pk2(s[6 * 33], s[7 * 33]);
        *(u32x4*)(WT + (size_t)(d0 + n) * K + k0 + 8 * c) = o; }
    asm volatile("s_waitcnt lgkmcnt(0)" ::: "memory");
}

template <bool FIRST> DI void phase_prologue(const Params& p, LAS unsigned char* lds, int tid, int lane, int wave, int bid, int G, int l_lo, int l_hi) {
    constexpr bool first = FIRST;
    const int gw = bid * 8 + wave, NGW = G * 8;
    unsigned char* ws = p.ws;
    {
        LAS float* scr = (LAS float*)(lds + wave * 8704);
        constexpr int I_UP = 16 * 88, I_DN = 44 * 32, I_IN = 16 * 73, I_OUT = 16 * 32;
        constexpr int PER_L = 4 * I_UP + 2 * I_DN + I_IN + I_OUT;
        for (int it = gw; it < (l_hi - l_lo) * PER_L; it += NGW) {
            const int l = l_lo + it / PER_L; int r = it % PER_L;
            bf16_t* wl = (bf16_t*)(ws + WS_W + (size_t)l * W_LAYER);
            if (r < I_UP) { transpose_item(p.in[6] + (size_t)l * DM * DFF, DM, DFF, (bf16_t*)((unsigned char*)wl + W_UP1), 1, scr, r, lane); continue; } r -= I_UP;
            if (r < I_UP) { transpose_item(p.in[7] + (size_t)l * DM * DFF, DM, DFF, (bf16_t*)((unsigned char*)wl + W_UP1), 2, scr, r, lane); continue; } r -= I_UP;
            if (r < I_DN) { transpose_item(p.in[8] + (size_t)l * DM * DFF, DFF, DM, (bf16_t*)((unsigned char*)wl + W_DN1), 0, scr, r, lane); continue; } r -= I_DN;
            if (r < I_IN) { transpose_item(p.in[9] + (size_t)l * DM * DIN, DM, DIN, (bf16_t*)((unsigned char*)wl + W_IN), 0, scr, r, lane); continue; } r -= I_IN;
            if (r < I_OUT) { transpose_item(p.in[20] + (size_t)l * DM * DM, DM, DM, (bf16_t*)((unsigned char*)wl + W_OUT), 0, scr, r, lane); continue; } r -= I_OUT;
            if (r < I_UP) { transpose_item(p.in[21] + (size_t)l * DM * DFF, DM, DFF, (bf16_t*)((unsigned char*)wl + W_UP2), 1, scr, r, lane); continue; } r -= I_UP;
            if (r < I_UP) { transpose_item(p.in[22] + (size_t)l * DM * DFF, DM, DFF, (bf16_t*)((unsigned char*)wl + W_UP2), 2, scr, r, lane); continue; } r -= I_UP;
            transpose_item(p.in[23] + (size_t)l * DM * DFF, DFF, DM, (bf16_t*)((unsigned char*)wl + W_DN2), 0, scr, r, lane);
        }
        const int gt = bid * 512 + tid, NT = G * 512;
        for (int i = gt; i < (l_hi - l_lo) * (DINP - DIN) * DM / 8; i += NT) { const int l = l_lo + i / ((DINP - DIN) * DM / 8), r = i % ((DINP - DIN) * DM / 8);
            *(u32x4*)((bf16_t*)(ws + WS_W + (size_t)l * W_LAYER + W_IN) + (size_t)DIN * DM + (size_t)r * 8) = (u32x4){0u, 0u, 0u, 0u}; }
        if (first) {
        for (int i = gt; i < 5 * TT; i += NT) ((float*)(ws + WS_ROWSS))[TT + i] = 0.f;
        unsigned char* tab = ws + WS_TAB;
        for (int i = gt; i < 4096; i += NT) { const int a = i >> 6, b = i & 63; const float x = (float)((a * b) & 63) * (1.0f / 32.0f);
            const float c = cospif(x), s = sinpif(x);
            ((bf16_t*)(tab + T_FC64))[i] = f2bf(c); ((bf16_t*)(tab + T_FS64))[i] = f2bf(s); ((bf16_t*)(tab + T_FSN64))[i] = f2bf(-s);
            const float y = (float)(a * b) * (1.0f / 2048.0f);
            ((float*)(tab + T_TW))[2 * i] = cospif(y); ((float*)(tab + T_TW))[2 * i + 1] = sinpif(y); }
        for (int i = gt; i < 65536; i += NT) { const int a = i >> 8, b = i & 255; const float x = (float)((a * b) & 255) * (1.0f / 128.0f);
            const float c = cospif(x), s = sinpif(x);
            ((bf16_t*)(tab + T_FC256))[i] = f2bf(c); ((bf16_t*)(tab + T_FS256))[i] = f2bf(s); ((bf16_t*)(tab + T_FSN256))[i] = f2bf(-s); }
        for (int i = gt; i < 1024; i += NT) { const int pp = i >> 4, f = i & 15; const float inv = powf(10000.0f, -(float)f / 16.0f); const float ang = (float)pp * inv;
            ((float*)(tab + T_ROPE))[2 * i] = cosf(ang); ((float*)(tab + T_ROPE))[2 * i + 1] = sinf(ang); }
        }
    }
    if (!FIRST) return;
    __syncthreads();
    {
        LAS float* S = (LAS float*)lds;
        LAS float* red = (LAS float*)(lds + 9 * 1024 * 4);
        for (int i = tid; i < 9 * 1024; i += 512) { const int r = i >> 10, k = i & 1023; const float v = (r < 8) ? p.in[1][r * 1024 + k] : p.in[3][k]; S[i] = v / (1.0f + __expf(-v)); }
        __syncthreads();
        for (int it = bid; it < 2 * 144; it += G) {
            const int l = it / 144, nb = it % 144, n = nb * 64 + lane;
            const float* W = p.in[4] + (size_t)l * DM * 9216 + n;
            float acc[9];
#pragma unroll
            for (int r = 0; r < 9; ++r) acc[r] = 0.f;
            const int kbeg = wave * 128;
#pragma unroll 8
            for (int k = 0; k < 128; ++k) { const float w = W[(size_t)(kbeg + k) * 9216];
#pragma unroll
                for (int r = 0; r < 9; ++r) acc[r] += S[r * 1024 + kbeg + k] * w; }
#pragma unroll
            for (int r = 0; r < 9; ++r) red[(wave * 9 + r) * 64 + lane] = acc[r];
            __syncthreads();
            for (int i = tid; i < 9 * 64; i += 512) { const int r = i >> 6, c = i & 63; float s = 0.f;
#pragma unroll
                for (int w = 0; w < 8; ++w) s += red[(w * 9 + r) * 64 + c];
                const int nn = nb * 64 + c;
                ((float*)(ws + WS_MOD))[((size_t)l * 9 + r) * 9216 + nn] = s + p.in[5][(size_t)l * 9216 + nn]; }
            __syncthreads();
        }
    }
}

DI void scale_pass(const float* xx, const float* xz, const float* mod  , int iscale, bf16_t* HN, float* rowss, int nrows, int gw, int NGW, int lane) {
    for (int row = gw; row < nrows; row += NGW) {
        const bool isx = row < TX; const int mi = isx ? (row >> 12) : 8;
        const float* src = isx ? xx + (size_t)row * DM : xz + (size_t)(row - TX) * DM;
        const float* sc = mod + (size_t)mi * 9216 + iscale * 1024;
        f32x4 v[4]; float ss = 0.f;
#pragma unroll
        for (int j = 0; j < 4; ++j) { v[j] = *(const f32x4*)(src + 4 * lane + 256 * j); ss += (v[j][0] * v[j][0] + v[j][1] * v[j][1]) + (v[j][2] * v[j][2] + v[j][3] * v[j][3]); }
        ss += swz_xor<1>(ss); ss += swz_xor<2>(ss); ss += swz_xor<4>(ss); ss += swz_xor<8>(ss); ss += swz_xor<16>(ss); ss = half_sum(ss);
        if (lane == 0) rowss[row] = ss;
#pragma unroll
        for (int j = 0; j < 4; ++j) { const f32x4 a = *(const f32x4*)(sc + 4 * lane + 256 * j);
            const f32x4 y = v[j] * (a + 1.0f); u32x2 w; w.x = pk2(y[0], y[1]); w.y = pk2(y[2], y[3]);
            *(u32x2*)(HN + (size_t)row * DM + 4 * lane + 256 * j) = w; }
    }
}
DI void shift_bias_pass(unsigned char* ws, int gw, int NGW, int lane, int l, int n_lo, int n_hi) {
    for (int it = n_lo + gw; it < n_hi; it += NGW) {
        int n = it; int g, N; size_t woff, sboff;
        if (n < 5632) { g = 0; N = 5632; woff = W_UP1; sboff = SB_UP1; } else if (n < 5632 + 2560) { g = 1; N = 2560; n -= 5632; woff = W_IN; sboff = SB_IN; } else { g = 2; N = 5632; n -= 5632 + 2560; woff = W_UP2; sboff = SB_UP2; }
        const bf16_t* wrow = (const bf16_t*)(ws + WS_W + (size_t)l * W_LAYER + woff) + (size_t)n * DM + 16 * lane;
        const bf16x8 w0 = ld16(wrow), w1 = ld16(wrow + 8);
        float wf[16];
#pragma unroll
        for (int j = 0; j < 8; ++j) { wf[j] = bf2f((bf16_t)w0[j]); wf[8 + j] = bf2f((bf16_t)w1[j]); }
        const float* modl = (const float*)(ws + WS_MOD) + (size_t)l * 9 * 9216 + (3 * g) * 1024 + 16 * lane;
        float* sb = (float*)(ws + WS_SB) + (size_t)l * SB_LAYER + sboff;
#pragma unroll
        for (int mi = 0; mi < 9; ++mi) { float s = 0.f;
#pragma unroll
            for (int j4 = 0; j4 < 4; ++j4) { const f32x4 sh = *(const f32x4*)(modl + (size_t)mi * 9216 + 4 * j4); s += (sh[0] * wf[4 * j4] + sh[1] * wf[4 * j4 + 1]) + (sh[2] * wf[4 * j4 + 2] + sh[3] * wf[4 * j4 + 3]); }
            s += swz_xor<1>(s); s += swz_xor<2>(s); s += swz_xor<4>(s); s += swz_xor<8>(s); s += swz_xor<16>(s); s = half_sum(s);
            if (lane == 0) sb[(size_t)mi * N + n] = s; }
    }
}

DI void norm_pass(const float* xx, const float* xz, const float* mod  , int ishift, int iscale, bf16_t* HN, int nrows, int gw, int NGW, int lane) {
    for (int row = gw; row < nrows; row += NGW) {
        const bool isx = row < TX; const int mi = isx ? (row >> 12) : 8;
        const float* src = isx ? xx + (size_t)row * DM : xz + (size_t)(row - TX) * DM;
        const float* sh = mod + (size_t)mi * 9216 + ishift * 1024; const float* sc = mod + (size_t)mi * 9216 + iscale * 1024;
        f32x4 v[4]; float ss = 0.f;
#pragma unroll
        for (int j = 0; j < 4; ++j) { v[j] = *(const f32x4*)(src + 4 * lane + 256 * j); ss += (v[j][0] * v[j][0] + v[j][1] * v[j][1]) + (v[j][2] * v[j][2] + v[j][3] * v[j][3]); }
        ss += swz_xor<1>(ss); ss += swz_xor<2>(ss); ss += swz_xor<4>(ss); ss += swz_xor<8>(ss); ss += swz_xor<16>(ss); ss = half_sum(ss);
        const float rstd = rsqrtf(ss * (1.0f / DM) + EPS);
#pragma unroll
        for (int j = 0; j < 4; ++j) { const f32x4 a = *(const f32x4*)(sc + 4 * lane + 256 * j), b = *(const f32x4*)(sh + 4 * lane + 256 * j);
            const f32x4 y = v[j] * rstd * (a + 1.0f) + b; u32x2 w; w.x = pk2(y[0], y[1]); w.y = pk2(y[2], y[3]);
            *(u32x2*)(HN + (size_t)row * DM + 4 * lane + 256 * j) = w; }
    }
}

DI void shift_bias_mfma(unsigned char* ws, int gw, int NGW, int lane) {
    const int c16 = lane & 15, quad = lane >> 4;
    constexpr int NBLK = (5632 + 2560 + 5632) / 16;
    for (int it = gw; it < 2 * NBLK; it += NGW) {
        const int l = it / NBLK; int n0 = (it % NBLK) * 16; int g, N; size_t woff, sboff;
        if (n0 < 5632) { g = 0; N = 5632; woff = W_UP1; sboff = SB_UP1; } else if (n0 < 5632 + 2560) { g = 1; N = 2560; n0 -= 5632; woff = W_IN; sboff = SB_IN; } else { g = 2; N = 5632; n0 -= 5632 + 2560; woff = W_UP2; sboff = SB_UP2; }
        const bf16_t* wrow = (const bf16_t*)(ws + WS_W + (size_t)l * W_LAYER + woff) + (size_t)(n0 + c16) * DM + quad * 8;
        const float* shp = (const float*)(ws + WS_MOD) + (size_t)l * 9 * 9216 + (3 * g) * 1024 + (size_t)min(c16, 8) * 9216 + quad * 8;
        f32x4 acc = {0.f, 0.f, 0.f, 0.f};
#pragma unroll 8
        for (int ks = 0; ks < 32; ++ks) { const bf16x8 a = ld16(wrow + 32 * ks); const f32x4 s0 = *(const f32x4*)(shp + 32 * ks), s1 = *(const f32x4*)(shp + 32 * ks + 4);
            bf16x8 b = pack8(s0, s1); if (c16 >= 9) b = (bf16x8){0, 0, 0, 0, 0, 0, 0, 0};
            acc = MFMA16(a, b, acc); }
        if (c16 < 9) *(f32x4*)((float*)(ws + WS_SB) + (size_t)l * SB_LAYER + sboff + (size_t)c16 * N + n0 + quad * 4) = acc;
    }
}
DI void z_finalize(unsigned char* ws, const float* zin, const float* gate8  , bf16_t* hnz  , const float* nscale8, float* rowssz, int gw, int NGW, int lane) {
    const float* part = (const float*)(ws + WS_TTR);
    float* ZB = (float*)(ws + WS_Z);
    for (int r = gw; r < TZ; r += NGW) {
        float ss = 0.f;
#pragma unroll
        for (int j = 0; j < 4; ++j) { const size_t o = (size_t)r * DM + 4 * lane + 256 * j;
            f32x4 a = *(const f32x4*)(part + o);
#pragma unroll
            for (int s = 1; s < 4; ++s) a += *(const f32x4*)(part + (size_t)s * TZ * DM + o);
            const f32x4 g = *(const f32x4*)(gate8 + 4 * lane + 256 * j), zi = *(const f32x4*)(zin + o);
            const f32x4 zn = zi + g * 0.5f * a;
            *(f32x4*)(ZB + o) = zn;
            if (hnz) { const f32x4 sc = *(const f32x4*)(nscale8 + 4 * lane + 256 * j) + 1.0f; const f32x4 y = zn * sc; u32x2 w; w.x = pk2(y[0], y[1]); w.y = pk2(y[2], y[3]); *(u32x2*)(hnz + o) = w;
                ss += (zn[0] * zn[0] + zn[1] * zn[1]) + (zn[2] * zn[2] + zn[3] * zn[3]); } }
        if (hnz) { ss += swz_xor<1>(ss); ss += swz_xor<2>(ss); ss += swz_xor<4>(ss); ss += swz_xor<8>(ss); ss += swz_xor<16>(ss); ss = half_sum(ss); if (lane == 0) rowssz[r] = ss; }
    }
}

DI float log_sigmoid(float x) { return fminf(x, 0.f) - __logf(1.0f + __expf(-fabsf(x))); }

template <bool ROPE> DI void prep_vec(u32x2 raw, bf16_t* ptr, const float* gain, float scale, bool rp, int li, int gr, int t, const LAS float* ropeL) {
    float x[4] = {__uint_as_float(raw.x << 16), __uint_as_float(raw.x & 0xffff0000u), __uint_as_float(raw.y << 16), __uint_as_float(raw.y & 0xffff0000u)};
    float ss = (x[0] * x[0] + x[1] * x[1]) + (x[2] * x[2] + x[3] * x[3]);
    ss += swz_xor<1>(ss); ss += swz_xor<2>(ss); ss += swz_xor<4>(ss); ss += swz_xor<8>(ss);
    const float rstd = rsqrtf(ss * (1.0f / 64.0f) + EPS);
    const f32x4 g = *(const f32x4*)(gain + 4 * li);
    float o[4];
#pragma unroll
    for (int j = 0; j < 4; ++j) { const float y = x[j] * rstd * g[j];
        if (ROPE) { const float partner = swz_xor<8>(y);
            const int d = 4 * li + j, i = d & 31; const int pp = (i < 16) ? gr : t, f = i & 15;
            const float cs = ropeL[2 * (pp * 16 + f)], sn = ropeL[2 * (pp * 16 + f) + 1];
            const float rot = (li < 8) ? (y * cs - partner * sn) : (partner * sn + y * cs);
            o[j] = (rp ? rot : y) * scale; }
        else o[j] = y * scale; }
    u32x2 w; w.x = pk2(o[0], o[1]); w.y = pk2(o[2], o[3]);
    *(u32x2*)ptr = w;
}

DI void gla_local_unit(unsigned char* ws, int u, int lane);
DI void prep_tile(const Params& p, int l, int tile, LAS unsigned char* lds, int tid) {
    unsigned char* ws = p.ws;
    bf16_t* HX = (bf16_t*)(ws + WS_HB);
    int b, row0, pos0, gr; bool isx;
    if (tile < 512) { b = tile >> 6; gr = tile & 63; row0 = b * SEQ + 64 * gr; pos0 = 64 * gr; isx = true; }
    else { const int tz = tile - 512; b = tz >> 2; gr = tz & 3; row0 = TX + b * CTX + 64 * gr; pos0 = SEQ + 64 * gr; isx = false; }
    const LAS float* ropeL = (const LAS float*)(lds + 65536);
    {
        const int li = tid & 15, jg = tid >> 4;
#pragma unroll
        for (int hb = 0; hb < 2; ++hb) {
            const int t = hb * 32 + jg;
            bf16_t* rowp = HX + (size_t)(row0 + t) * DINP + 4 * li;
            u32x2 raw[14];
#pragma unroll
            for (int v = 0; v < 14; ++v) { const int col = (v < 4) ? C_NAQ + 64 * v : (v < 8) ? C_NAK + 64 * (v - 4) : (v < 12) ? C_GQQ + 64 * (v - 8) : C_GQK + 64 * (v - 12);
                raw[v] = *(const u32x2*)(rowp + col); }
#pragma unroll
            for (int v = 0; v < 14; ++v) { const int col = (v < 4) ? C_NAQ + 64 * v : (v < 8) ? C_NAK + 64 * (v - 4) : (v < 12) ? C_GQQ + 64 * (v - 8) : C_GQK + 64 * (v - 12);
                if (v < 4) prep_vec<false>(raw[v], rowp + col, p.in[10] + l * 64, QSCALE, false, li, gr, t, ropeL);
                else if (v < 8) prep_vec<false>(raw[v], rowp + col, p.in[11] + l * 64, 1.0f, false, li, gr, t, ropeL);
                else if (v < 12) prep_vec<true>(raw[v], rowp + col, p.in[18] + l * 64, QSCALE, isx, li, gr, t, ropeL);
                else prep_vec<true>(raw[v], rowp + col, p.in[19] + l * 64, 1.0f, isx, li, gr, t, ropeL); }
        }
    }
    {
#pragma unroll
        for (int k0 = 0; k0 < 2; ++k0) {
            unsigned h[4][8]; bf16_t* dstp[4];
#pragma unroll
            for (int k = 0; k < 4; ++k) { const int job = tid + 512 * (k0 * 4 + k); const int cc = job & 511, tg = job >> 9;
                int col; bf16_t* dst;
                if (cc < 256) { col = C_NAV + cc; dst = (bf16_t*)(ws + WS_NAVT) + ((size_t)(b * 256 + cc)) * KSEQ; }
                else { col = C_GLV + (cc - 256); dst = (bf16_t*)(ws + WS_GLVT) + ((size_t)(b * 256 + (cc - 256))) * KSEQ; }
                const bf16_t* src = HX + (size_t)(row0 + 8 * tg) * DINP + col;
#pragma unroll
                for (int i = 0; i < 8; ++i) h[k][i] = src[(size_t)i * DINP];
                dstp[k] = dst + pos0 + 8 * tg; }
#pragma unroll
            for (int k = 0; k < 4; ++k) { u32x4 w; w.x = h[k][0] | (h[k][1] << 16); w.y = h[k][2] | (h[k][3] << 16); w.z = h[k][4] | (h[k][5] << 16); w.w = h[k][6] | (h[k][7] << 16);
                *(u32x4*)dstp[k] = w; }
        }
    }
    LAS float* A = (LAS float*)lds;
    {
        const int colid = tid & 255, half = tid >> 8, dir = colid >> 7, hd = colid & 127;
        const float* wg = (dir == 0 ? p.in[13] : p.in[15]) + l * 16 * 128 + hd;
        const float bg = (dir == 0 ? p.in[14] : p.in[16])[l * 128 + hd];
        float w[16];
#pragma unroll
        for (int r = 0; r < 16; ++r) w[r] = wg[r * 128];
#pragma unroll 4
        for (int t = half * 32; t < half * 32 + 32; ++t) {
            const bf16_t* gp = HX + (size_t)(row0 + t) * DINP + (dir == 0 ? C_GF : C_GB);
            const bf16x8 g0 = ld16(gp), g1 = ld16(gp + 8);
            float acc = bg;
#pragma unroll
            for (int r = 0; r < 8; ++r) { acc += bf2f((bf16_t)g0[r]) * w[r]; acc += bf2f((bf16_t)g1[r]) * w[8 + r]; }
            A[(dir * 64 + t) * 128 + hd] = log_sigmoid(acc) * (1.0f / 16.0f);
        }
    }
    __syncthreads();
    if (tid < 256) {
        const int dir = tid >> 7, hd = tid & 127; float s = 0.f;
        if (dir == 0) {
#pragma unroll 8
            for (int t = 0; t < 64; ++t) { s += A[t * 128 + hd]; A[t * 128 + hd] = s; } }
        else {
#pragma unroll 8
            for (int t = 63; t >= 0; --t) { s += A[(64 + t) * 128 + hd]; A[(64 + t) * 128 + hd] = s; } }
        ((float*)(ws + WS_BLAST))[(((size_t)b * NCHUNK + (pos0 >> 6)) * 2 + dir) * 128 + hd] = s;
    }
    __syncthreads();
    {
        unsigned short kraw[4][8];
#pragma unroll
        for (int k = 0; k < 4; ++k) { const int job = tid + 512 * k; const int hd = job & 127, tg = (job >> 7) & 7;
            const bf16_t* src = HX + (size_t)(row0 + 8 * tg) * DINP + C_GLK + hd;
#pragma unroll
            for (int i = 0; i < 8; ++i) kraw[k][i] = src[(size_t)i * DINP]; }
#pragma unroll
        for (int k = 0; k < 4; ++k) { const int job = tid + 512 * k; const int hd = job & 127, tg = (job >> 7) & 7, dir = job >> 10;
            const float bl = A[(dir * 64 + (dir == 0 ? 63 : 0)) * 128 + hd];
            unsigned h[8];
#pragma unroll
            for (int i = 0; i < 8; ++i) h[i] = f2bf(bf2f(kraw[k][i]) * __expf(bl - A[(dir * 64 + 8 * tg + i) * 128 + hd]));
            u32x4 w; w.x = h[0] | (h[1] << 16); w.y = h[2] | (h[3] << 16); w.z = h[4] | (h[5] << 16); w.w = h[6] | (h[7] << 16);
            *(u32x4*)((bf16_t*)(ws + WS_KKT) + ((size_t)(dir * NB + b) * 128 + hd) * KSEQ + pos0 + 8 * tg) = w; }
    }
    __syncthreads();
    {
        const float qs = 0.17677669529663687f;
        unsigned qraw[8], kraw[8];
#pragma unroll
        for (int k = 0; k < 8; ++k) { const int e = tid + 512 * k; const int t = e >> 6, hp = (e & 63) * 2; const bf16_t* rowp = HX + (size_t)(row0 + t) * DINP;
            qraw[k] = *(const unsigned*)(rowp + C_GLQ + hp); kraw[k] = *(const unsigned*)(rowp + C_GLK + hp); }
#pragma unroll
        for (int k = 0; k < 8; ++k) { const int e = tid + 512 * k; const int t = e >> 6, hp = (e & 63) * 2; bf16_t* rowp = HX + (size_t)(row0 + t) * DINP;
            const float q0 = __uint_as_float(qraw[k] << 16), q1 = __uint_as_float(qraw[k] & 0xffff0000u), k0 = __uint_as_float(kraw[k] << 16), k1 = __uint_as_float(kraw[k] & 0xffff0000u);
            const float bf0 = A[t * 128 + hp], bf1 = A[t * 128 + hp + 1], bb0 = A[(64 + t) * 128 + hp], bb1 = A[(64 + t) * 128 + hp + 1];
            *(unsigned*)(rowp + C_GLQ + hp) = pk2(q0 * qs * __expf(bf0), q1 * qs * __expf(bf1));
            *(unsigned*)(rowp + C_GLK + hp) = pk2(k0 * __expf(-bf0), k1 * __expf(-bf1));
            *(unsigned*)(rowp + C_GLQB + hp) = pk2(q0 * qs * __expf(bb0), q1 * qs * __expf(bb1));
            *(unsigned*)(rowp + C_GLKB + hp) = pk2(k0 * __expf(-bb0), k1 * __expf(-bb1)); }
    }
    asm volatile("s_waitcnt vmcnt(0)" ::: "memory");
    __syncthreads();
    { const int wv = __builtin_amdgcn_readfirstlane(tid >> 6), h = wv >> 1, dir = wv & 1;
      gla_local_unit(ws, ((b * 4 + h) * 2 + dir) * NCHUNK + (pos0 >> 6), tid & 63); }
}

template <int NG> struct AttnState { float m[NG], l[NG]; f32x4 o[NG][4]; bf16x8 q[NG][2]; };

template <int NG> DI void attn_init(AttnState<NG>& st) {
#pragma unroll
    for (int g = 0; g < NG; ++g) { st.m[g] = -1e30f; st.l[g] = 0.f;
#pragma unroll
        for (int d = 0; d < 4; ++d) st.o[g][d] = (f32x4){0.f, 0.f, 0.f, 0.f}; }
}
template <int NG, bool BIAS> DI void attn_block(AttnState<NG>& st, const bf16_t* kp0, const bf16_t* kp1, const bf16_t* vp0, const bf16_t* vp1, const f32x4& bias0, const f32x4& bias1) {
    const bf16x8 k00 = ld16(kp0), k01 = ld16(kp0 + 32), k10 = ld16(kp1), k11 = ld16(kp1 + 32);
    u64 v0[4], v1[4];
#pragma unroll
    for (int d = 0; d < 4; ++d) { v0[d] = ld8(vp0 + (size_t)d * 16 * KSEQ); v1[d] = ld8(vp1 + (size_t)d * 16 * KSEQ); }
#pragma unroll
    for (int g = 0; g < NG; ++g) {
        f32x4 s0 = MFMA16(k00, st.q[g][0], ((f32x4){0.f, 0.f, 0.f, 0.f})); s0 = MFMA16(k01, st.q[g][1], s0);
        f32x4 s1 = MFMA16(k10, st.q[g][0], ((f32x4){0.f, 0.f, 0.f, 0.f})); s1 = MFMA16(k11, st.q[g][1], s1);
        if (BIAS) { s0 += bias0; s1 += bias1; }
        float mx = fmaxf(fmaxf(fmaxf(s0[0], s0[1]), fmaxf(s0[2], s0[3])), fmaxf(fmaxf(s1[0], s1[1]), fmaxf(s1[2], s1[3])));
        mx = quad_max(mx);
        const float mn = fmaxf(st.m[g], mx), corr = __builtin_amdgcn_exp2f(st.m[g] - mn); st.m[g] = mn;
        f32x4 p0, p1;
#pragma unroll
        for (int j = 0; j < 4; ++j) { p0[j] = __builtin_amdgcn_exp2f(s0[j] - mn); p1[j] = __builtin_amdgcn_exp2f(s1[j] - mn); }
        st.l[g] = st.l[g] * corr + ((p0[0] + p0[1]) + (p0[2] + p0[3])) + ((p1[0] + p1[1]) + (p1[2] + p1[3]));
        const bf16x8 pf = pack8(p0, p1);
#pragma unroll
        for (int d = 0; d < 4; ++d) { st.o[g][d] = st.o[g][d] * corr; st.o[g][d] = MFMA16(cat8(v0[d], v1[d]), pf, st.o[g][d]); }
    }
}
template <int NG> DI void attn_run(AttnState<NG>& st, const bf16_t* kl, size_t kpitch, const bf16_t* vl, int nblk) {
    const f32x4 z = {0.f, 0.f, 0.f, 0.f};
#pragma unroll 2
    for (int i = 0; i < nblk; ++i) { const bf16_t* kp0 = kl + (size_t)(32 * i) * kpitch; attn_block<NG, false>(st, kp0, kp0 + 16 * kpitch, vl + 32 * i, vl + 32 * i + 16, z, z); }
}
template <int NG> DI void attn_finish(AttnState<NG>& st, bf16_t* orow  , int hstride, int quad) {
#pragma unroll
    for (int g = 0; g < NG; ++g) { const float inv = 1.0f / quad_sum(st.l[g]);
#pragma unroll
        for (int d = 0; d < 4; ++d) { const f32x4 o = st.o[g][d] * inv; u32x2 w; w.x = pk2(o[0], o[1]); w.y = pk2(o[2], o[3]);
            *(u32x2*)(orow + g * hstride + 16 * d + 4 * quad) = w; } }
}

DI void gqa_unit_x(unsigned char* ws, int u, int lane) {
    const int c16 = lane & 15, quad = lane >> 4;
    const int qb = u & 255, kvh = (u >> 8) & 1, b = u >> 9;
    const bf16_t* HX = (const bf16_t*)(ws + WS_HB); bf16_t* MIX = (bf16_t*)(ws + WS_HN);
    const size_t qrow = (size_t)b * SEQ + 16 * qb + c16;
    AttnState<2> st; attn_init(st);
#pragma unroll
    for (int g = 0; g < 2; ++g) { const bf16_t* qp = HX + qrow * DINP + C_GQQ + (2 * kvh + g) * 64 + quad * 8; st.q[g][0] = ld16(qp); st.q[g][1] = ld16(qp + 32); }
    const bf16_t* vt = (const bf16_t*)(ws + WS_GVT) + ((size_t)(b * 2 + kvh) * 64 + c16) * KSEQ + quad * 4;
    attn_run<2>(st, HX + ((size_t)b * SEQ + c16) * DINP + C_GQK + kvh * 64 + quad * 8, DINP, vt, SEQ / 32);
    attn_run<2>(st, HX + ((size_t)TX + b * CTX + c16) * DINP + C_GQK + kvh * 64 + quad * 8, DINP, vt + SEQ, CTX / 32);
    attn_finish<2>(st, MIX + qrow * DM + 768 + (2 * kvh) * 64, 64, quad);
}
DI void gqa_unit_z(unsigned char* ws, int u, int lane) {
    const int c16 = lane & 15, quad = lane >> 4;
    const int qb = u & 15, kvh = (u >> 4) & 1, b = u >> 5;
    const bf16_t* HX = (const bf16_t*)(ws + WS_HB); bf16_t* MIX = (bf16_t*)(ws + WS_HN);
    const size_t qrow = (size_t)TX + b * CTX + 16 * qb + c16;
    AttnState<2> st; attn_init(st);
#pragma unroll
    for (int g = 0; g < 2; ++g) { const bf16_t* qp = HX + qrow * DINP + C_GQQ + (2 * kvh + g) * 64 + quad * 8; st.q[g][0] = ld16(qp); st.q[g][1] = ld16(qp + 32); }
    const bf16_t* vt = (const bf16_t*)(ws + WS_GVT) + ((size_t)(b * 2 + kvh) * 64 + c16) * KSEQ + quad * 4;
    attn_run<2>(st, HX + ((size_t)TX + b * CTX + c16) * DINP + C_GQK + kvh * 64 + quad * 8, DINP, vt + SEQ, CTX / 32);
    attn_finish<2>(st, MIX + qrow * DM + 768 + (2 * kvh) * 64, 64, quad);
}
DI void na_unit_z(unsigned char* ws, int u, int lane) {
    const int c16 = lane & 15, quad = lane >> 4;
    const int qb = u & 15, h = (u >> 4) & 3, b = u >> 6;
    const bf16_t* HX = (const bf16_t*)(ws + WS_HB); bf16_t* MIX = (bf16_t*)(ws + WS_HN);
    const size_t qrow = (size_t)TX + b * CTX + 16 * qb + c16;
    AttnState<1> st; attn_init(st);
    { const bf16_t* qp = HX + qrow * DINP + C_NAQ + h * 64 + quad * 8; st.q[0][0] = ld16(qp); st.q[0][1] = ld16(qp + 32); }
    const bf16_t* vt = (const bf16_t*)(ws + WS_NAVT) + ((size_t)(b * 4 + h) * 64 + c16) * KSEQ + quad * 4;
    attn_run<1>(st, HX + ((size_t)TX + b * CTX + c16) * DINP + C_NAK + h * 64 + quad * 8, DINP, vt + SEQ, CTX / 32);
    attn_finish<1>(st, MIX + qrow * DM + 256 + h * 64, 64, quad);
}
DI void na_unit_x(unsigned char* ws, const LAS float* rpbL, int u, int lane) {
    const int c16 = lane & 15, quad = lane >> 4;
    const int cb = u & 3, r = (u >> 2) & 63, h = (u >> 8) & 3, b = u >> 10;
    const bf16_t* HX = (const bf16_t*)(ws + WS_HB); bf16_t* MIX = (bf16_t*)(ws + WS_HN);
    const int c = 16 * cb + c16;
    const size_t qrow = (size_t)b * SEQ + 64 * r + c;
    AttnState<1> st; attn_init(st);
    { const bf16_t* qp = HX + qrow * DINP + C_NAQ + h * 64 + quad * 8; st.q[0][0] = ld16(qp); st.q[0][1] = ld16(qp + 32); }
    const bf16_t* vt = (const bf16_t*)(ws + WS_NAVT) + ((size_t)(b * 4 + h) * 64 + c16) * KSEQ + quad * 4;
    const int rs = min(max(r - 4, 0), 56), cbase = min(max(16 * cb - 8, 0), 32), cs = min(max(c - 8, 0), 48);
    const LAS float* rpb = rpbL + h * 15 * 31;
#pragma unroll 2
    for (int wr = 0; wr < 8; ++wr) {
        const int krow = rs + wr, t0 = krow * 64 + cbase;
        const LAS float* bp = rpb + (krow - r + 7) * 31;
        f32x4 b0, b1;
#pragma unroll
        for (int j = 0; j < 4; ++j) { const int kc0 = cbase + 4 * quad + j, kc1 = kc0 + 16;
            const bool ok0 = (kc0 >= cs) && (kc0 < cs + 16), ok1 = (kc1 >= cs) && (kc1 < cs + 16);
            const float w0 = bp[min(max(kc0 - c + 15, 0), 30)], w1 = bp[min(max(kc1 - c + 15, 0), 30)];
            b0[j] = ok0 ? w0 * LOG2E : -1e30f; b1[j] = ok1 ? w1 * LOG2E : -1e30f; }
        const bf16_t* kp0 = HX + ((size_t)b * SEQ + t0 + c16) * DINP + C_NAK + h * 64 + quad * 8;
        attn_block<1, true>(st, kp0, kp0 + (size_t)16 * DINP, vt + t0, vt + t0 + 16, b0, b1);
    }
    attn_run<1>(st, HX + ((size_t)TX + b * CTX + c16) * DINP + C_NAK + h * 64 + quad * 8, DINP, vt + SEQ, CTX / 32);
    attn_finish<1>(st, MIX + qrow * DM + 256 + h * 64, 64, quad);
}

DI void na_row_unit(unsigned char* ws, const LAS float* rpbL, int u, int lane) {
    const int c16 = lane & 15, quad = lane >> 4;
    const int r = u & 63, h = (u >> 6) & 3, b = u >> 8;
    const bf16_t* HX = (const bf16_t*)(ws + WS_HB); bf16_t* MIX = (bf16_t*)(ws + WS_HN);
    const size_t qrow0 = (size_t)b * SEQ + 64 * r;
    float m[4], l[4]; f32x4 o[4][4]; bf16x8 q[4][2];
#pragma unroll
    for (int g = 0; g < 4; ++g) { m[g] = -1e30f; l[g] = 0.f;
#pragma unroll
        for (int d = 0; d < 4; ++d) o[g][d] = (f32x4){0.f, 0.f, 0.f, 0.f};
        const bf16_t* qp = HX + (qrow0 + 16 * g + c16) * DINP + C_NAQ + h * 64 + quad * 8; q[g][0] = ld16(qp); q[g][1] = ld16(qp + 32); }
    const bf16_t* vt = (const bf16_t*)(ws + WS_NAVT) + ((size_t)(b * 4 + h) * 64 + c16) * KSEQ + quad * 8;
    const int tokoff = 8 * (c16 >> 2) + (c16 & 3);
    const int rs = min(max(r - 4, 0), 56);
    const LAS float* rpb = rpbL + h * 15 * 31;
#pragma unroll 2
    for (int blk = 0; blk < 24; ++blk) {
        const bool win = blk < 16; const int wr = blk >> 1, cblk = blk & 1;
        const int t0 = win ? (rs + wr) * 64 + 32 * cblk : SEQ + 32 * (blk - 16);
        const bf16_t* kbase = (win ? HX + ((size_t)b * SEQ + t0 + tokoff) * DINP : HX + ((size_t)TX + b * CTX + (t0 - SEQ) + tokoff) * DINP) + C_NAK + h * 64 + quad * 8;
        const bf16x8 kA0 = ld16(kbase), kA1 = ld16(kbase + 32), kB0 = ld16(kbase + (size_t)4 * DINP), kB1 = ld16(kbase + (size_t)4 * DINP + 32);
        bf16x8 vf[4];
#pragma unroll
        for (int d = 0; d < 4; ++d) vf[d] = ld16(vt + t0 + (size_t)d * 16 * KSEQ);
        const LAS float* bp = rpb + (win ? (rs + wr - r + 7) : 0) * 31;
#pragma unroll
        for (int g = 0; g < 4; ++g) {
            if (win && ((g == 0 && cblk == 1) || (g == 3 && cblk == 0))) continue;
            f32x4 s0 = MFMA16(kA0, q[g][0], ((f32x4){0.f, 0.f, 0.f, 0.f})); s0 = MFMA16(kA1, q[g][1], s0);
            f32x4 s1 = MFMA16(kB0, q[g][0], ((f32x4){0.f, 0.f, 0.f, 0.f})); s1 = MFMA16(kB1, q[g][1], s1);
            if (win) { const int c = 16 * g + c16, cs = min(max(c - 8, 0), 48);
                const int kc0 = 32 * cblk + 8 * quad, lo = cs - kc0; const LAS float* bq = bp + (kc0 - c + 15);
#pragma unroll
                for (int j = 0; j < 4; ++j) { const float w0 = bq[j], w1 = bq[j + 4];
                    const bool ok0 = (unsigned)(j - lo) < 16u, ok1 = (unsigned)(j + 4 - lo) < 16u;
                    s0[j] = ok0 ? s0[j] + w0 * LOG2E : -INFINITY; s1[j] = ok1 ? s1[j] + w1 * LOG2E : -INFINITY; } }
            float mx = fmaxf(fmaxf(fmaxf(s0[0], s0[1]), fmaxf(s0[2], s0[3])), fmaxf(fmaxf(s1[0], s1[1]), fmaxf(s1[2], s1[3])));
            mx = quad_max(mx);
            if (__any(mx > m[g] + 8.0f)) { const float mn = fmaxf(m[g], mx), corr = __builtin_amdgcn_exp2f(m[g] - mn); m[g] = mn; l[g] *= corr;
#pragma unroll
                for (int d = 0; d < 4; ++d) o[g][d] = o[g][d] * corr; }
            const float mr = m[g];
            f32x4 p0, p1;
#pragma unroll
            for (int j = 0; j < 4; ++j) { p0[j] = __builtin_amdgcn_exp2f(s0[j] - mr); p1[j] = __builtin_amdgcn_exp2f(s1[j] - mr); }
            l[g] += ((p0[0] + p0[1]) + (p0[2] + p0[3])) + ((p1[0] + p1[1]) + (p1[2] + p1[3]));
            const bf16x8 pf = pack8(p0, p1);
#pragma unroll
            for (int d = 0; d < 4; ++d) o[g][d] = MFMA16(vf[d], pf, o[g][d]);
        }
    }
#pragma unroll
    for (int g = 0; g < 4; ++g) { const float inv = 1.0f / quad_sum(l[g]); bf16_t* orow = MIX + (qrow0 + 16 * g + c16) * DM + 256 + h * 64;
#pragma unroll
        for (int d = 0; d < 4; ++d) { const f32x4 ov = o[g][d] * inv; u32x2 w; w.x = pk2(ov[0], ov[1]); w.y = pk2(ov[2], ov[3]);
            *(u32x2*)(orow + 16 * d + 4 * quad) = w; } }
}

DI int chunk_row0(int b, int pc) { return pc < 64 ? b * SEQ + 64 * pc : TX + b * CTX + 64 * (pc - 64); }
DI void gla_local_unit(unsigned char* ws, int u, int lane) {
    const int c16 = lane & 15, quad = lane >> 4;
    const int pc = u % NCHUNK; const int seq = u / NCHUNK; const int dir = seq & 1, h = (seq >> 1) & 3, b = seq >> 3;
    const bf16_t* vt = (const bf16_t*)(ws + WS_GLVT) + ((size_t)(b * 4 + h) * 64 + c16) * KSEQ + 64 * pc + quad * 8;
    const bf16_t* kt = (const bf16_t*)(ws + WS_KKT) + ((size_t)((dir * NB + b) * 4 + h) * 32 + c16) * KSEQ + 64 * pc + quad * 8;
    bf16x8 kf[2][2];
#pragma unroll
    for (int db = 0; db < 2; ++db)
#pragma unroll
        for (int ks = 0; ks < 2; ++ks) kf[db][ks] = ld16(kt + (size_t)db * 16 * KSEQ + 32 * ks);
    float* dst = (float*)(ws + WS_SLOC) + ((size_t)seq * NCHUNK + pc) * 2048;
#pragma unroll
    for (int eb = 0; eb < 4; ++eb) { const bf16x8 a0 = ld16(vt + (size_t)eb * 16 * KSEQ), a1 = ld16(vt + (size_t)eb * 16 * KSEQ + 32);
#pragma unroll
        for (int db = 0; db < 2; ++db) { f32x4 acc = MFMA16(a0, kf[db][0], ((f32x4){0.f, 0.f, 0.f, 0.f})); acc = MFMA16(a1, kf[db][1], acc);
#pragma unroll
            for (int j = 0; j < 4; ++j) dst[(16 * eb + 4 * quad + j) * 32 + 16 * db + c16] = acc[j]; } }
}
DI void gla_scan(unsigned char* ws, int gt, int NT) {
    const float* sloc = (const float*)(ws + WS_SLOC); bf16_t* sst = (bf16_t*)(ws + WS_SST); const float* blast = (const float*)(ws + WS_BLAST);
    for (int idx = gt; idx < 64 * 2048; idx += NT) {
        const int el = idx & 2047, seq = idx >> 11, d = el & 31, dir = seq & 1, h = (seq >> 1) & 3, b = seq >> 3;
        float S = 0.f;
        for (int s0 = 0; s0 < NCHUNK; s0 += 17) {
            float lv[17], dv[17];
#pragma unroll
            for (int i = 0; i < 17; ++i) { const int s = s0 + i; const int pc = (dir == 0) ? (s < 4 ? 64 + s : s - 4) : (s < 4 ? 67 - s : 67 - s);
                lv[i] = sloc[((size_t)seq * NCHUNK + pc) * 2048 + el]; dv[i] = blast[(((size_t)b * NCHUNK + pc) * 2 + dir) * 128 + h * 32 + d]; }
#pragma unroll
            for (int i = 0; i < 17; ++i) { const int s = s0 + i; const int pc = (dir == 0) ? (s < 4 ? 64 + s : s - 4) : (s < 4 ? 67 - s : 67 - s);
                sst[((size_t)seq * NCHUNK + pc) * 2048 + el] = f2bf(S); S = __expf(dv[i]) * S + lv[i]; }
        }
    }
}
DI void gla_out_unit(const Params& p, int l, int u, int lane) {
    unsigned char* ws = p.ws;
    const int c16 = lane & 15, quad = lane >> 4;
    const int ib = u & 3, pc = (u >> 2) % NCHUNK, bh = (u >> 2) / NCHUNK, h = bh & 3, b = bh >> 2;
    const bf16_t* HX = (const bf16_t*)(ws + WS_HB); bf16_t* MIX = (bf16_t*)(ws + WS_HN);
    const int row0 = chunk_row0(b, pc);
    const bf16_t* vt = (const bf16_t*)(ws + WS_GLVT) + ((size_t)(b * 4 + h) * 64 + c16) * KSEQ + 64 * pc + quad * 4;
    f32x4 o[4];
#pragma unroll
    for (int e = 0; e < 4; ++e) o[e] = (f32x4){0.f, 0.f, 0.f, 0.f};
    const int i_tok = 16 * ib + c16;
#pragma unroll
    for (int dir = 0; dir < 2; ++dir) {
        const int qc = (dir == 0 ? C_GLQ : C_GLQB) + h * 32, kc = (dir == 0 ? C_GLK : C_GLKB) + h * 32;
        const bf16x8 qf = ld16(HX + (size_t)(row0 + i_tok) * DINP + qc + quad * 8);
        const bf16_t* sp = (const bf16_t*)(ws + WS_SST) + ((size_t)((b * 4 + h) * 2 + dir) * NCHUNK + pc) * 2048 + c16 * 32 + quad * 8;
#pragma unroll
        for (int e = 0; e < 4; ++e) o[e] = MFMA16(ld16(sp + e * 16 * 32), qf, o[e]);
#pragma unroll
        for (int pr = 0; pr < 2; ++pr) {
            f32x4 s[2];
#pragma unroll
            for (int sb = 0; sb < 2; ++sb) { const int jb = 2 * pr + sb;
                const bf16x8 kf = ld16(HX + (size_t)(row0 + 16 * jb + c16) * DINP + kc + quad * 8);
                s[sb] = MFMA16(kf, qf, ((f32x4){0.f, 0.f, 0.f, 0.f}));
#pragma unroll
                for (int j = 0; j < 4; ++j) { const int jt = 16 * jb + 4 * quad + j; const bool keep = (dir == 0) ? (jt <= i_tok) : (jt >= i_tok); s[sb][j] = keep ? s[sb][j] : 0.f; } }
            const bf16x8 pf = pack8(s[0], s[1]);
#pragma unroll
            for (int e = 0; e < 4; ++e) o[e] = MFMA16(cat8(ld8(vt + (size_t)e * 16 * KSEQ + 32 * pr), ld8(vt + (size_t)e * 16 * KSEQ + 32 * pr + 16)), pf, o[e]);
        }
    }
    float ss = 0.f;
#pragma unroll
    for (int e = 0; e < 4; ++e) ss += (o[e][0] * o[e][0] + o[e][1] * o[e][1]) + (o[e][2] * o[e][2] + o[e][3] * o[e][3]);
    ss = quad_sum(ss);
    const float rstd = rsqrtf(ss * (1.0f / 64.0f) + EPS);
    const float* gain = p.in[17] + l * 64;
    const size_t row = (size_t)row0 + i_tok;
#pragma unroll
    for (int e = 0; e < 4; ++e) { const int ec = 16 * e + 4 * quad;
        const u32x2 rr = *(const u32x2*)(HX + row * DINP + C_GLR + h * 64 + ec); const f32x4 g = *(const f32x4*)(gain + ec);
        const float r0 = __uint_as_float(rr.x << 16), r1 = __uint_as_float(rr.x & 0xffff0000u), r2 = __uint_as_float(rr.y << 16), r3 = __uint_as_float(rr.y & 0xffff0000u);
        u32x2 w; w.x = pk2(o[e][0] * rstd * g[0] * pg8::silu_f(r0), o[e][1] * rstd * g[1] * pg8::silu_f(r1)); w.y = pk2(o[e][2] * rstd * g[2] * pg8::silu_f(r2), o[e][3] * rstd * g[3] * pg8::silu_f(r3));
        *(u32x2*)(MIX + row * DM + 512 + h * 64 + ec) = w; }
}

DI void gla_chunk_unit(const Params& p, int l, int u, int lane) {
    unsigned char* ws = p.ws;
    const int c16 = lane & 15, quad = lane >> 4;
    const int pc = u % NCHUNK, bh = u / NCHUNK, h = bh & 3, b = bh >> 2;
    const bf16_t* HX = (const bf16_t*)(ws + WS_HB); bf16_t* MIX = (bf16_t*)(ws + WS_HN);
    const int row0 = chunk_row0(b, pc);
    const bf16_t* vt = (const bf16_t*)(ws + WS_GLVT) + ((size_t)(b * 4 + h) * 64 + c16) * KSEQ + 64 * pc + quad * 8;
    bf16x8 vf[2][4];
#pragma unroll
    for (int pr = 0; pr < 2; ++pr)
#pragma unroll
        for (int e = 0; e < 4; ++e) vf[pr][e] = ld16(vt + (size_t)e * 16 * KSEQ + 32 * pr);
    f32x4 o[4][4];
#pragma unroll
    for (int ib = 0; ib < 4; ++ib)
#pragma unroll
        for (int e = 0; e < 4; ++e) o[ib][e] = (f32x4){0.f, 0.f, 0.f, 0.f};
    const int ktok = 8 * (c16 >> 2) + (c16 & 3);
#pragma unroll
    for (int dir = 0; dir < 2; ++dir) {
        const int qc = (dir == 0 ? C_GLQ : C_GLQB) + h * 32, kc = (dir == 0 ? C_GLK : C_GLKB) + h * 32;
        bf16x8 qf[4], sf[4], kA[2], kB[2];
#pragma unroll
        for (int ib = 0; ib < 4; ++ib) qf[ib] = ld16(HX + (size_t)(row0 + 16 * ib + c16) * DINP + qc + quad * 8);
        const bf16_t* sp = (const bf16_t*)(ws + WS_SST) + ((size_t)((b * 4 + h) * 2 + dir) * NCHUNK + pc) * 2048 + c16 * 32 + quad * 8;
#pragma unroll
        for (int e = 0; e < 4; ++e) sf[e] = ld16(sp + e * 16 * 32);
#pragma unroll
        for (int pr = 0; pr < 2; ++pr) { const bf16_t* kp = HX + (size_t)(row0 + 32 * pr + ktok) * DINP + kc + quad * 8; kA[pr] = ld16(kp); kB[pr] = ld16(kp + (size_t)4 * DINP); }
#pragma unroll
        for (int ib = 0; ib < 4; ++ib) {
#pragma unroll
            for (int e = 0; e < 4; ++e) o[ib][e] = MFMA16(sf[e], qf[ib], o[ib][e]);
            const int it = 16 * ib + c16;
#pragma unroll
            for (int pr = 0; pr < 2; ++pr) {
                const bool need = (dir == 0) ? (32 * pr <= 16 * ib + 15) : (32 * pr + 31 >= 16 * ib);
                if (!need) continue;
                f32x4 s0 = MFMA16(kA[pr], qf[ib], ((f32x4){0.f, 0.f, 0.f, 0.f})), s1 = MFMA16(kB[pr], qf[ib], ((f32x4){0.f, 0.f, 0.f, 0.f}));
#pragma unroll
                for (int j = 0; j < 4; ++j) { const int j0 = 32 * pr + 8 * quad + j, j1 = j0 + 4;
                    const bool k0 = (dir == 0) ? (j0 <= it) : (j0 >= it), k1 = (dir == 0) ? (j1 <= it) : (j1 >= it);
                    s0[j] = k0 ? s0[j] : 0.f; s1[j] = k1 ? s1[j] : 0.f; }
                const bf16x8 pf = pack8(s0, s1);
#pragma unroll
                for (int e = 0; e < 4; ++e) o[ib][e] = MFMA16(vf[pr][e], pf, o[ib][e]);
            }
        }
    }
    const float* gain = p.in[17] + l * 64;
#pragma unroll
    for (int ib = 0; ib < 4; ++ib) {
        float ss = 0.f;
#pragma unroll
        for (int e = 0; e < 4; ++e) ss += (o[ib][e][0] * o[ib][e][0] + o[ib][e][1] * o[ib][e][1]) + (o[ib][e][2] * o[ib][e][2] + o[ib][e][3] * o[ib][e][3]);
        ss = quad_sum(ss);
        const float rstd = rsqrtf(ss * (1.0f / 64.0f) + EPS);
        const size_t row = (size_t)row0 + 16 * ib + c16;
#pragma unroll
        for (int e = 0; e < 4; ++e) { const int ec = 16 * e + 4 * quad;
            const u32x2 rr = *(const u32x2*)(HX + row * DINP + C_GLR + h * 64 + ec); const f32x4 g = *(const f32x4*)(gain + ec);
            const float r0 = __uint_as_float(rr.x << 16), r1 = __uint_as_float(rr.x & 0xffff0000u), r2 = __uint_as_float(rr.y << 16), r3 = __uint_as_float(rr.y & 0xffff0000u);
            u32x2 w; w.x = pk2(o[ib][e][0] * rstd * g[0] * pg8::silu_f(r0), o[ib][e][1] * rstd * g[1] * pg8::silu_f(r1)); w.y = pk2(o[ib][e][2] * rstd * g[2] * pg8::silu_f(r2), o[ib][e][3] * rstd * g[3] * pg8::silu_f(r3));
            *(u32x2*)(MIX + row * DM + 512 + h * 64 + ec) = w; }
    }
}

DI void four1_unit(unsigned char* ws, int u, int lane) {
    const int c16 = lane & 15, quad = lane >> 4;
    const int cq = u & 3, l2 = (u >> 2) & 63, bg = u >> 8, g = bg & 3, b = bg >> 2;
    const bf16_t* HX = (const bf16_t*)(ws + WS_HB);
    const bf16_t* FC = (const bf16_t*)(ws + WS_TAB + T_FC64); const bf16_t* FSN = (const bf16_t*)(ws + WS_TAB + T_FSN64); const float* TW = (const float*)(ws + WS_TAB + T_TW);
    bf16x8 uf[2];
    const bf16_t* up = HX + ((size_t)b * SEQ + l2) * DINP + C_FOUR + g * 64 + 16 * cq + c16;
#pragma unroll
    for (int ks = 0; ks < 2; ++ks) { unsigned hh[8];
#pragma unroll
        for (int j = 0; j < 8; ++j) hh[j] = up[(size_t)(64 * (quad * 8 + j + 32 * ks)) * DINP];
        u32x4 w; w.x = hh[0] | (hh[1] << 16); w.y = hh[2] | (hh[3] << 16); w.z = hh[4] | (hh[5] << 16); w.w = hh[6] | (hh[7] << 16); uf[ks] = __builtin_bit_cast(bf16x8, w); }
    bf16_t* tr = (bf16_t*)(ws + WS_TTR); bf16_t* ti = (bf16_t*)(ws + WS_TTI);
#pragma unroll
    for (int kq = 0; kq < 4; ++kq) {
        const bf16_t* fr = FC + (16 * kq + c16) * 64 + quad * 8; const bf16_t* fi = FSN + (16 * kq + c16) * 64 + quad * 8;
        f32x4 re = MFMA16(ld16(fr), uf[0], ((f32x4){0.f, 0.f, 0.f, 0.f})); re = MFMA16(ld16(fr + 32), uf[1], re);
        f32x4 im = MFMA16(ld16(fi), uf[0], ((f32x4){0.f, 0.f, 0.f, 0.f})); im = MFMA16(ld16(fi + 32), uf[1], im);
#pragma unroll
        for (int j = 0; j < 4; ++j) { const int kb = 16 * kq + 4 * quad + j; const float cw = TW[2 * (kb * 64 + l2)], sw = TW[2 * (kb * 64 + l2) + 1];
            const float xr = re[j] * cw + im[j] * sw, xi = im[j] * cw - re[j] * sw;
            const size_t off = (((size_t)bg * 64 + kb) * 64 + l2) * 64 + 16 * cq + c16;
            tr[off] = f2bf(xr); ti[off] = f2bf(xi); }
    }
}
template <int NLB, bool CPLX> DI void four2_unit(const bf16_t* xr, const bf16_t* xi, size_t xpitch, const bf16_t* FC64, const bf16_t* FS64, const bf16_t* FSN64,
                                                  const bf16_t* FLC, const bf16_t* FLS, bf16_t* out, size_t out_rstride, float scale, int mb, int lane, int kq_lo = 0, int kq_hi = NLB) {
    const int c16 = lane & 15, quad = lane >> 4;
    bf16x8 bc[2], bs[2], bsn[2];
#pragma unroll
    for (int ks = 0; ks < 2; ++ks) { const size_t o = (size_t)(16 * mb + c16) * 64 + quad * 8 + 32 * ks; bc[ks] = ld16(FC64 + o); bs[ks] = ld16(FS64 + o); bsn[ks] = ld16(FSN64 + o); }
    bf16x8 qr[NLB / 2], qi[NLB / 2];
#pragma unroll
    for (int pr = 0; pr < NLB / 2; ++pr) {
        f32x4 tr[2], ti[2];
#pragma unroll
        for (int sb = 0; sb < 2; ++sb) { const int lb = 2 * pr + sb;
            const bf16_t* xp = xr + (size_t)(16 * lb + c16) * xpitch + quad * 8;
            const bf16x8 a0 = ld16(xp), a1 = ld16(xp + 32);
            tr[sb] = MFMA16(a0, bc[0], ((f32x4){0.f, 0.f, 0.f, 0.f})); tr[sb] = MFMA16(a1, bc[1], tr[sb]);
            ti[sb] = MFMA16(a0, bsn[0], ((f32x4){0.f, 0.f, 0.f, 0.f})); ti[sb] = MFMA16(a1, bsn[1], ti[sb]);
            if (CPLX) { const bf16_t* yp = xi + (size_t)(16 * lb + c16) * xpitch + quad * 8; const bf16x8 i0 = ld16(yp), i1 = ld16(yp + 32);
                tr[sb] = MFMA16(i0, bs[0], tr[sb]); tr[sb] = MFMA16(i1, bs[1], tr[sb]);
                ti[sb] = MFMA16(i0, bc[0], ti[sb]); ti[sb] = MFMA16(i1, bc[1], ti[sb]); } }
        qr[pr] = pack8(tr[0], tr[1]); qi[pr] = pack8(ti[0], ti[1]);
    }
    constexpr int NL = NLB * 16;
#pragma unroll 2
    for (int kq = kq_lo; kq < kq_hi; ++kq) {
        f32x4 y = {0.f, 0.f, 0.f, 0.f};
        const bf16_t* fc = FLC + (size_t)(16 * kq + c16) * NL + quad * 4; const bf16_t* fs = FLS + (size_t)(16 * kq + c16) * NL + quad * 4;
#pragma unroll
        for (int pr = 0; pr < NLB / 2; ++pr) { y = MFMA16(cat8(ld8(fc + 32 * pr), ld8(fc + 32 * pr + 16)), qr[pr], y); y = MFMA16(cat8(ld8(fs + 32 * pr), ld8(fs + 32 * pr + 16)), qi[pr], y); }
#pragma unroll
        for (int j = 0; j < 4; ++j) out[(size_t)(16 * kq + 4 * quad + j) * out_rstride + c16] = f2bf(y[j] * scale);
    }
}

DI void four2_row_unit(unsigned char* ws, int u, int lane) {
    asm volatile("" : "+v"(lane));
    const int c16 = lane & 15, quad = lane >> 4;
    const int kb = u & 63, bg = u >> 6;
    const unsigned char* tab = ws + WS_TAB;
    const bf16_t* FC = (const bf16_t*)(tab + T_FC64); const bf16_t* FS = (const bf16_t*)(tab + T_FS64); const bf16_t* FSN = (const bf16_t*)(tab + T_FSN64);
    const size_t xo = ((size_t)bg * 64 + kb) * 4096;
    const bf16_t* xr = (const bf16_t*)(ws + WS_TTR) + xo; const bf16_t* xi = (const bf16_t*)(ws + WS_TTI) + xo;
    bf16x8 tc[4][2], ts[4][2];
#pragma unroll
    for (int kq = 0; kq < 4; ++kq)
#pragma unroll
        for (int pr = 0; pr < 2; ++pr) { const size_t o = (size_t)(16 * kq + c16) * 64 + quad * 4 + 32 * pr; tc[kq][pr] = cat8(ld8(FC + o), ld8(FC + o + 16)); ts[kq][pr] = cat8(ld8(FS + o), ld8(FS + o + 16)); }
    bf16_t* out = (bf16_t*)(ws + WS_HN) + ((size_t)(bg >> 2) * SEQ + kb) * DM + (bg & 3) * 64;
#pragma unroll 1
    for (int mb = 0; mb < 4; ++mb) {
        bf16x8 bc[2], bs[2], bsn[2];
#pragma unroll
        for (int ks = 0; ks < 2; ++ks) { const size_t o = (size_t)(16 * mb + c16) * 64 + quad * 8 + 32 * ks; bc[ks] = ld16(FC + o); bs[ks] = ld16(FS + o); bsn[ks] = ld16(FSN + o); }
        bf16x8 qr[2], qi[2];
#pragma unroll
        for (int pr = 0; pr < 2; ++pr) { f32x4 tr[2], ti[2];
#pragma unroll
            for (int sb = 0; sb < 2; ++sb) { const int lb = 2 * pr + sb; const size_t o = (size_t)(16 * lb + c16) * 64 + quad * 8;
                const bf16x8 ar0 = ld16(xr + o), ar1 = ld16(xr + o + 32), ai0 = ld16(xi + o), ai1 = ld16(xi + o + 32);
                tr[sb] = MFMA16(ar0, bc[0], ((f32x4){0.f, 0.f, 0.f, 0.f})); tr[sb] = MFMA16(ar1, bc[1], tr[sb]); tr[sb] = MFMA16(ai0, bs[0], tr[sb]); tr[sb] = MFMA16(ai1, bs[1], tr[sb]);
                ti[sb] = MFMA16(ar0, bsn[0], ((f32x4){0.f, 0.f, 0.f, 0.f})); ti[sb] = MFMA16(ar1, bsn[1], ti[sb]); ti[sb] = MFMA16(ai0, bc[0], ti[sb]); ti[sb] = MFMA16(ai1, bc[1], ti[sb]); }
            qr[pr] = pack8(tr[0], tr[1]); qi[pr] = pack8(ti[0], ti[1]); }
#pragma unroll
        for (int kq = 0; kq < 4; ++kq) { f32x4 y = {0.f, 0.f, 0.f, 0.f};
#pragma unroll
            for (int pr = 0; pr < 2; ++pr) { y = MFMA16(tc[kq][pr], qr[pr], y); y = MFMA16(ts[kq][pr], qi[pr], y); }
#pragma unroll
            for (int j = 0; j < 4; ++j) out[(size_t)(16 * kq + 4 * quad + j) * 64 * DM + 16 * mb + c16] = f2bf(y[j] * (1.0f / 512.0f)); }
    }
}

#define PHASE_VARS \
    int tid = threadIdx.x; asm volatile("" : "+v"(tid)); \
    const int lane = tid & 63, wave = __builtin_amdgcn_readfirstlane(tid >> 6); \
    const int G = gridDim.x, bid = blockIdx.x, vbid = ((G & 7) == 0) ? (bid & 7) * (G >> 3) + (bid >> 3) : bid, gw = vbid * 8 + wave, NGW = G * 8, gt = bid * 512 + tid, NT = G * 512; \
    size_t ws_off0 = 0; asm volatile("" : "+s"(ws_off0)); unsigned char* ws = p.ws + ws_off0; \
    int hs = hs_loop; asm volatile("" : "+s"(hs)); \
    const int l = hs >> 1; const bool second = hs & 1; const bool lastl = (l == 1); \
    const float* mod = (const float*)(ws + WS_MOD) + (size_t)l * 9 * 9216; \
    const unsigned char* wl = ws + WS_W + (size_t)l * W_LAYER; \
    float* ZB = (float*)(ws + WS_Z); bf16_t* HN = (bf16_t*)(ws + WS_HN); bf16_t* HB = (bf16_t*)(ws + WS_HB); \
    (void)vbid; (void)lane; (void)wave; (void)gw; (void)NGW; (void)gt; (void)NT; (void)second; (void)lastl; (void)mod; (void)wl; (void)ZB; (void)HN; (void)HB; (void)bid; (void)G;

__global__ void __launch_bounds__(512, 2) mega_fwd(Params p) {
    extern __shared__ __attribute__((aligned(16))) unsigned char lds_raw[];
    LAS unsigned char* lds = (LAS unsigned char*)lds_raw;
    cg::grid_group grid = cg::this_grid();
    if (threadIdx.x < 2) ((volatile LAS unsigned*)(lds + LDS_BARST))[threadIdx.x] = 0u;
    __syncthreads();
    (void)xcd_barrier_post((unsigned*)(p.ws + WS_BAR), (volatile LAS unsigned*)(lds + LDS_BARST));
#define GRID_BAR() grid_bar_fn((unsigned*)(p.ws + WS_BAR), (unsigned)LDS_BARST)
#if DIAG_MODE
    unsigned long long t_prev = __builtin_amdgcn_s_memrealtime(); unsigned t_cat[8] = {0u, 0u, 0u, 0u, 0u, 0u, 0u, 0u};
#define STAMP(c) do { const unsigned long long t_now = __builtin_amdgcn_s_memrealtime(); t_cat[c] += (unsigned)(t_now - t_prev); t_prev = t_now; } while (0)
#else
#define STAMP(c) do {} while (0)
#endif
    { const int hs_loop = 0; PHASE_VARS
      phase_prologue<true>(p, lds, tid, lane, wave, bid, G, 0, 2); }
    grid.sync(); STAMP(0);
    { const int hs_loop = 0; PHASE_VARS
      shift_bias_mfma(ws, gw, NGW, lane);
      scale_pass(p.in[0], p.in[2], mod, 1, HN, (float*)(ws + WS_ROWSS), TT, gw, NGW, lane); }
    GRID_BAR(); STAMP(1);
    for (int rs_ = 0; rs_ < REP_SYNC; ++rs_) GRID_BAR();

#pragma unroll 1
    for (int hs_loop = 0; hs_loop < 4; ++hs_loop) {
        for (int rep = 0; rep < REP_UP; ++rep) {
        { PHASE_VARS
          const int Mrows = (hs == 3) ? TX : TT;
          const bf16_t* Ain = second ? (const bf16_t*)(ws + WS_NAVT) : HN;
          const int slot = second ? (l == 0 ? 2 : 5) : (l == 0 ? 0 : 3);
          pg8::Gemm g{Ain, (const bf16_t*)(wl + (second ? W_UP2 : W_UP1)), Mrows, 2 * DFF, DM, DM}; pg8::PrefOrder S; S.init(Mrows, 2 * DFF, G, bid);
          S.rowss = (const float*)(ws + WS_ROWSS) + (size_t)slot * TT; S.sb = (const float*)(ws + WS_SB) + (size_t)l * SB_LAYER + (second ? SB_UP2 : SB_UP1); S.sbN = 2 * DFF;
          pg8::EpiSwiglu E{HB, DFF};
          pg8::gemm_phase<pg8::EpiSwiglu, pg8::PrefOrder, true, true>(lds, g, S, E); }
        GRID_BAR(); STAMP(2); }
        { PHASE_VARS
          const float* xin = (hs == 0) ? p.in[0] : p.out;
          bf16_t* hn = (hs == 3) ? (bf16_t*)nullptr : HN;
          const float* nscale = second ? (const float*)(ws + WS_MOD) + (size_t)9 * 9216 + 1 * 1024 : mod + 4 * 1024;
          const int nslot = second ? 3 : (l == 0 ? 1 : 4);
          pg8::Gemm g{HB, (const bf16_t*)(wl + (second ? W_DN2 : W_DN1)), TX, DM, DFF, DFF}; pg8::StaticOrder S; S.init(TX, DM, G, bid);
          pg8::EpiResid E{xin, ZB, p.out, ZB, mod + (second ? 8 : 2) * 1024, 0.5f, hn, nscale, (float*)(ws + WS_ROWSS) + (size_t)nslot * TT};
          pg8::gemm_phase<pg8::EpiResid, pg8::StaticOrder, true, true>(lds, g, S, E); }
        if (hs_loop < 3) {
        { PHASE_VARS
          const int sl = bid & 3, koff = (sl == 0) ? 0 : (sl == 1) ? 768 : (sl == 2) ? 1408 : 2176, klen = (sl & 1) ? 640 : 768;
          pg8::Gemm g{HB + koff, (const bf16_t*)(wl + (second ? W_DN2 : W_DN1)) + koff, TT, DM, klen, DFF};
          pg8::OneUnit S{128 + (bid >> 4), (bid >> 2) & 3, bid < 128};
          pg8::EpiPart E{(float*)(ws + WS_TTR) + (size_t)sl * TZ * DM - (size_t)TX * DM};
          pg8::gemm_phase<pg8::EpiPart, pg8::OneUnit, false, true>(lds, g, S, E); }
        GRID_BAR();
        { PHASE_VARS
          const float* zin = (hs == 0) ? p.in[2] : ZB;
          const float* nscale = second ? (const float*)(ws + WS_MOD) + (size_t)9 * 9216 + 1 * 1024 : mod + 4 * 1024;
          const int nslot = second ? 3 : (l == 0 ? 1 : 4);
          z_finalize(ws, zin, mod + (size_t)8 * 9216 + (second ? 8 : 2) * 1024, HN + (size_t)TX * DM, nscale + (size_t)8 * 9216, (float*)(ws + WS_ROWSS) + (size_t)nslot * TT + TX, gw, NGW, lane); }
        }
        GRID_BAR(); STAMP(2);
        if (hs_loop & 1) continue;
        { PHASE_VARS
          pg8::Gemm g{HN, (const bf16_t*)(wl + W_IN), TT, DINP, DM, DM}; pg8::PrefOrder S; S.init(TT, DINP, G, bid);
          S.rowss = (const float*)(ws + WS_ROWSS) + (size_t)(l == 0 ? 1 : 4) * TT; S.sb = (const float*)(ws + WS_SB) + (size_t)l * SB_LAYER + SB_IN; S.sbN = DINP;
          pg8::EpiBf16 E{HB, DINP}; pg8::gemm_phase<pg8::EpiBf16, pg8::PrefOrder, true, true>(lds, g, S, E); }
        GRID_BAR(); STAMP(3);
        { PHASE_VARS
          for (int i = tid; i < 2048; i += 512) ((LAS float*)(lds + 65536))[i] = ((const float*)(ws + WS_TAB + T_ROPE))[i];
          __syncthreads();
          for (int t = bid; t < 544; t += G) prep_tile(p, l, t, lds, tid); }
        { PHASE_VARS
          const int n_busy = 544 - 2 * G;
          if (n_busy > 0 && n_busy < G) { if (bid >= n_busy) for (int u = (bid - n_busy) * 8 + wave; u < 8192; u += (G - n_busy) * 8) four1_unit(ws, u, lane); }
          else for (int u = gw; u < 8192; u += NGW) four1_unit(ws, u, lane); }
        GRID_BAR(); STAMP(4);
        for (int rep = 0; rep < REP_S3; ++rep) {
        { PHASE_VARS
          gla_scan(ws, gt, NT); }
        { PHASE_VARS
          const unsigned char* tab = ws + WS_TAB;
          for (int i = tid; i < 4 * 15 * 31; i += 512) ((LAS float*)lds)[i] = p.in[12][(size_t)l * 4 * 15 * 31 + i];
          __syncthreads();
          const int n_f2 = 2048, n_na = 2048, n_fz = lastl ? 0 : 512, n_naz = lastl ? 0 : 512;
          const int tot = n_f2 + n_na + n_fz + n_naz;
          for (int u = gw; u < tot; u += NGW) {
              if (u < n_na) { for (int rn = 0; rn < REP_NA; ++rn) na_row_unit(ws, (const LAS float*)lds, u, lane); }
              else if (u < n_na + n_f2) { for (int rf = 0; rf < REP_F2; ++rf) four2_row_unit(ws, u - n_na, lane); }
              else if (u < n_na + n_f2 + n_fz) { const int v = u - n_na - n_f2; const int qt = v & 3, mb = (v >> 2) & 3, bg = v >> 4;
                  const bf16_t* xr = HB + ((size_t)TX + (bg >> 2) * CTX) * DINP + C_FOUR + (bg & 3) * 64;
                  four2_unit<16, false>(xr, xr, DINP, (const bf16_t*)(tab + T_FC64), (const bf16_t*)(tab + T_FS64), (const bf16_t*)(tab + T_FSN64),
                                        (const bf16_t*)(tab + T_FC256), (const bf16_t*)(tab + T_FS256), HN + ((size_t)TX + (bg >> 2) * CTX) * DM + (bg & 3) * 64 + 16 * mb, (size_t)DM, 1.0f / 128.0f, mb, lane, 4 * qt, 4 * qt + 4); }
              else na_unit_z(ws, u - n_na - n_f2 - n_fz, lane);
          } }
        GRID_BAR(); STAMP(6); }
        for (int rep = 0; rep < REP_S4; ++rep) {
        { PHASE_VARS
          typedef attn_body::bf16 abf;
          const abf* HXb = (const abf*)HB; abf* MIXb = (abf*)HN;
          const int n_units = 512 + (lastl ? 0 : 32);
          for (int u = vbid; u < n_units; u += G) {
              const abf *Qu, *K0, *V0, *K1, *V1; abf* Ou; int NT0, NTt;
              if (u < 512) { const int b = u >> 6, h = (u >> 4) & 3, qb = u & 15, kvh = h >> 1;
                  Qu = HXb + ((size_t)b * SEQ + 256 * qb) * DINP + C_GQQ + h * 64;
                  K0 = HXb + (size_t)b * SEQ * DINP + C_GQK + kvh * 64; V0 = HXb + (size_t)b * SEQ * DINP + C_GQV + kvh * 64;
                  K1 = HXb + ((size_t)TX + b * CTX) * DINP + C_GQK + kvh * 64; V1 = HXb + ((size_t)TX + b * CTX) * DINP + C_GQV + kvh * 64;
                  NT0 = 64; NTt = 68; Ou = MIXb + ((size_t)b * SEQ + 256 * qb) * DM + 768 + h * 64; }
              else { const int v = u - 512, b = v >> 2, h = v & 3, kvh = h >> 1;
                  Qu = HXb + ((size_t)TX + b * CTX) * DINP + C_GQQ + h * 64;
                  K1 = HXb + ((size_t)TX + b * CTX) * DINP + C_GQK + kvh * 64; V1 = HXb + ((size_t)TX + b * CTX) * DINP + C_GQV + kvh * 64; K0 = K1; V0 = V1;
                  NT0 = 0; NTt = 4; Ou = MIXb + ((size_t)TX + b * CTX) * DM + 768 + h * 64; }
              attn_body::attn_unit<8>(Qu, K0, V0, K1, V1, NT0, NTt, Ou, (char*)lds_raw);
          } }
        { PHASE_VARS
          const int n_lat = 8 * 4 * 64, n_ctx = lastl ? 0 : 8 * 4 * 4 * 4;
          const int voff = (NGW > n_ctx) ? NGW - n_ctx : 0;
          for (int u = gw; u < n_lat; u += NGW) gla_chunk_unit(p, l, (u >> 6) * NCHUNK + (u & 63), lane);
          for (int v = gw - voff; v < n_ctx; v += NGW) if (v >= 0) { const int ib = v & 3, pcz = (v >> 2) & 3, bh = v >> 4; gla_out_unit(p, l, ((bh * NCHUNK + 64 + pcz) << 2) | ib, lane); } }
        GRID_BAR(); STAMP(7); }
        { PHASE_VARS
          const int Mo = lastl ? TX : TT; pg8::Gemm g{HN, (const bf16_t*)(wl + W_OUT), Mo, DM, DM, DM}; pg8::StaticOrder S; S.init(Mo, DM, G, bid);
          pg8::EpiResid E{p.out, ZB, p.out, ZB, mod + 5 * 1024, 1.0f, (bf16_t*)(ws + WS_NAVT), mod + 7 * 1024, (float*)(ws + WS_ROWSS) + (size_t)(l == 0 ? 2 : 5) * TT}; pg8::gemm_phase<pg8::EpiResid, pg8::StaticOrder, true, true>(lds, g, S, E); }
        GRID_BAR(); STAMP(3);
    }
#if DIAG_MODE
    if (blockIdx.x == 0) {
        const float ta = (float)t_cat[DIAG_A] * 0.01f, tb = (float)t_cat[DIAG_B] * 0.01f;
        if (threadIdx.x == 0) p.out[0] = 100.0f * ta;
        for (int i = threadIdx.x; i < (1 << 20); i += 512) p.out[1024 + i] = tb;
    }
#endif
}

extern "C" void kernel_launch(void* const* d_in, const int* in_sizes, int n_in, void* d_out, int out_size, void* d_ws, size_t ws_size, hipStream_t stream) {
    static int grid = 0;
    if (grid == 0) {
        int dev = 0, cus = 0, per_cu = 0;
        hipGetDevice(&dev);
        hipDeviceGetAttribute(&cus, hipDeviceAttributeMultiprocessorCount, dev);
        hipFuncSetAttribute((const void*)mega_fwd, hipFuncAttributeMaxDynamicSharedMemorySize, LDS_BYTES);
        hipOccupancyMaxActiveBlocksPerMultiprocessor(&per_cu, (const void*)mega_fwd, 512, LDS_BYTES);
        (void)hipGetLastError();
        if (per_cu < 1) per_cu = 1;
        if (per_cu > 1) per_cu = 1;
        grid = cus * per_cu;
        if (n_in != 24 || ws_size < WS_END) { fprintf(stderr, "kernel_launch: unexpected n_in %d / ws_size %zu (need %zu)\n", n_in, ws_size, (size_t)WS_END); }
    }
    (void)hipMemsetAsync((unsigned char*)d_ws + WS_BAR, 0, 16384, stream);
    Params p{};
    for (int i = 0; i < 24; ++i) p.in[i] = (const float*)d_in[i];
    p.out = (float*)d_out; p.ws = (unsigned char*)d_ws;
    void* args[] = {&p};
    hipError_t e = hipLaunchCooperativeKernel((const void*)mega_fwd, dim3(grid), dim3(512), args, LDS_BYTES, stream);
    if (e != hipSuccess) fprintf(stderr, "cooperative launch failed: %s (grid %d)\n", hipGetErrorString(e), grid);
}
```
